# Optimizing an MI355X kernel written in HIP

```python
import math
import jax
import jax.numpy as jnp
from jax import lax
import numpy as np

D_MODEL = 1024
BATCH = 8
SEQ = 4096
DEPTH = 2

GRID_W = 64
CTX_LEN = 256
N_MIXERS = 2
N_Q_HEADS = 16
N_KV_HEADS = 4
HEAD_DIM = D_MODEL // N_Q_HEADS
WINDOW = 128
BLOCK = 128
ROPE_THETA = 10000.0
DN_HEADS = 8
DN_DK = D_MODEL // DN_HEADS
DN_DV = D_MODEL // DN_HEADS
DN_WIDTH = DN_HEADS * DN_DV
CONV_K = 3
CHUNK = 64
N_EXPERTS = 16
EXPERT_FF = 2 * D_MODEL
CAPACITY_FACTOR = 2
ADA_SCALE = 0.5
EPS = 1e-6

kernel_name = 'hybrid_swa_gdn_ecmoe_dit'


def rms_norm(x, g):
    xf = x.astype(jnp.float32)
    y = xf * lax.rsqrt(jnp.mean(xf * xf, axis=-1, keepdims=True) + EPS)
    return (y * g.astype(jnp.float32)).astype(x.dtype)


def modulate(x, g, shift, scale):
    return rms_norm(x, g) * (1 + scale) + shift


def ada_modulation(cond, w, b):
    m = jax.nn.silu(cond) @ w + b
    return jnp.split(m, 6, axis=-1)


def axial_rope_angles(n_tokens):
    rows = n_tokens // GRID_W
    row = jnp.repeat(jnp.arange(rows), GRID_W)
    col = jnp.tile(jnp.arange(GRID_W), rows)
    quarter = HEAD_DIM // 4
    inv_freq = ROPE_THETA ** (-jnp.arange(quarter, dtype=jnp.float32) / quarter)
    ang = jnp.stack([row[:, None] * inv_freq, col[:, None] * inv_freq], axis=1)
    return jnp.cos(ang), jnp.sin(ang)


def apply_axial_rope(x, cos, sin):
    shp = x.shape
    quarter = HEAD_DIM // 4
    xr = x.reshape(shp[:-1] + (2, 2, quarter)).astype(jnp.float32)
    bshape = (shp[1],) + (1,) * (len(shp) - 3) + (2, quarter)
    c = cos.reshape(bshape)
    s = sin.reshape(bshape)
    x1 = xr[..., 0, :]
    x2 = xr[..., 1, :]
    out = jnp.stack([x1 * c - x2 * s, x2 * c + x1 * s], axis=-2)
    return out.reshape(shp).astype(x.dtype)


def window_sink_attention(h_lat, h_ctx, w_qkv, sink, w_o, need_ctx_out):
    B, N, _ = h_lat.shape
    L = h_ctx.shape[1]
    G = N_Q_HEADS // N_KV_HEADS
    dq = N_Q_HEADS * HEAD_DIM
    dkv = N_KV_HEADS * HEAD_DIM

    def project(h):
        p = h @ w_qkv
        lead = h.shape[:2]
        q = p[..., :dq].reshape(lead + (N_KV_HEADS, G, HEAD_DIM))
        k = p[..., dq:dq + dkv].reshape(lead + (N_KV_HEADS, HEAD_DIM))
        v = p[..., dq + dkv:].reshape(lead + (N_KV_HEADS, HEAD_DIM))
        return q, k, v

    ql, kl, vl = project(h_lat)
    qc, kc, vc = project(h_ctx)
    cos, sin = axial_rope_angles(N)
    ql = apply_axial_rope(ql, cos, sin)
    kl = apply_axial_rope(kl, cos, sin)
    scale = HEAD_DIM ** -0.5
    sink_b = sink.astype(jnp.float32).reshape(N_KV_HEADS, G)[None, :, :, None, None]

    def sink_softmax(s):
        m = jnp.maximum(jnp.max(s, axis=-1, keepdims=True), sink_b)
        p = jnp.exp(s - m)
        return p / (jnp.sum(p, axis=-1, keepdims=True) + jnp.exp(sink_b - m))

    def ctx_scores(q):
        return jnp.einsum('bqhgd,bkhd->bhgqk', q, kc).astype(jnp.float32) * scale

    kpad = jnp.pad(kl, ((0, 0), (BLOCK, BLOCK), (0, 0), (0, 0)))
    vpad = jnp.pad(vl, ((0, 0), (BLOCK, BLOCK), (0, 0), (0, 0)))
    offs = jnp.arange(3 * BLOCK) - BLOCK
    rel = offs[None, :] - jnp.arange(BLOCK)[:, None]
    band = jnp.abs(rel) <= WINDOW

    def block(i):
        start = i * BLOCK
        q_i = lax.dynamic_slice_in_dim(ql, start, BLOCK, axis=1)
        k_i = lax.dynamic_slice_in_dim(kpad, start, 3 * BLOCK, axis=1)
        v_i = lax.dynamic_slice_in_dim(vpad, start, 3 * BLOCK, axis=1)
        kpos = start + offs
        mask = band & ((kpos >= 0) & (kpos < N))[None, :]
        s_loc = jnp.einsum('bqhgd,bkhd->bhgqk', q_i, k_i).astype(jnp.float32) * scale
        s_loc = jnp.where(mask, s_loc, -jnp.inf)
        p = sink_softmax(jnp.concatenate([s_loc, ctx_scores(q_i)], axis=-1)).astype(v_i.dtype)
        return (jnp.einsum('bhgqk,bkhd->bqhgd', p[..., :3 * BLOCK], v_i)
                + jnp.einsum('bhgqk,bkhd->bqhgd', p[..., 3 * BLOCK:], vc))

    o_lat = lax.map(block, jnp.arange(N // BLOCK))
    o_lat = jnp.moveaxis(o_lat, 0, 1).reshape(B, N, dq) @ w_o
    o_ctx = None
    if need_ctx_out:
        p = sink_softmax(ctx_scores(qc)).astype(vc.dtype)
        o_ctx = jnp.einsum('bhgqk,bkhd->bqhgd', p, vc).reshape(B, L, dq) @ w_o
    return o_lat, o_ctx


def centred_depthwise_conv(x, w):
    K, C = w.shape
    return lax.conv_general_dilated(x, w.reshape(K, 1, C).astype(x.dtype), window_strides=(1,),
                                    padding=[(K // 2, K // 2)], dimension_numbers=('NWC', 'WIO', 'NWC'),
                                    feature_group_count=C)


def l2_normalise(t):
    tf = t.astype(jnp.float32)
    return tf * lax.rsqrt(jnp.sum(tf * tf, axis=-1, keepdims=True) + EPS)


def chunk_gated_delta(q, k, v, g, beta, s0):
    B, N, H, _ = q.shape
    dv = v.shape[-1]
    nc = N // CHUNK

    def chunks(t):
        return t.reshape(B, nc, CHUNK, H, -1).transpose(1, 0, 3, 2, 4)

    qc, kc, vc = chunks(q), chunks(k), chunks(v)
    gc = jnp.cumsum(g.reshape(B, nc, CHUNK, H).transpose(1, 0, 3, 2), axis=-1)
    bc = beta.reshape(B, nc, CHUNK, H).transpose(1, 0, 3, 2)[..., None]
    tril = jnp.tril(jnp.ones((CHUNK, CHUNK), bool))
    strict = jnp.tril(jnp.ones((CHUNK, CHUNK), bool), -1)
    diff = gc[..., :, None] - gc[..., None, :]
    decay = jnp.where(tril, jnp.exp(jnp.where(tril, diff, 0.0)), 0.0)
    kb = kc * bc
    a_mat = jnp.where(strict, jnp.einsum('nbhid,nbhjd->nbhij', kb, kc) * decay, 0.0)
    eye = jnp.broadcast_to(jnp.eye(CHUNK, dtype=a_mat.dtype), a_mat.shape)
    t_mat = lax.linalg.triangular_solve(eye + a_mat, eye, left_side=True, lower=True)
    u = t_mat @ (vc * bc)
    w = t_mat @ (kb * jnp.exp(gc)[..., None])
    qk = jnp.einsum('nbhid,nbhjd->nbhij', qc, kc) * decay

    def step(state, xs):
        q_i, k_i, u_i, w_i, qk_i, g_i = xs
        v_new = u_i - w_i @ state
        o_i = (q_i * jnp.exp(g_i)[..., None]) @ state + qk_i @ v_new
        g_last = g_i[..., -1:]
        state = state * jnp.exp(g_last)[..., None] + jnp.einsum(
            'bhcd,bhce->bhde', k_i * jnp.exp(g_last - g_i)[..., None], v_new)
        return state, o_i

    s_final, o = lax.scan(step, s0, (qc, kc, u, w, qk, gc))
    return o.transpose(1, 0, 3, 2, 4).reshape(B, N, H, dv), s_final


def gated_deltanet_bidir(h_lat, h_ctx, w_in, conv_w, a_log, dt_bias, o_norm, w_o, need_ctx_out):
    def project(h):
        B, N, _ = h.shape
        p = h @ w_in
        qkv = jax.nn.silu(centred_depthwise_conv(p[..., :3 * DN_WIDTH], conv_w))
        q, k, v = jnp.split(qkv, 3, axis=-1)
        q = l2_normalise(q.reshape(B, N, DN_HEADS, DN_DK)) * (DN_DK ** -0.5)
        k = l2_normalise(k.reshape(B, N, DN_HEADS, DN_DK))
        v = v.reshape(B, N, DN_HEADS, DN_DV).astype(jnp.float32)
        z = p[..., 3 * DN_WIDTH:4 * DN_WIDTH]
        a = p[..., 4 * DN_WIDTH:4 * DN_WIDTH + 2 * DN_HEADS].astype(jnp.float32).reshape(B, N, 2, DN_HEADS)
        b = p[..., 4 * DN_WIDTH + 2 * DN_HEADS:].astype(jnp.float32).reshape(B, N, 2, DN_HEADS)
        g = -jnp.exp(a_log.astype(jnp.float32)) * jax.nn.softplus(a + dt_bias.astype(jnp.float32))
        beta = jax.nn.sigmoid(b)
        return q, k, v, z, g, beta

    ql, kl, vl, zl, gl, bl = project(h_lat)
    qc, kc, vc, zc, gc, bc = project(h_ctx)
    s0 = jnp.zeros((h_lat.shape[0], DN_HEADS, DN_DK, DN_DV), jnp.float32)

    def flip(t):
        return jnp.flip(t, axis=1)

    oc_f, sc_f = chunk_gated_delta(qc, kc, vc, gc[:, :, 0], bc[:, :, 0], s0)
    ol_f, _ = chunk_gated_delta(ql, kl, vl, gl[:, :, 0], bl[:, :, 0], sc_f)
    oc_b, sc_b = chunk_gated_delta(flip(qc), flip(kc), flip(vc), flip(gc[:, :, 1]), flip(bc[:, :, 1]), s0)
    ol_b, _ = chunk_gated_delta(flip(ql), flip(kl), flip(vl), flip(gl[:, :, 1]), flip(bl[:, :, 1]), sc_b)

    def readout(o, z):
        B, N = o.shape[:2]
        o = o * lax.rsqrt(jnp.mean(o * o, axis=-1, keepdims=True) + EPS) * o_norm.astype(jnp.float32)
        o = o.astype(z.dtype) * jax.nn.silu(z).reshape(B, N, DN_HEADS, DN_DV)
        return o.reshape(B, N, DN_WIDTH) @ w_o

    o_lat = readout(ol_f + flip(ol_b), zl)
    o_ctx = readout(oc_f + flip(oc_b), zc) if need_ctx_out else None
    return o_lat, o_ctx


def expert_choice_moe(h, w_router, w_gate, w_up, w_down):
    B, N, D = h.shape
    cap = CAPACITY_FACTOR * N // N_EXPERTS
    aff = jax.nn.softmax((h @ w_router).astype(jnp.float32), axis=-1)
    gates, idx = lax.top_k(jnp.swapaxes(aff, 1, 2), cap)
    xs = jax.vmap(lambda hb, ib: hb[ib])(h, idx)
    hid = jax.nn.silu(jnp.einsum('becd,edf->becf', xs, w_gate)) * jnp.einsum('becd,edf->becf', xs, w_up)
    y = jnp.einsum('becf,efd->becd', hid, w_down) * gates[..., None].astype(h.dtype)
    return jax.vmap(lambda ib, yb: jnp.zeros((N, D), h.dtype).at[ib.reshape(-1)].add(yb.reshape(-1, D)))(idx, y)


def setup_inputs(seed: int = 0) -> dict:
    key = jax.random.key(seed)
    ks = jax.random.split(key, 30)
    D = D_MODEL

    def nrm(i, shape, scale):
        return jax.random.normal(ks[i], shape, jnp.float32) * scale

    def gain(i, n):
        return 1.0 + nrm(i, (n,), 0.02)

    a_log = jnp.log(jax.random.uniform(ks[20], (2, DN_HEADS), jnp.float32, minval=1.0, maxval=16.0))
    dt = jnp.exp(jax.random.uniform(ks[21], (2, DN_HEADS), jnp.float32,
                                    minval=math.log(1e-3), maxval=math.log(1e-1)))
    dt_bias = dt + jnp.log(-jnp.expm1(-dt))
    return {
        'x': nrm(0, (BATCH, SEQ, D), 1.0),
        'c': nrm(1, (BATCH, D), 1.0),
        'ctx': nrm(2, (BATCH, CTX_LEN, D), 1.0),
        'c_ctx': nrm(3, (D,), 1.0),
        'l0_ada_w': nrm(4, (D, 6 * D), ADA_SCALE * D ** -0.5),
        'l0_ada_b': nrm(5, (6 * D,), 0.02),
        'l0_norm_mix': gain(6, D),
        'l0_w_qkv': nrm(7, (D, (N_Q_HEADS + 2 * N_KV_HEADS) * HEAD_DIM), D ** -0.5),
        'l0_sink': nrm(8, (N_Q_HEADS,), 0.5),
        'l0_w_o': nrm(9, (N_Q_HEADS * HEAD_DIM, D), (N_Q_HEADS * HEAD_DIM) ** -0.5),
        'l0_norm_ffn': gain(10, D),
        'l0_router': nrm(11, (D, N_EXPERTS), D ** -0.5),
        'l0_w_gate': nrm(12, (N_EXPERTS, D, EXPERT_FF), D ** -0.5),
        'l0_w_up': nrm(13, (N_EXPERTS, D, EXPERT_FF), D ** -0.5),
        'l0_w_down': nrm(14, (N_EXPERTS, EXPERT_FF, D), EXPERT_FF ** -0.5),
        'l1_ada_w': nrm(15, (D, 6 * D), ADA_SCALE * D ** -0.5),
        'l1_ada_b': nrm(16, (6 * D,), 0.02),
        'l1_norm_mix': gain(17, D),
        'l1_w_in': nrm(18, (D, 4 * DN_WIDTH + 4 * DN_HEADS), D ** -0.5),
        'l1_conv': nrm(19, (CONV_K, 3 * DN_WIDTH), CONV_K ** -0.5),
        'l1_a_log': a_log,
        'l1_dt_bias': dt_bias,
        'l1_o_norm': gain(22, DN_DV),
        'l1_w_o': nrm(23, (DN_WIDTH, D), DN_WIDTH ** -0.5),
        'l1_norm_ffn': gain(24, D),
        'l1_router': nrm(25, (D, N_EXPERTS), D ** -0.5),
        'l1_w_gate': nrm(26, (N_EXPERTS, D, EXPERT_FF), D ** -0.5),
        'l1_w_up': nrm(27, (N_EXPERTS, D, EXPERT_FF), D ** -0.5),
        'l1_w_down': nrm(28, (N_EXPERTS, EXPERT_FF, D), EXPERT_FF ** -0.5),
        'final_norm': gain(29, D),
    }


def reference(x, c, ctx, c_ctx,
              l0_ada_w, l0_ada_b, l0_norm_mix, l0_w_qkv, l0_sink, l0_w_o, l0_norm_ffn,
              l0_router, l0_w_gate, l0_w_up, l0_w_down,
              l1_ada_w, l1_ada_b, l1_norm_mix, l1_w_in, l1_conv, l1_a_log, l1_dt_bias, l1_o_norm, l1_w_o,
              l1_norm_ffn, l1_router, l1_w_gate, l1_w_up, l1_w_down,
              final_norm):
    layer_params = (
        ((l0_ada_w, l0_ada_b, l0_norm_mix, l0_norm_ffn, l0_router, l0_w_gate, l0_w_up, l0_w_down),
         (l0_w_qkv, l0_sink, l0_w_o)),
        ((l1_ada_w, l1_ada_b, l1_norm_mix, l1_norm_ffn, l1_router, l1_w_gate, l1_w_up, l1_w_down),
         (l1_w_in, l1_conv, l1_a_log, l1_dt_bias, l1_o_norm, l1_w_o)),
    )
    x_lat, x_ctx = x, ctx
    for i in range(DEPTH):
        (ada_w, ada_b, norm_mix, norm_ffn, router, w_gate, w_up, w_down), mix_params = layer_params[i]
        last = i == DEPTH - 1
        sh1, sc1, gt1, sh2, sc2, gt2 = [t[:, None, :] for t in ada_modulation(c, ada_w, ada_b)]
        csh1, csc1, cgt1, csh2, csc2, cgt2 = ada_modulation(c_ctx, ada_w, ada_b)
        h_lat = modulate(x_lat, norm_mix, sh1, sc1)
        h_ctx = modulate(x_ctx, norm_mix, csh1, csc1)
        if i % N_MIXERS == 0:
            m_lat, m_ctx = window_sink_attention(h_lat, h_ctx, *mix_params, need_ctx_out=not last)
        else:
            m_lat, m_ctx = gated_deltanet_bidir(h_lat, h_ctx, *mix_params, need_ctx_out=not last)
        x_lat = x_lat + gt1 * m_lat
        x_lat = x_lat + gt2 * expert_choice_moe(modulate(x_lat, norm_ffn, sh2, sc2), router, w_gate, w_up, w_down)
        if not last:
            x_ctx = x_ctx + cgt1 * m_ctx
            x_ctx = x_ctx + cgt2 * expert_choice_moe(modulate(x_ctx, norm_ffn, csh2, csc2),
                                                     router, w_gate, w_up, w_down)
    return rms_norm(x_lat, final_norm)
```

```cpp
#include <hip/hip_runtime.h>
#include <cstdio>
#include <cstdint>
#define MK_ONE_LAUNCH 1
namespace pg8 {
#define PG8_LAS __attribute__((address_space(3)))
typedef unsigned short bf16_t;
typedef short bf16x8 __attribute__((ext_vector_type(8)));
typedef float f32x4 __attribute__((ext_vector_type(4)));
typedef unsigned u32x4 __attribute__((ext_vector_type(4)));
constexpr int BM = 256, BK = 64, HALF = 128, HTB = HALF * BK * 2  , STAGE_BYTES = 8 * HTB, NXCD = 8, WGM = 8;

__host__ __device__ __forceinline__ int lds_byte(int r, int c) { const int st = (r >> 4) * 2 + (c >> 5), rr = r & 15, cc = c & 31, ob = rr * 64 + cc * 2; return st * 1024 + (ob ^ (((ob >> 9) & 1) << 5)); }
__host__ __device__ __forceinline__ void stage_rc(int b, int& R, int& C) { const int st = b / 1024, sb = b % 1024, swz = sb ^ (((sb >> 9) & 1) << 5); R = (st >> 1) * 16 + swz / 64; C = (st & 1) * 32 + (swz % 64) / 2; }
__host__ __device__ __forceinline__ int perm32(int rho) { const int n = rho >> 4, i = rho & 15; return 8 * (i >> 2) + 4 * n + (i & 3); }

struct Unit { int pm, pn; };
struct Gemm { const bf16_t* A; const bf16_t* Bt; int M, N, K; };

struct StaticOrder {
    int nM, nN, nwg, G, c;
    __host__ __device__ void init(int M, int N, int G_, int c_) { nM = M / BM; nN = N / BM; nwg = nM * nN; G = G_; c = c_; }
    __host__ __device__ bool next(int i, Unit& u) const {
        const long L = (long)i * G + c; if (L >= nwg) return false;
        int wgid = (int)L; { const int q = nwg / NXCD, r = nwg % NXCD, xcd = wgid % NXCD, off = wgid / NXCD; wgid = (xcd < r ? xcd * (q + 1) : r * (q + 1) + (xcd - r) * q) + off; }
        const int nig = WGM * nN, gid = wgid / nig, fm = gid * WGM, gsz = (nM - fm) < WGM ? (nM - fm) : WGM;
        u.pm = fm + ((wgid % nig) % gsz); u.pn = (wgid % nig) / gsz; return true;
    }
    __device__ __forceinline__ void a_ready(const Unit&) const {}
    __device__ __forceinline__ void done(const Unit&) const {}
    __device__ __forceinline__ const char* aptr(const Gemm& g, const Unit& u, size_t tstep) const { return (const char*)g.A + (size_t)u.pm * tstep; }
    __device__ __forceinline__ const char* bptr(const Gemm& g, const Unit& u, size_t tstep) const { return (const char*)g.Bt + (size_t)u.pn * tstep; }
};

__device__ __forceinline__ unsigned cvt_pk_bf16(float lo, float hi) { unsigned r; asm volatile("v_cvt_pk_bf16_f32 %0, %1, %2" : "=v"(r) : "v"(lo), "v"(hi)); return r; }
typedef int v8i32 __attribute__((ext_vector_type(8)));
__device__ __forceinline__ v8i32 ld8(const PG8_LAS unsigned char* p) { typedef int v4i __attribute__((ext_vector_type(4))); const v4i x = *(const PG8_LAS v4i*)p, y = *(const PG8_LAS v4i*)(p + 1024); return (v8i32){x[0], x[1], x[2], x[3], y[0], y[1], y[2], y[3]}; }
__device__ __forceinline__ void mfma8(f32x4& acc, const v8i32& a, const v8i32& b, int sc) { asm volatile("v_mfma_scale_f32_16x16x128_f8f6f4 %0, %1, %2, %0, %3, %3 op_sel_hi:[0,0,0]" : "+v"(acc) : "v"(a), "v"(b), "v"(sc)); }
template <class Epi, class Sched, bool ALIGN_EPI = false, bool SP2 = false, bool FP8 = false>
__device__ __forceinline__ void gemm_phase(PG8_LAS unsigned char* lds, const Gemm g, const Sched& S, const Epi& E) {
    const int tid = threadIdx.x, wid = __builtin_amdgcn_readfirstlane(tid >> 6), lane = tid & 63, wr = wid >> 2, wc = wid & 3, fr = lane & 15, fq = lane >> 4;
    const int K = g.K, nt = K / BK;
    unsigned voffA[2], voffB[2];
#pragma unroll
    for (int i = 0; i < 2; ++i) { int R, C; stage_rc(tid * 16 + i * 8192, R, C); const int Rb = Epi::PERM ? ((R & ~31) + perm32(R & 31)) : R;
        voffA[i] = (unsigned)(R * K + C) * 2u; voffB[i] = (unsigned)(Rb * K + C) * 2u; }
    const size_t kstep = (size_t)(BK * 2);
    const size_t hstep = (size_t)HALF * K * 2;
    const size_t tstep = 2 * hstep;
    const unsigned ldsw = (unsigned)wid * 1024u;
    const int aoff = lds_byte(wr * 64 + fr, fq * 8), boff = lds_byte(wc * 32 + fr, fq * 8);
#define PG8_SA(b, h) (((b) * 2 + (h)) * HTB)
#define PG8_SB(b, h) ((4 + (b) * 2 + (h)) * HTB)
#define PG8_STAGE(bufoff, gbase, voff) do { _Pragma("unroll") for (int _i = 0; _i < 2; ++_i) \
        __builtin_amdgcn_global_load_lds((const unsigned*)((const char*)(gbase) + (voff)[_i]), (PG8_LAS unsigned*)(lds + (bufoff) + ldsw + _i * 8192), 16, 0, 0); } while (0)
#define PG8_LDA(dst, b, h) do { if constexpr (FP8) { _Pragma("unroll") for (int m = 0; m < 4; ++m) dst##8[m] = ld8(lds + PG8_SA(b, h) + aoff + m * 2048); } else { \
        _Pragma("unroll") for (int m = 0; m < 4; ++m) _Pragma("unroll") for (int k = 0; k < 2; ++k) dst[m][k] = *(const PG8_LAS bf16x8*)(lds + PG8_SA(b, h) + aoff + m * 2048 + k * 1024); } } while (0)
#define PG8_LDB(dst, b, h) do { if constexpr (FP8) { _Pragma("unroll") for (int n = 0; n < 2; ++n) dst##8[n] = ld8(lds + PG8_SB(b, h) + boff + n * 2048); } else { \
        _Pragma("unroll") for (int n = 0; n < 2; ++n) _Pragma("unroll") for (int k = 0; k < 2; ++k) dst[n][k] = *(const PG8_LAS bf16x8*)(lds + PG8_SB(b, h) + boff + n * 2048 + k * 1024); } } while (0)
#define PG8_MMA(ai, bj, At, Bt) do { if constexpr (FP8) __builtin_amdgcn_sched_barrier(0); __builtin_amdgcn_s_setprio(1); if constexpr (FP8) { _Pragma("unroll") for (int m = 0; m < 4; ++m) _Pragma("unroll") for (int n = 0; n < 2; ++n) \
        mfma8(acc[ai][bj][m][n], Bt##8[n], At##8[m], sc8); } else { \
        _Pragma("unroll") for (int m = 0; m < 4; ++m) _Pragma("unroll") for (int n = 0; n < 2; ++n) _Pragma("unroll") for (int k = 0; k < 2; ++k) \
        acc[ai][bj][m][n] = __builtin_amdgcn_mfma_f32_16x16x32_bf16(Bt[n][k], At[m][k], acc[ai][bj][m][n], 0, 0, 0); } __builtin_amdgcn_s_setprio(0); if constexpr (FP8) __builtin_amdgcn_sched_barrier(0); } while (0)
#define PG8_WAIT_V(n) asm volatile("s_waitcnt vmcnt(" #n ")" ::: "memory")
#define PG8_WAIT_L(n) asm volatile("s_waitcnt lgkmcnt(" #n ")" ::: "memory")
#define PG8_BAR __builtin_amdgcn_s_barrier()
#define PG8_SCHED __builtin_amdgcn_sched_barrier(0)
    Unit cur, nxt; int ui = 0;
    if (!S.next(0, cur)) return;
    f32x4 acc[2][2][4][2];
#pragma unroll
    for (int a = 0; a < 2; ++a)
#pragma unroll
        for (int b = 0; b < 2; ++b)
#pragma unroll
            for (int m = 0; m < 4; ++m)
#pragma unroll
                for (int n = 0; n < 2; ++n) acc[a][b][m][n] = (f32x4){0.f, 0.f, 0.f, 0.f};
    bf16x8 At[4][2], B0[2][2], B1[2][2]; v8i32 At8[4], B08[2], B18[2]; int sc8 = 0x7f7f7f7f; asm volatile("" : "+v"(sc8));
    const char* cA = S.aptr(g, cur, tstep); const char* cB = S.bptr(g, cur, tstep);
    S.a_ready(cur);
    if constexpr (SP2) {
        PG8_STAGE(PG8_SB(0, 0), cB, voffB); PG8_STAGE(PG8_SB(0, 1), cB + hstep, voffB); PG8_STAGE(PG8_SA(0, 0), cA, voffA); PG8_STAGE(PG8_SA(0, 1), cA + hstep, voffA);
        if (wr == 1) PG8_BAR;
        PG8_WAIT_V(2); PG8_BAR;
        PG8_STAGE(PG8_SB(1, 0), cB + kstep, voffB); PG8_STAGE(PG8_SA(1, 0), cA + kstep, voffA); PG8_STAGE(PG8_SB(1, 1), cB + hstep + kstep, voffB);
        PG8_WAIT_V(6); PG8_BAR;
    } else {
        PG8_STAGE(PG8_SB(0, 0), cB, voffB); PG8_STAGE(PG8_SA(0, 0), cA, voffA); PG8_STAGE(PG8_SB(0, 1), cB + hstep, voffB); PG8_STAGE(PG8_SA(0, 1), cA + hstep, voffA);
        if (wr == 1) PG8_BAR;
        PG8_WAIT_V(4); PG8_BAR;
        PG8_STAGE(PG8_SB(1, 0), cB + kstep, voffB); PG8_STAGE(PG8_SA(1, 0), cA + kstep, voffA); PG8_STAGE(PG8_SB(1, 1), cB + hstep + kstep, voffB);
        PG8_WAIT_V(6); PG8_BAR;
    }
    for (;;) {
        const bool has_next = S.next(ui + 1, nxt);
        const char* nA = has_next ? S.aptr(g, nxt, tstep) : cA; const char* nB = has_next ? S.bptr(g, nxt, tstep) : cB;
#pragma unroll 1
        for (int t = 0; t < nt; t += 2) {
            const bool last = (t == nt - 2);
            const char* a1 = cA + (size_t)(t + 1) * kstep;
            const char* a2 = last ? nA : cA + (size_t)(t + 2) * kstep; const char* b2 = last ? nB : cB + (size_t)(t + 2) * kstep;
            const char* a3 = a2 + kstep; const char* b3 = b2 + kstep;
            if (last && has_next) S.a_ready(nxt);
            if constexpr (SP2) {
            PG8_LDB(B0, 0, 0); PG8_LDB(B1, 0, 1); PG8_SCHED; PG8_LDA(At, 0, 0); PG8_STAGE(PG8_SA(1, 1), a1 + hstep, voffA);
            PG8_WAIT_V(8); PG8_WAIT_L(0); PG8_BAR; PG8_MMA(0, 0, At, B0); PG8_MMA(0, 1, At, B1); PG8_BAR; PG8_SCHED;
            PG8_LDA(At, 0, 1); PG8_STAGE(PG8_SB(0, 0), b2, voffB); PG8_STAGE(PG8_SB(0, 1), b2 + hstep, voffB); PG8_STAGE(PG8_SA(0, 0), a2, voffA);
            PG8_WAIT_V(8); PG8_WAIT_L(0); PG8_BAR; PG8_MMA(1, 0, At, B0); PG8_MMA(1, 1, At, B1); PG8_BAR; PG8_SCHED;
            PG8_LDB(B0, 1, 0); PG8_LDB(B1, 1, 1); PG8_SCHED; PG8_LDA(At, 1, 0); PG8_STAGE(PG8_SA(0, 1), a2 + hstep, voffA);
            PG8_WAIT_V(8); PG8_WAIT_L(0); PG8_BAR; PG8_MMA(0, 0, At, B0); PG8_MMA(0, 1, At, B1); PG8_BAR; PG8_SCHED;
            PG8_LDA(At, 1, 1); PG8_STAGE(PG8_SB(1, 0), b3, voffB); PG8_STAGE(PG8_SB(1, 1), b3 + hstep, voffB); PG8_STAGE(PG8_SA(1, 0), a3, voffA);
            PG8_WAIT_V(8); PG8_WAIT_L(0); PG8_BAR; PG8_MMA(1, 0, At, B0); PG8_MMA(1, 1, At, B1); PG8_BAR; PG8_SCHED;
            } else {
            PG8_LDB(B0, 0, 0); PG8_SCHED; PG8_LDA(At, 0, 0); PG8_STAGE(PG8_SA(1, 1), a1 + hstep, voffA);
            PG8_WAIT_L(8); PG8_BAR; PG8_WAIT_L(0); PG8_MMA(0, 0, At, B0); PG8_BAR; PG8_SCHED;
            PG8_LDB(B1, 0, 1); PG8_STAGE(PG8_SB(0, 0), b2, voffB);
            PG8_BAR; PG8_WAIT_L(0); PG8_MMA(0, 1, At, B1); PG8_BAR;
            PG8_LDA(At, 0, 1); PG8_STAGE(PG8_SA(0, 0), a2, voffA);
            PG8_BAR; PG8_WAIT_L(0); PG8_MMA(1, 0, At, B0); PG8_BAR; PG8_SCHED;
            PG8_STAGE(PG8_SB(0, 1), b2 + hstep, voffB);
            PG8_WAIT_V(6); PG8_BAR; PG8_MMA(1, 1, At, B1); PG8_BAR;
            PG8_LDB(B0, 1, 0); PG8_SCHED; PG8_LDA(At, 1, 0); PG8_STAGE(PG8_SA(0, 1), a2 + hstep, voffA);
            PG8_WAIT_L(8); PG8_BAR; PG8_WAIT_L(0); PG8_MMA(0, 0, At, B0); PG8_BAR; PG8_SCHED;
            PG8_LDB(B1, 1, 1); PG8_STAGE(PG8_SB(1, 0), b3, voffB);
            PG8_BAR; PG8_WAIT_L(0); PG8_MMA(0, 1, At, B1); PG8_BAR;
            PG8_LDA(At, 1, 1); PG8_STAGE(PG8_SA(1, 0), a3, voffA);
            PG8_BAR; PG8_WAIT_L(0); PG8_MMA(1, 0, At, B0); PG8_BAR; PG8_SCHED;
            PG8_STAGE(PG8_SB(1, 1), b3 + hstep, voffB);
            PG8_WAIT_V(6); PG8_BAR; PG8_MMA(1, 1, At, B1); PG8_BAR;
            }
        }
        if constexpr (FP8) asm volatile("s_nop 15\n\ts_nop 15" ::: "memory");
        if constexpr (ALIGN_EPI) { if (wr == 0) PG8_BAR; }
        if constexpr (!Epi::AFTER_DRAIN) { E(acc, cur, wr, wc, fr, fq); S.done(cur); }
        if (!has_next) break;
#pragma unroll
        for (int a = 0; a < 2; ++a)
#pragma unroll
            for (int b = 0; b < 2; ++b)
#pragma unroll
                for (int m = 0; m < 4; ++m)
#pragma unroll
                    for (int n = 0; n < 2; ++n) acc[a][b][m][n] = (f32x4){0.f, 0.f, 0.f, 0.f};
        cur = nxt; cA = nA; cB = nB; ++ui;
        if constexpr (ALIGN_EPI) { if (wr == 1) PG8_BAR; }
    }
    PG8_WAIT_V(0);
    if constexpr (!ALIGN_EPI) { if (wr == 0) PG8_BAR; }
    PG8_BAR;
    if constexpr (Epi::AFTER_DRAIN) { E.fused(acc, cur, wr, wc, fr, fq, lds, wid, lane); S.done(cur); }
#undef PG8_SA
#undef PG8_SB
#undef PG8_STAGE
#undef PG8_LDA
#undef PG8_LDB
#undef PG8_MMA
#undef PG8_WAIT_V
#undef PG8_WAIT_L
#undef PG8_BAR
#undef PG8_SCHED
}
}

constexpr int D = 1024, NB = 8, SEQ = 4096, CTXL = 256;
constexpr int MLAT = NB * SEQ, MCTX = NB * CTXL, MTOT = MLAT + MCTX;
constexpr int NE = 16, FF = 2048, CAPL = 512, CAPC = 32;
constexpr int EROWS0 = NB * (CAPL + CAPC);
constexpr int EROWS1 = NB * CAPL;
constexpr int NQKV = 1536, NWIN = 4096, LDWIN = 4128;
constexpr float EPS = 1e-6f;
constexpr int NWAVES = 8, NTHR = 512;
constexpr int NPH = 21;

constexpr size_t MiB = 1u << 20;
constexpr size_t WS_CTL = 0, CTL_ZERO_BYTES = 1 * MiB;
constexpr size_t WS_MOD = 1 * MiB;
constexpr size_t WS_ROPE = 1 * MiB + 512 * 1024;
constexpr size_t WS_WQKV = 2 * MiB, WS_WO0 = 5 * MiB, WS_WIN = 7 * MiB, WS_WO1 = 15 * MiB;
constexpr size_t WS_WGU = 17 * MiB, WS_WD = 81 * MiB, WS_WGU1 = 113 * MiB, WS_WD1 = 177 * MiB;
constexpr size_t WS_XRES = 209 * MiB;
constexpr size_t WS_H = 345 * MiB;
constexpr size_t WS_H8 = WS_H;
constexpr size_t WS_AFF = 413 * MiB;
constexpr size_t WS_GW = 416 * MiB;
constexpr size_t WS_SLOT = 417 * MiB;
constexpr size_t WS_G = 420 * MiB, WS_BETA = 423 * MiB;
constexpr size_t WS_R = 427 * MiB;
constexpr size_t WS_Q = WS_R, WS_K = WS_R + 68 * MiB, WS_V = WS_R + 85 * MiB, WS_ATT = WS_R + 102 * MiB;
constexpr size_t WS_XG = WS_R, WS_HID = WS_R + 136 * MiB;
constexpr size_t WS_PQKV = WS_R, WS_Z = WS_R + 204 * MiB, WS_QN = WS_R + 272 * MiB, WS_KN = WS_R + 340 * MiB, WS_VV = WS_R + 408 * MiB;
constexpr size_t WS_TB = WS_R, WS_TG = WS_R + 68 * MiB, WS_QKD = WS_R + 136 * MiB, WS_GC = WS_AFF;
constexpr size_t WS_RO = WS_R;
constexpr size_t WS_END = WS_R + 476 * MiB;
constexpr int CW_BAR = 4096;

constexpr int RING_BYTES = 131072;
constexpr int LDSCTL_OFF = RING_BYTES, MISC_OFF = LDSCTL_OFF + 320;
constexpr int LDS_BYTES = 147456;

#define GAS __attribute__((address_space(1)))
#define LAS __attribute__((address_space(3)))
typedef unsigned short bf16;
typedef unsigned v4u __attribute__((ext_vector_type(4)));
typedef unsigned v2u __attribute__((ext_vector_type(2)));
typedef float f32x4 __attribute__((ext_vector_type(4)));
typedef short bf16x8 __attribute__((ext_vector_type(8)));
typedef GAS unsigned gu32;
typedef GAS unsigned long long gu64;
#define RLX_AGENT __ATOMIC_RELAXED, __HIP_MEMORY_SCOPE_AGENT
#define LDS_WAIT() asm volatile("s_waitcnt lgkmcnt(0)" ::: "memory")
#define VM_WAIT() asm volatile("s_waitcnt vmcnt(0)" ::: "memory")

#define XB_TMO      128
#define XB_XCNT(j)  (256  + 64 * (j))
#define XB_XSUB(j)  (1280 + 64 * (j))
#define XB_XGEN(j)  (2304 + 64 * (j))
#define XB_TOP      3328
#define XB_TOPGEN   3392
#define XCD_BAR_WORDS 3456
#define XB_SPIN_CAP (1u << 18)

__device__ __forceinline__ unsigned xb_ld(unsigned* p)              { return __hip_atomic_load(p, __ATOMIC_RELAXED, __HIP_MEMORY_SCOPE_AGENT); }
__device__ __forceinline__ unsigned xb_add(unsigned* p, unsigned v) { return __hip_atomic_fetch_add(p, v, __ATOMIC_RELAXED, __HIP_MEMORY_SCOPE_AGENT); }
__device__ __forceinline__ unsigned xb_xcc_id() { return (unsigned)__builtin_amdgcn_s_getreg((3 << 11) | 20) & 0xFu; }
#define XB_SPIN(cond, bar) do { unsigned _sp = 0; while (cond) { __builtin_amdgcn_s_sleep(1); \
    if ((++_sp & 255u) == 0u) { if (xb_ld(&(bar)[XB_TMO])) break; if (_sp > XB_SPIN_CAP) { atomicAdd(&(bar)[XB_TMO], 1u); break; } } } } while (0)

struct XcdBarrier {
    unsigned* bar; unsigned x;
    volatile LAS unsigned* st;
};

__device__ __forceinline__ XcdBarrier xcd_barrier_post(unsigned* bar, volatile LAS unsigned* st) {
    XcdBarrier b; b.bar = bar; b.x = xb_xcc_id(); b.st = st;
    if (threadIdx.x == 0) (void)xb_add(&bar[XB_XCNT(b.x)], 1u);
    return b;
}
__device__ __forceinline__ void xcd_barrier_complete(unsigned* bar, unsigned x, unsigned& nloc, unsigned& nx) {
    const unsigned G = gridDim.x * gridDim.y * gridDim.z;
    unsigned sum, cnt, mine, sp = 0u;
    for (;;) {
        sum = 0u; cnt = 0u; mine = 0u;
#pragma unroll
        for (unsigned j = 0; j < 16; ++j) { const unsigned c = xb_ld(&bar[XB_XCNT(j)]); sum += c; cnt += (c > 0u) ? 1u : 0u; mine = (j == x) ? c : mine; }
        if (sum == G) break;
        __builtin_amdgcn_s_sleep(1);
        if ((++sp & 255u) == 0u) { if (xb_ld(&bar[XB_TMO])) break; if (sp > XB_SPIN_CAP) { atomicAdd(&bar[XB_TMO], 1u); break; } }
    }
    nloc = mine > 0u ? mine : 1u; nx = cnt > 0u ? cnt : 1u;
}

__device__ __forceinline__ void xcd_barrier(const XcdBarrier& b) {
    asm volatile("s_waitcnt vmcnt(0)" ::: "memory");
    __syncthreads();
    if (threadIdx.x == 0) {
        unsigned* bar = b.bar;
        __builtin_amdgcn_s_waitcnt(0);
        unsigned nloc = b.st[0], nx = b.st[1];
        if (nloc == 0u) { xcd_barrier_complete(bar, b.x, nloc, nx); b.st[0] = nloc; b.st[1] = nx; }
        const unsigned old = xb_add(&bar[XB_XSUB(b.x)], 1u);
        const unsigned gen = old / nloc;
        if (old + 1u == (gen + 1u) * nloc) {
            __builtin_amdgcn_fence(__ATOMIC_RELEASE, "agent");
            asm volatile("s_waitcnt vmcnt(0)" ::: "memory");
            const unsigned og = xb_add(&bar[XB_TOP], 1u);
            const unsigned tg = og / nx;
            if (og + 1u == (tg + 1u) * nx) xb_add(&bar[XB_TOPGEN], 1u);
            else XB_SPIN(xb_ld(&bar[XB_TOPGEN]) == tg, bar);
            __builtin_amdgcn_fence(__ATOMIC_ACQUIRE, "agent");
            xb_add(&bar[XB_XGEN(b.x)], 1u);
            asm volatile("s_waitcnt vmcnt(0)" ::: "memory");
        } else {
            XB_SPIN(xb_ld(&bar[XB_XGEN(b.x)]) == gen, bar);
            __builtin_amdgcn_fence(__ATOMIC_ACQUIRE, "agent");
            asm volatile("s_waitcnt vmcnt(0)" ::: "memory");
        }
    }
    __syncthreads();
}

struct Args { const float* in[30]; float* out; unsigned char* ws; int ph_lo, ph_hi; };
struct Frame { LAS unsigned char* lds; volatile LAS unsigned* MISC; int tid, lane, wave, vcu, G; };

__device__ __forceinline__ float wave_sum(float v) {
#pragma unroll
    for (int o = 1; o < 64; o <<= 1) v += __shfl_xor(v, o);
    return v;
}
template <int N> __device__ __forceinline__ float fold_sum(float (&p)[N], int lane) {
    int o = 32;
#pragma unroll
    for (int n = N; n > 1; n >>= 1) { const unsigned um = (lane & o) ? 0xffffffffu : 0u;
#pragma unroll
        for (int k = 0; k < n / 2; ++k) { const unsigned a = __float_as_uint(p[k]), b = __float_as_uint(p[k + n / 2]);
            const float send = __uint_as_float((a & um) | (b & ~um)), keep = __uint_as_float((b & um) | (a & ~um)); p[k] = keep + __shfl_xor(send, o); }
        o >>= 1; }
    float v = p[0];
#pragma unroll
    for (int oo = 32; oo >= 1; oo >>= 1) if (oo <= o) v += __shfl_xor(v, oo);
    return v;
}
__device__ __forceinline__ float proj16(const f32x4 (&v)[4], const LAS float* w16, int lane) {
    float pj[16];
#pragma unroll
    for (int e = 0; e < 16; ++e) { float s = 0.f;
#pragma unroll
        for (int j = 0; j < 4; ++j) { const f32x4 w = ((const LAS f32x4*)(w16 + e * 1024))[lane + 64 * j]; s += (v[j].x * w.x + v[j].y * w.y) + (v[j].z * w.z + v[j].w * w.w); }
        pj[e] = s; }
    return fold_sum<16>(pj, lane);
}
template <int R> __device__ __forceinline__ void proj16xR(const f32x4 (&v)[R][4], const LAS float* w16, int lane, float (&out)[R]) {
    float p[R][16];
#pragma unroll
    for (int e = 0; e < 16; ++e) { float s[R];
#pragma unroll
        for (int t = 0; t < R; ++t) s[t] = 0.f;
#pragma unroll
        for (int j = 0; j < 4; ++j) { const f32x4 w = ((const LAS f32x4*)(w16 + e * 1024))[lane + 64 * j];
#pragma unroll
            for (int t = 0; t < R; ++t) s[t] += (v[t][j].x * w.x + v[t][j].y * w.y) + (v[t][j].z * w.z + v[t][j].w * w.w); }
#pragma unroll
        for (int t = 0; t < R; ++t) p[t][e] = s[t]; }
#pragma unroll
    for (int t = 0; t < R; ++t) out[t] = fold_sum<16>(p[t], lane);
}
__device__ __forceinline__ void proj16x2(const f32x4 (&v0)[4], const f32x4 (&v1)[4], const LAS float* w16, int lane, float& r0, float& r1) {
    float p0[16], p1[16];
#pragma unroll
    for (int e = 0; e < 16; ++e) { float s0 = 0.f, s1 = 0.f;
#pragma unroll
        for (int j = 0; j < 4; ++j) { const f32x4 w = ((const LAS f32x4*)(w16 + e * 1024))[lane + 64 * j];
            s0 += (v0[j].x * w.x + v0[j].y * w.y) + (v0[j].z * w.z + v0[j].w * w.w); s1 += (v1[j].x * w.x + v1[j].y * w.y) + (v1[j].z * w.z + v1[j].w * w.w); }
        p0[e] = s0; p1[e] = s1; }
    r0 = fold_sum<16>(p0, lane); r1 = fold_sum<16>(p1, lane);
}
__device__ __forceinline__ float bflo(unsigned w) { return __uint_as_float(w << 16); }
__device__ __forceinline__ float bfhi(unsigned w) { return __uint_as_float(w & 0xffff0000u); }
__device__ __forceinline__ unsigned pkbf(float lo, float hi) { return pg8::cvt_pk_bf16(lo, hi); }
__device__ __forceinline__ float silu_f(float x) { return x * __builtin_amdgcn_rcpf(1.f + __expf(-x)); }
__device__ __forceinline__ unsigned pk4f8(float a, float b, float c, float d) { int v = __builtin_amdgcn_cvt_pk_fp8_f32(a, b, 0, false); v = __builtin_amdgcn_cvt_pk_fp8_f32(c, d, v, true); return (unsigned)v; }
constexpr float W8S = 64.f, W8I = 1.f / 64.f;
__device__ __forceinline__ int modrow(int m) { return m < MLAT ? (m >> 12) : 8; }

__device__ __forceinline__ void tr_item(const float* W, size_t ldw, int k0, size_t srccol0, bool permq, bf16* WT, size_t K, size_t dstrow0, LAS float* scr, int lane) {
    const int nl = lane & 31;
    size_t col = srccol0 + nl;
    if (permq) { const int nd = (int)col; const int s = nd & 63, j = (s & 31) >> 1; col = (size_t)((nd - s) + (s & 32) + ((s & 1) ? 16 + j : j)); }
    float t[32];
#pragma unroll
    for (int i = 0; i < 32; ++i) t[i] = W[(size_t)(k0 + 2 * i + (lane >> 5)) * ldw + col];
#pragma unroll
    for (int i = 0; i < 32; ++i) scr[(2 * i + (lane >> 5)) * 33 + nl] = t[i];
    LDS_WAIT(); asm volatile("" ::: "memory");
    const int c = lane & 7;
#pragma unroll
    for (int j = 0; j < 4; ++j) { const int n = (lane >> 3) + 8 * j; const LAS float* s = scr + (8 * c) * 33 + n;
        v4u o; o.x = pkbf(s[0 * 33], s[1 * 33]); o.y = pkbf(s[2 * 33], s[3 * 33]); o.z = pkbf(s[4 * 33], s[5 * 33]); o.w = pkbf(s[6 * 33], s[7 * 33]);
        *(v4u*)(WT + (dstrow0 + n) * K + k0 + 8 * c) = o; }
    LDS_WAIT(); asm volatile("" ::: "memory");
}
__device__ __forceinline__ void tr_item8(const float* W, size_t ldw, int k0, size_t srccol0, unsigned char* WT, size_t K, size_t dstrow0, LAS float* scr, int lane) {
    const int nl = lane & 31; const size_t col = srccol0 + nl;
    float t[32];
#pragma unroll
    for (int i = 0; i < 32; ++i) t[i] = W[(size_t)(k0 + 2 * i + (lane >> 5)) * ldw + col];
#pragma unroll
    for (int i = 0; i < 32; ++i) scr[(2 * i + (lane >> 5)) * 33 + nl] = t[i] * W8S;
    LDS_WAIT(); asm volatile("" ::: "memory");
    const int c = lane & 7;
#pragma unroll
    for (int j = 0; j < 4; ++j) { const int n = (lane >> 3) + 8 * j; const LAS float* s = scr + (8 * c) * 33 + n;
        v2u o; o.x = pk4f8(s[0 * 33], s[1 * 33], s[2 * 33], s[3 * 33]); o.y = pk4f8(s[4 * 33], s[5 * 33], s[6 * 33], s[7 * 33]);
        *(v2u*)(WT + (dstrow0 + n) * K + k0 + 8 * c) = o; }
    LDS_WAIT(); asm volatile("" ::: "memory");
}
constexpr int IT_GU = 16 * 2048, IT_D = 16 * 1024, IT_MOE = IT_GU + IT_D;
__device__ __forceinline__ void tr_moe_items(const Frame& F, const float* wg, const float* wu, const float* wd, unsigned char* wgu, unsigned char* wdn, int lo, int hi, int widx, int nw) {
    LAS float* scr = (LAS float*)(F.lds + F.wave * 16384);
    for (int r = lo + widx; r < hi; r += nw) {
        if (r < IT_GU) { const int e = r >> 11, q = r & 2047, kb = q >> 7, nb = q & 127, n0 = nb * 32, pn = n0 >> 8, w = n0 & 255;
            const float* W = ((w < 128) ? wg : wu) + (size_t)e * 1024 * 2048;
            tr_item8(W, 2048, kb * 64, (size_t)(pn * 128 + (w & 127)), wgu, 1024, (size_t)e * 4096 + n0, scr, F.lane); }
        else { const int rr = r - IT_GU; const int e = rr >> 10, q = rr & 1023, kb = q >> 5, nb = q & 31, n0 = nb * 32;
            tr_item8(wd + (size_t)e * 2048 * 1024, 1024, kb * 64, (size_t)n0, wdn, 2048, (size_t)e * 1024 + n0, scr, F.lane); }
    }
}
constexpr int L0_QKV = 208 * 8 * 9, L0_WO = 224 * 8 * 9, L0_TOPK = 128 * 8 * 5, L0_PRO = IT_MOE - L0_QKV - L0_WO - L0_TOPK;
constexpr int L1_ATT = 128 * 8 * 4, L1_G2 = 192 * 8 * 10, L1_WIN = 128 * 8 * 8, L1_TOPK = 128 * 8 * 5, L1_PREP = 192 * 8 * 5, L1_CMB = IT_MOE - L1_ATT - L1_G2 - L1_WIN - L1_TOPK - L1_PREP;
__device__ __forceinline__ void phase_prologue(const Frame& F, const Args& A) {
    unsigned char* ws = A.ws;
    const int gw = F.vcu * NWAVES + F.wave, NGW = F.G * NWAVES;
    {
        LAS float* sl = (LAS float*)F.lds;
        LAS float* part = sl + 9 * 1024;
        float* MOD = (float*)(ws + WS_MOD);
        if (F.vcu < 192) {
            for (int idx = F.tid; idx < 9 * 1024; idx += NTHR) { const int r = idx >> 10, k = idx & 1023; const float v = r < 8 ? A.in[1][r * 1024 + k] : A.in[3][k]; sl[idx] = silu_f(v); }
        }
        __syncthreads();
        for (int u = F.vcu; u < 192; u += F.G) {
            const int layer = u / 96, cg = u % 96, col = cg * 64 + F.lane;
            const float* W = layer ? A.in[15] : A.in[4]; const float* bias = layer ? A.in[16] : A.in[5];
            float acc[9];
#pragma unroll
            for (int r = 0; r < 9; ++r) acc[r] = 0.f;
            const int k0 = F.wave * 128;
#pragma unroll 8
            for (int k = k0; k < k0 + 128; ++k) { const float w = W[(size_t)k * 6144 + col];
#pragma unroll
                for (int r = 0; r < 9; ++r) acc[r] += sl[r * 1024 + k] * w; }
#pragma unroll
            for (int r = 0; r < 9; ++r) part[(F.wave * 9 + r) * 64 + F.lane] = acc[r];
            __syncthreads();
            for (int idx = F.tid; idx < 576; idx += NTHR) { const int r = idx >> 6, l = idx & 63; float s = 0.f;
#pragma unroll
                for (int w = 0; w < 8; ++w) s += part[(w * 9 + r) * 64 + l];
                MOD[(size_t)(layer * 9 + r) * 6144 + cg * 64 + l] = s + bias[cg * 64 + l]; }
            __syncthreads();
        }
        if (F.vcu == F.G - 1) {
            float* rc = (float*)(ws + WS_ROPE); float* rs = rc + 1024;
            for (int idx = F.tid; idx < 1024; idx += NTHR) { const int pos = idx >> 4, j = idx & 15;
                const float inv = exp2f(-(float)j * (13.287712379549449f / 16.f));
                const float ang = (float)pos * inv; rc[idx] = cosf(ang); rs[idx] = sinf(ang); }
        }
        __syncthreads();
    }
    {
        LAS float* scr = (LAS float*)(F.lds + F.wave * 16384);
        constexpr int I_QKV = 16 * 48, I_WO = 16 * 32, I_WIN = 16 * 128;
        constexpr int NSMALL = I_QKV + 2 * I_WO + I_WIN;
        for (int it = gw; it < NSMALL; it += NGW) {
            int r = it;
            if (r < I_QKV) { const int kb = r / 48, nb = r % 48; tr_item(A.in[7], NQKV, kb * 64, (size_t)nb * 32, nb * 32 < 1280, (bf16*)(ws + WS_WQKV), 1024, (size_t)nb * 32, scr, F.lane); continue; } r -= I_QKV;
            if (r < I_WO) { const int kb = r >> 5, nb = r & 31; tr_item(A.in[9], 1024, kb * 64, (size_t)nb * 32, false, (bf16*)(ws + WS_WO0), 1024, (size_t)nb * 32, scr, F.lane); continue; } r -= I_WO;
            if (r < I_WIN) { const int kb = r >> 7, nb = r & 127; tr_item(A.in[18], LDWIN, kb * 64, (size_t)nb * 32, false, (bf16*)(ws + WS_WIN), 1024, (size_t)nb * 32, scr, F.lane); continue; } r -= I_WIN;
            { const int kb = r >> 5, nb = r & 31; tr_item(A.in[23], 1024, kb * 64, (size_t)nb * 32, false, (bf16*)(ws + WS_WO1), 1024, (size_t)nb * 32, scr, F.lane); }
        }
        constexpr int L0_NOADA = 64 * 8 * 6;
        if (F.G == 256) { if (F.vcu >= 192) tr_moe_items(F, A.in[12], A.in[13], A.in[14], ws + WS_WGU, ws + WS_WD, 0, L0_NOADA, (F.vcu - 192) * NWAVES + F.wave, 64 * NWAVES);
            tr_moe_items(F, A.in[12], A.in[13], A.in[14], ws + WS_WGU, ws + WS_WD, L0_NOADA, L0_PRO, gw, NGW); }
        else tr_moe_items(F, A.in[12], A.in[13], A.in[14], ws + WS_WGU, ws + WS_WD, 0, L0_PRO, gw, NGW);
    }
}

struct RowCoef { f32x4 a[4], b[4]; };
__device__ __forceinline__ void load_coef(RowCoef& C, const float* g, const float* sh, const float* sc, int lane) {
#pragma unroll
    for (int j = 0; j < 4; ++j) { const f32x4 gv = ((const f32x4*)g)[lane + 64 * j], sv = ((const f32x4*)sc)[lane + 64 * j]; C.a[j] = gv * (sv + 1.0f); C.b[j] = ((const f32x4*)sh)[lane + 64 * j]; }
}
__device__ __forceinline__ float row_rstd(const f32x4 (&v)[4]) {
    float s = 0.f;
#pragma unroll
    for (int j = 0; j < 4; ++j) s += (v[j].x * v[j].x + v[j].y * v[j].y) + (v[j].z * v[j].z + v[j].w * v[j].w);
    return 1.0f / sqrtf(wave_sum(s) * (1.0f / 1024.0f) + EPS);
}
__device__ __forceinline__ void store_row_bf16(bf16* row, const f32x4 (&v)[4], int lane) {
#pragma unroll
    for (int j = 0; j < 4; ++j) { v2u w; w.x = pkbf(v[j].x, v[j].y); w.y = pkbf(v[j].z, v[j].w); ((v2u*)row)[lane + 64 * j] = w; }
}

__device__ __forceinline__ void load_row_bf16(f32x4 (&v)[4], const bf16* row, int lane) {
#pragma unroll
    for (int j = 0; j < 4; ++j) { const v2u w = ((const v2u*)row)[lane + 64 * j]; v[j] = (f32x4){bflo(w.x), bfhi(w.x), bflo(w.y), bfhi(w.y)}; }
}
__device__ __forceinline__ void phase_modnorm0(const Frame& F, const Args& A) {
    const int gw = F.vcu * NWAVES + F.wave, NGW = F.G * NWAVES;
    const float* MOD = (const float*)(A.ws + WS_MOD); bf16* H = (bf16*)(A.ws + WS_H);
    const int rpw = (MTOT + NGW - 1) / NGW;
    int curb = -1; RowCoef C;
    const int mbeg = gw * rpw, cnt = (MTOT - mbeg) < rpw ? (MTOT - mbeg) : rpw;
    f32x4 nx[4];
    if (cnt > 0) { const float* xr = mbeg < MLAT ? A.in[0] + (size_t)mbeg * D : A.in[2] + (size_t)(mbeg - MLAT) * D;
#pragma unroll
        for (int j = 0; j < 4; ++j) nx[j] = ((const f32x4*)xr)[F.lane + 64 * j]; }
    for (int r = 0; r < cnt; ++r) { const int m = mbeg + r;
        const int mb = modrow(m);
        if (mb != curb) { load_coef(C, A.in[6], MOD + (size_t)mb * 6144, MOD + (size_t)mb * 6144 + 1024, F.lane); curb = mb; }
        f32x4 v[4];
#pragma unroll
        for (int j = 0; j < 4; ++j) v[j] = nx[j];
        if (r + 1 < cnt) { const int m1 = m + 1; const float* xr = m1 < MLAT ? A.in[0] + (size_t)m1 * D : A.in[2] + (size_t)(m1 - MLAT) * D;
#pragma unroll
            for (int j = 0; j < 4; ++j) nx[j] = ((const f32x4*)xr)[F.lane + 64 * j]; }
        const float rstd = row_rstd(v);
#pragma unroll
        for (int j = 0; j < 4; ++j) v[j] = v[j] * rstd * C.a[j] + C.b[j];
        store_row_bf16(H + (size_t)m * D, v, F.lane);
    }
}

template <int NML, int NNL> struct GroupOrder {
    static constexpr int PER = NML * NNL, BW = 4 * NNL;
    int nx, e0, lid;
    __device__ void init(int G_, int bx) { nx = G_ / 8; e0 = bx % 8; lid = bx / 8; }
    __device__ bool next(int i, pg8::Unit& u) const { const int q = i * nx + lid; if (q >= 2 * PER) return false;
        const int e = e0 + 8 * (q / PER), r = q % PER, band = r / BW, rr = r % BW, brow = (NML - 4 * band) < 4 ? (NML - 4 * band) : 4;
        u.pm = e * NML + 4 * band + rr % brow; u.pn = e * NNL + rr / brow; return true; }
    __device__ __forceinline__ void a_ready(const pg8::Unit&) const {}
    __device__ __forceinline__ void done(const pg8::Unit&) const {}
    __device__ __forceinline__ const char* aptr(const pg8::Gemm& g, const pg8::Unit& u, size_t tstep) const { return (const char*)g.A + (size_t)u.pm * tstep; }
    __device__ __forceinline__ const char* bptr(const pg8::Gemm& g, const pg8::Unit& u, size_t tstep) const { return (const char*)g.Bt + (size_t)u.pn * tstep; }
};
struct QKVOrder {
    int nx, x0, lid;
    __device__ void init(int G_, int bx) { nx = G_ / 8; x0 = bx % 8; lid = bx / 8; }
    __device__ bool next(int i, pg8::Unit& u) const { const int q = i * nx + lid; if (q >= 102) return false; const int tm = 17 * x0 + q / 6, c = q % 6;
        if (c < 5) { u.pm = tm; u.pn = c; } else { u.pm = 1000 + tm; u.pn = 5; } return true; }
    __device__ __forceinline__ void a_ready(const pg8::Unit&) const {}
    __device__ __forceinline__ void done(const pg8::Unit&) const {}
    __device__ __forceinline__ const char* aptr(const pg8::Gemm& g, const pg8::Unit& u, size_t tstep) const { return u.pm >= 1000 ? (const char*)g.Bt + 5 * tstep : (const char*)g.A + (size_t)u.pm * tstep; }
    __device__ __forceinline__ const char* bptr(const pg8::Gemm& g, const pg8::Unit& u, size_t tstep) const { return u.pm >= 1000 ? (const char*)g.A + (size_t)(u.pm - 1000) * tstep : (const char*)g.Bt + (size_t)u.pn * tstep; }
};
struct EpiQKV {
    static constexpr bool PERM = true, AFTER_DRAIN = false;
    bf16 *Q, *K, *V; const float* rc; const float* rs; float QS;
    __device__ __forceinline__ void operator()(const f32x4 (&acc)[2][2][4][2], const pg8::Unit& u, int wr, int wc, int fr, int fq) const {
        if (u.pm >= 1000) {
            const int tok0 = (u.pm - 1000) * 256;
#pragma unroll
            for (int ai = 0; ai < 2; ++ai)
#pragma unroll
                for (int m = 0; m < 4; ++m) { const int dr = ai * 128 + wr * 64 + m * 16 + fr;
#pragma unroll
                    for (int bj = 0; bj < 2; ++bj) { const f32x4 v0 = acc[ai][bj][m][0], v1 = acc[ai][bj][m][1];
                        v4u w; w.x = pkbf(v0[0], v0[1]); w.y = pkbf(v0[2], v0[3]); w.z = pkbf(v1[0], v1[1]); w.w = pkbf(v1[2], v1[3]);
                        *(v4u*)(V + (size_t)dr * MTOT + tok0 + bj * 128 + wc * 32 + 8 * fq) = w; } }
            return; }
        const int pn = u.pn; bf16* base; int ld, coff;
        if (pn < 4) { base = Q; ld = 1024; coff = pn * 256; } else { base = K; ld = 256; coff = 0; }
        const bool rope = (u.pm < MLAT / 256);
        const float sc = pn < 4 ? QS : 1.0f;
        const int iscol = wc & 1;
#pragma unroll
        for (int ai = 0; ai < 2; ++ai)
#pragma unroll
            for (int m = 0; m < 4; ++m) {
                const int r = u.pm * 256 + ai * 128 + wr * 64 + m * 16 + fr;
                f32x4 cv = (f32x4){1.f, 1.f, 1.f, 1.f}, sv = (f32x4){0.f, 0.f, 0.f, 0.f};
                if (rope) { const int n = r & 4095; const int pos = iscol ? (n & 63) : (n >> 6); cv = *(const f32x4*)(rc + pos * 16 + 4 * fq); sv = *(const f32x4*)(rs + pos * 16 + 4 * fq); }
#pragma unroll
                for (int bj = 0; bj < 2; ++bj) {
                    const f32x4 v0 = acc[ai][bj][m][0], v1 = acc[ai][bj][m][1];
                    const float o0 = (v0[0] * cv[0] - v0[1] * sv[0]) * sc, o1 = (v0[1] * cv[0] + v0[0] * sv[0]) * sc;
                    const float o2 = (v0[2] * cv[1] - v0[3] * sv[1]) * sc, o3 = (v0[3] * cv[1] + v0[2] * sv[1]) * sc;
                    const float o4 = (v1[0] * cv[2] - v1[1] * sv[2]) * sc, o5 = (v1[1] * cv[2] + v1[0] * sv[2]) * sc;
                    const float o6 = (v1[2] * cv[3] - v1[3] * sv[3]) * sc, o7 = (v1[3] * cv[3] + v1[2] * sv[3]) * sc;
                    v4u w; w.x = pkbf(o0, o1); w.y = pkbf(o2, o3); w.z = pkbf(o4, o5); w.w = pkbf(o6, o7);
                    *(v4u*)(base + (size_t)r * ld + coff + bj * 128 + wc * 32 + 8 * fq) = w;
                }
            }
    }
};
template <bool XIN_BF16> struct EpiResid {
    static constexpr bool PERM = true, AFTER_DRAIN = false;
    const void* xlat; const void* xctx; bf16* out; const float* gate;
    __device__ __forceinline__ void operator()(const f32x4 (&acc)[2][2][4][2], const pg8::Unit& u, int wr, int wc, int fr, int fq) const {
        const int mb = u.pm < MLAT / 256 ? (u.pm >> 4) : 8;
        const int col0 = u.pn * 256 + wc * 32 + 8 * fq;
        const float* gp = gate + (size_t)mb * 6144 + col0;
        f32x4 gv[2][2];
#pragma unroll
        for (int bj = 0; bj < 2; ++bj)
#pragma unroll
            for (int n = 0; n < 2; ++n) gv[bj][n] = *(const f32x4*)(gp + bj * 128 + n * 4);
#pragma unroll
        for (int ai = 0; ai < 2; ++ai)
#pragma unroll
            for (int m = 0; m < 4; ++m) {
                const int r = u.pm * 256 + ai * 128 + wr * 64 + m * 16 + fr;
                bf16* o = out + (size_t)r * D + col0;
#pragma unroll
                for (int bj = 0; bj < 2; ++bj) { f32x4 x0, x1;
                    if (XIN_BF16) { const v4u w = *(const v4u*)((const bf16*)xlat + (size_t)r * D + col0 + bj * 128);
                        x0 = (f32x4){bflo(w.x), bfhi(w.x), bflo(w.y), bfhi(w.y)}; x1 = (f32x4){bflo(w.z), bfhi(w.z), bflo(w.w), bfhi(w.w)}; }
                    else { const float* xin = (r < MLAT ? (const float*)xlat + (size_t)r * D : (const float*)xctx + (size_t)(r - MLAT) * D) + col0 + bj * 128; x0 = *(const f32x4*)xin; x1 = *(const f32x4*)(xin + 4); }
                    x0 += gv[bj][0] * acc[ai][bj][m][0]; x1 += gv[bj][1] * acc[ai][bj][m][1];
                    v4u w; w.x = pkbf(x0[0], x0[1]); w.y = pkbf(x0[2], x0[3]); w.z = pkbf(x1[0], x1[1]); w.w = pkbf(x1[2], x1[3]);
                    *(v4u*)(o + bj * 128) = w; }
            }
    }
};
struct EpiSwiGLU {
    static constexpr bool PERM = true, AFTER_DRAIN = false;
    unsigned char* HID;
    __device__ __forceinline__ void operator()(const f32x4 (&acc)[2][2][4][2], const pg8::Unit& u, int wr, int wc, int fr, int fq) const {
        asm volatile("" : "+v"(fr), "+v"(fq));
        const int col = (u.pn & 15) * 128 + wc * 32 + 8 * fq;
#pragma unroll
        for (int ai = 0; ai < 2; ++ai)
#pragma unroll
            for (int m = 0; m < 4; ++m) {
                const int r = u.pm * 256 + ai * 128 + wr * 64 + m * 16 + fr;
                const f32x4 g0 = acc[ai][0][m][0] * W8I, g1 = acc[ai][0][m][1] * W8I, u0 = acc[ai][1][m][0] * W8I, u1 = acc[ai][1][m][1] * W8I;
                v2u w; w.x = pk4f8(silu_f(g0[0]) * u0[0], silu_f(g0[1]) * u0[1], silu_f(g0[2]) * u0[2], silu_f(g0[3]) * u0[3]);
                w.y = pk4f8(silu_f(g1[0]) * u1[0], silu_f(g1[1]) * u1[1], silu_f(g1[2]) * u1[2], silu_f(g1[3]) * u1[3]);
                *(v2u*)(HID + (size_t)r * FF + col) = w;
            }
    }
};
struct EpiY {
    static constexpr bool PERM = true, AFTER_DRAIN = false;
    bf16* Y;
    __device__ __forceinline__ void operator()(const f32x4 (&acc)[2][2][4][2], const pg8::Unit& u, int wr, int wc, int fr, int fq) const {
        asm volatile("" : "+v"(fr), "+v"(fq));
        const int col = (u.pn & 3) * 256 + wc * 32 + 8 * fq;
#pragma unroll
        for (int ai = 0; ai < 2; ++ai)
#pragma unroll
            for (int m = 0; m < 4; ++m) {
                const int r = u.pm * 256 + ai * 128 + wr * 64 + m * 16 + fr;
                const float gwt = W8I;
#pragma unroll
                for (int bj = 0; bj < 2; ++bj) { const f32x4 v0 = acc[ai][bj][m][0] * gwt, v1 = acc[ai][bj][m][1] * gwt;
                    v4u w; w.x = pkbf(v0[0], v0[1]); w.y = pkbf(v0[2], v0[3]); w.z = pkbf(v1[0], v1[1]); w.w = pkbf(v1[2], v1[3]);
                    *(v4u*)(Y + (size_t)r * D + col + bj * 128) = w; }
            }
    }
};
struct EpiP {
    static constexpr bool PERM = true, AFTER_DRAIN = false;
    bf16 *P, *Z;
    __device__ __forceinline__ void operator()(const f32x4 (&acc)[2][2][4][2], const pg8::Unit& u, int wr, int wc, int fr, int fq) const {
        bf16* base; int ld, coff;
        if (u.pn < 12) { base = P; ld = 3072; coff = u.pn * 256; } else { base = Z; ld = 1024; coff = (u.pn - 12) * 256; }
#pragma unroll
        for (int ai = 0; ai < 2; ++ai)
#pragma unroll
            for (int m = 0; m < 4; ++m) {
                const int r = u.pm * 256 + ai * 128 + wr * 64 + m * 16 + fr;
#pragma unroll
                for (int bj = 0; bj < 2; ++bj) { const f32x4 v0 = acc[ai][bj][m][0], v1 = acc[ai][bj][m][1];
                    v4u w; w.x = pkbf(v0[0], v0[1]); w.y = pkbf(v0[2], v0[3]); w.z = pkbf(v1[0], v1[1]); w.w = pkbf(v1[2], v1[3]);
                    *(v4u*)(base + (size_t)r * ld + coff + bj * 128 + wc * 32 + 8 * fq) = w; }
            }
    }
};

typedef float f32x16 __attribute__((ext_vector_type(16)));
typedef float f32x2_t __attribute__((ext_vector_type(2)));
typedef __bf16 bf16x2_t __attribute__((ext_vector_type(2)));
__device__ __forceinline__ unsigned cvtpk(float lo, float hi) { f32x2_t v = {lo, hi}; bf16x2_t b = __builtin_convertvector(v, bf16x2_t); return __builtin_bit_cast(unsigned, b); }
#define MFMA32(a, b, c) __builtin_amdgcn_mfma_f32_32x32x16_bf16((a), (b), (c), 0, 0, 0)
constexpr float LOG2E = 1.4426950408889634f;
constexpr float QSCALE = 0.125f * LOG2E;
constexpr int ATT_KROW = 144, ATT_VROW = 136, ATT_KB = 64 * ATT_KROW, ATT_VB = 64 * ATT_VROW;
__device__ __forceinline__ void phase_attn_v2(const Frame& F, const Args& A) {
    const bf16* Q = (const bf16*)(A.ws + WS_Q); const bf16* K = (const bf16*)(A.ws + WS_K); const bf16* VT = (const bf16*)(A.ws + WS_V); bf16* O = (bf16*)(A.ws + WS_ATT);
    LAS unsigned char* Kb = F.lds; LAS unsigned char* Vb = F.lds + 2 * ATT_KB;
    const int g = F.wave >> 1, half = F.wave & 1, r = F.lane & 31, hh = F.lane >> 5;
    const int kr = F.tid >> 3, kc = F.tid & 7;
    constexpr int NU_LAT = NB * 4 * 64, NU_CTX = NB * 4 * 4;
    for (int u = F.vcu; u < NU_LAT + NU_CTX; u += F.G) {
        int b, kvh, qb; const bool lat = u < NU_LAT;
        if (lat) { b = u >> 8; kvh = (u >> 6) & 3; qb = u & 63; } else { const int uu = u - NU_LAT; b = uu >> 4; kvh = (uu >> 2) & 3; qb = uu & 3; }
        const int hq = kvh * 4 + g, n = qb * 64 + half * 32 + r;
        const size_t mrow = lat ? (size_t)b * SEQ + n : (size_t)MLAT + b * CTXL + n;
        const int jlo = lat ? (qb - 2 < 0 ? 0 : qb - 2) : 0, jhi = lat ? (qb + 2 > 63 ? 63 : qb + 2) : -1, nl = jhi - jlo + 1, T = nl + 4;
        const size_t ctxbase = (size_t)MLAT + b * CTXL, latbase = (size_t)b * SEQ;
        v4u kreg, vreg;
        { const size_t rb = (nl > 0) ? latbase + (size_t)jlo * 64 : ctxbase;
          kreg = *(const v4u*)(K + (rb + kr) * 256 + kvh * 64 + kc * 8); vreg = *(const v4u*)(VT + (size_t)(kvh * 64 + kr) * MTOT + rb + kc * 8); }
        bf16x8 qf[4];
#pragma unroll
        for (int ks = 0; ks < 4; ++ks) qf[ks] = *(const bf16x8*)(Q + mrow * 1024 + hq * 64 + 16 * ks + 8 * hh);
        const float sink2 = A.in[8][hq] * LOG2E;
        float mrun = sink2, lsum = 0.f;
        f32x16 oacc[2];
#pragma unroll
        for (int i = 0; i < 16; ++i) { oacc[0][i] = 0.f; oacc[1][i] = 0.f; }
        *(LAS v4u*)(Kb + kr * ATT_KROW + kc * 16) = kreg;
        *(LAS v2u*)(Vb + kr * ATT_VROW + kc * 16) = (v2u){vreg.x, vreg.y}; *(LAS v2u*)(Vb + kr * ATT_VROW + kc * 16 + 8) = (v2u){vreg.z, vreg.w};
        __syncthreads();
        for (int t = 0; t < T; ++t) {
            if (t + 1 < T) { const int t1 = t + 1; const size_t rb = (t1 < nl) ? latbase + (size_t)(jlo + t1) * 64 : ctxbase + (size_t)(t1 - nl) * 64;
                kreg = *(const v4u*)(K + (rb + kr) * 256 + kvh * 64 + kc * 8); vreg = *(const v4u*)(VT + (size_t)(kvh * 64 + kr) * MTOT + rb + kc * 8); }
            const LAS unsigned char* kb = Kb + (t & 1) * ATT_KB; const LAS unsigned char* vb = Vb + (t & 1) * ATT_VB;
            f32x16 st[2];
#pragma unroll
            for (int sub = 0; sub < 2; ++sub) {
#pragma unroll
                for (int i = 0; i < 16; ++i) st[sub][i] = 0.f;
#pragma unroll
                for (int ks = 0; ks < 4; ++ks) { const bf16x8 kf = *(const LAS bf16x8*)(kb + (32 * sub + r) * ATT_KROW + (16 * ks + 8 * hh) * 2); st[sub] = MFMA32(kf, qf[ks], st[sub]); }
            }
            if (t < nl) { const int jt = jlo + t;
                if (jt == qb - 2 || jt == qb + 2) {
#pragma unroll
                    for (int sub = 0; sub < 2; ++sub)
#pragma unroll
                        for (int i = 0; i < 16; ++i) { const int key = jt * 64 + 32 * sub + (i & 3) + 8 * (i >> 2) + 4 * hh; const int d = key - n; if (d > 128 || d < -128) st[sub][i] = -INFINITY; }
                } }
            float mx = st[0][0];
#pragma unroll
            for (int i = 1; i < 16; ++i) mx = fmaxf(mx, st[0][i]);
#pragma unroll
            for (int i = 0; i < 16; ++i) mx = fmaxf(mx, st[1][i]);
            mx = fmaxf(mx, __shfl_xor(mx, 32));
            const float mnew = fmaxf(mrun, mx);
            if (__builtin_amdgcn_ballot_w64(mnew != mrun) != 0ull) {
                const float alpha = __builtin_amdgcn_exp2f(mrun - mnew); mrun = mnew; lsum *= alpha;
#pragma unroll
                for (int i = 0; i < 16; ++i) { oacc[0][i] *= alpha; oacc[1][i] *= alpha; } }
            float ps = 0.f;
#pragma unroll
            for (int sub = 0; sub < 2; ++sub)
#pragma unroll
                for (int i = 0; i < 16; ++i) { const float p = __builtin_amdgcn_exp2f(st[sub][i] - mnew); st[sub][i] = p; ps += p; }
            lsum += ps;
#pragma unroll
            for (int sub = 0; sub < 2; ++sub)
#pragma unroll
                for (int s = 0; s < 2; ++s) {
                    v4u pw; pw.x = cvtpk(st[sub][8 * s], st[sub][8 * s + 1]); pw.y = cvtpk(st[sub][8 * s + 2], st[sub][8 * s + 3]); pw.z = cvtpk(st[sub][8 * s + 4], st[sub][8 * s + 5]); pw.w = cvtpk(st[sub][8 * s + 6], st[sub][8 * s + 7]);
                    const bf16x8 pf = __builtin_bit_cast(bf16x8, pw);
#pragma unroll
                    for (int dt = 0; dt < 2; ++dt) { const LAS unsigned char* vp = vb + (32 * dt + r) * ATT_VROW + (32 * sub + 16 * s + 4 * hh) * 2;
                        const v2u lo = *(const LAS v2u*)vp, hi = *(const LAS v2u*)(vp + 16);
                        const bf16x8 vf = __builtin_bit_cast(bf16x8, (v4u){lo.x, lo.y, hi.x, hi.y});
                        oacc[dt] = MFMA32(vf, pf, oacc[dt]); }
                }
            if (t + 1 < T) { LAS unsigned char* kw = Kb + ((t + 1) & 1) * ATT_KB; LAS unsigned char* vw = Vb + ((t + 1) & 1) * ATT_VB;
                *(LAS v4u*)(kw + kr * ATT_KROW + kc * 16) = kreg;
                *(LAS v2u*)(vw + kr * ATT_VROW + kc * 16) = (v2u){vreg.x, vreg.y}; *(LAS v2u*)(vw + kr * ATT_VROW + kc * 16 + 8) = (v2u){vreg.z, vreg.w}; }
            __syncthreads();
        }
        lsum += __shfl_xor(lsum, 32);
        const float inv = 1.0f / (lsum + __builtin_amdgcn_exp2f(sink2 - mrun));
        bf16* orow = O + mrow * 1024 + hq * 64;
#pragma unroll
        for (int dt = 0; dt < 2; ++dt)
#pragma unroll
            for (int rq = 0; rq < 4; ++rq) { v2u w; w.x = cvtpk(oacc[dt][4 * rq] * inv, oacc[dt][4 * rq + 1] * inv); w.y = cvtpk(oacc[dt][4 * rq + 2] * inv, oacc[dt][4 * rq + 3] * inv);
                *(v2u*)(orow + 32 * dt + 8 * rq + 4 * hh) = w; }
    }
    if (F.G == 256 && F.vcu >= 128) tr_moe_items(F, A.in[26], A.in[27], A.in[28], A.ws + WS_WGU1, A.ws + WS_WD1, 0, L1_ATT, (F.vcu - 128) * NWAVES + F.wave, 128 * NWAVES);
    else if (F.G != 256) tr_moe_items(F, A.in[26], A.in[27], A.in[28], A.ws + WS_WGU1, A.ws + WS_WD1, 0, L1_ATT, F.vcu * NWAVES + F.wave, F.G * NWAVES);
}

template <int R> __device__ __forceinline__ void nr_rows(const Frame& F, const bf16* xres, int m0, const float* g, const float* mod, const LAS float* WrT, unsigned char* H8, float* AFF, float* AFFC, RowCoef& C, int& curb) {
    f32x4 vv[R][4];
#pragma unroll
    for (int t = 0; t < R; ++t) load_row_bf16(vv[t], xres + (size_t)(m0 + t) * D, F.lane);
#pragma unroll
    for (int t = 0; t < R; ++t) { const int m = m0 + t; const int mb = modrow(m);
        if (mb != curb) { load_coef(C, g, mod + (size_t)mb * 6144 + 3 * 1024, mod + (size_t)mb * 6144 + 4 * 1024, F.lane); curb = mb; }
        const float rstd = row_rstd(vv[t]);
#pragma unroll
        for (int j = 0; j < 4; ++j) vv[t][j] = vv[t][j] * rstd * C.a[j] + C.b[j];
#pragma unroll
        for (int j = 0; j < 4; ++j) ((unsigned*)(H8 + (size_t)m * D))[F.lane + 64 * j] = pk4f8(vv[t][j].x, vv[t][j].y, vv[t][j].z, vv[t][j].w); }
    const LAS float* wrt = WrT; asm volatile("" : "+v"(wrt));
    float lgt[R];
    proj16xR<R>(vv, wrt, F.lane, lgt);
#pragma unroll
    for (int t = 0; t < R; ++t) { const float logit = lgt[t];
        float mx = logit;
#pragma unroll
        for (int o = 4; o < 64; o <<= 1) mx = fmaxf(mx, __shfl_xor(mx, o));
        const float ex = expf(logit - mx); float den = ex;
#pragma unroll
        for (int o = 4; o < 64; o <<= 1) den += __shfl_xor(den, o);
        const float mine = ex / den; const int ee = F.lane >> 2; const int m = m0 + t;
        if ((F.lane & 3) == 0) { if (m < MLAT) AFF[((size_t)(m >> 12) * NE + ee) * SEQ + (m & 4095)] = mine; else { const int mm = m - MLAT; AFFC[((size_t)(mm >> 8) * NE + ee) * CTXL + (mm & 255)] = mine; } } }
}
__device__ __forceinline__ void phase_norm_router(const Frame& F, const Args& A, const bf16* xres, int nrows, const float* g, const float* mod, const float* router) {
    LAS float* WrT = (LAS float*)F.lds;
    for (int idx = F.tid; idx < 16384; idx += NTHR) WrT[(idx & 15) * 1024 + (idx >> 4)] = router[idx];
    __syncthreads();
    const int gw = F.vcu * NWAVES + F.wave, NGW = F.G * NWAVES;
    unsigned char* H8 = A.ws + WS_H8; float* AFF = (float*)(A.ws + WS_AFF); float* AFFC = AFF + (size_t)NB * NE * SEQ;
    const int rpw = (nrows + NGW - 1) / NGW;
    int curb = -1; RowCoef C;
    const int mbeg = gw * rpw, cnt = (nrows - mbeg) < rpw ? (nrows - mbeg) : rpw;
    int r = 0;
    for (; r + 4 <= cnt; r += 4) nr_rows<4>(F, xres, mbeg + r, g, mod, WrT, H8, AFF, AFFC, C, curb);
    for (; r < cnt; ++r) nr_rows<1>(F, xres, mbeg + r, g, mod, WrT, H8, AFF, AFFC, C, curb);
    __syncthreads();
}

__device__ __forceinline__ void phase_topk(const Frame& F, const Args& A, bool with_ctx, int erows, const float* cwg, const float* cwu, const float* cwd, unsigned char* cwgu, unsigned char* cwdn, int clo, int chi) {
    LAS unsigned* hist = (LAS unsigned*)F.lds;
    LAS unsigned* ctl = hist + 256;
    LAS unsigned* wsum = hist + 272;
    LAS int* sel = (LAS int*)(hist + 512);
    const float* AFF = (const float*)(A.ws + WS_AFF); const float* AFFC = AFF + (size_t)NB * NE * SEQ;
    float* GW = (float*)(A.ws + WS_GW); int* SLOT = (int*)(A.ws + WS_SLOT);
    const unsigned char* H8 = A.ws + WS_H8; unsigned char* XG = A.ws + WS_XG;
    const int nprob = with_ctx ? 256 : 128;
    for (int p = F.vcu; p < nprob; p += F.G) {
        int b, e, N, cap, rowbase, tokbase; const float* src;
        if (p < 128) { b = p >> 4; e = p & 15; N = SEQ; cap = CAPL; src = AFF + (size_t)(b * NE + e) * SEQ; rowbase = e * erows + b * CAPL; tokbase = b * SEQ; }
        else { const int pp = p - 128; b = pp >> 4; e = pp & 15; N = CTXL; cap = CAPC; src = AFFC + (size_t)(b * NE + e) * CTXL; rowbase = e * erows + NB * CAPL + b * CAPC; tokbase = MLAT + b * CTXL; }
        const bool own = 8 * F.tid < N;
        unsigned v[8];
        { f32x4 x0 = (f32x4){0.f, 0.f, 0.f, 0.f}, x1 = x0; if (own) { x0 = ((const f32x4*)src)[2 * F.tid]; x1 = ((const f32x4*)src)[2 * F.tid + 1]; }
          v[0] = __float_as_uint(x0.x); v[1] = __float_as_uint(x0.y); v[2] = __float_as_uint(x0.z); v[3] = __float_as_uint(x0.w); v[4] = __float_as_uint(x1.x); v[5] = __float_as_uint(x1.y); v[6] = __float_as_uint(x1.z); v[7] = __float_as_uint(x1.w); }
        unsigned prefix = 0u, need = (unsigned)cap;
#pragma unroll
        for (int pass = 0; pass < 4; ++pass) { const int shift = 24 - 8 * pass;
            if (F.tid < 256) hist[F.tid] = 0u;
            __syncthreads();
            if (own) {
#pragma unroll
                for (int k = 0; k < 8; ++k) { const bool match = (pass == 0) ? true : ((v[k] >> ((shift + 8) & 31)) == (prefix >> ((shift + 8) & 31))); if (match) atomicAdd((unsigned*)&hist[(v[k] >> shift) & 255u], 1u); } }
            __syncthreads();
            if (F.wave == 0) { const unsigned c0 = hist[4 * F.lane], c1 = hist[4 * F.lane + 1], c2 = hist[4 * F.lane + 2], c3 = hist[4 * F.lane + 3]; const unsigned tot = (c0 + c1) + (c2 + c3);
                unsigned sv = tot;
#pragma unroll
                for (int o = 1; o < 64; o <<= 1) { const unsigned t = __shfl_down(sv, o); if (F.lane + o < 64) sv += t; }
                const unsigned g3 = sv - tot, g2 = g3 + c3, g1 = g2 + c2, g0 = g1 + c1;
                if (g3 < need && need <= g3 + c3) { ctl[0] = 4 * F.lane + 3; ctl[1] = need - g3; }
                else if (g2 < need && need <= g2 + c2) { ctl[0] = 4 * F.lane + 2; ctl[1] = need - g2; }
                else if (g1 < need && need <= g1 + c1) { ctl[0] = 4 * F.lane + 1; ctl[1] = need - g1; }
                else if (g0 < need && need <= g0 + c0) { ctl[0] = 4 * F.lane; ctl[1] = need - g0; } }
            __syncthreads();
            prefix |= ctl[0] << shift; need = ctl[1]; }
        const unsigned T = prefix;
        unsigned packed = 0u;
        if (own) {
#pragma unroll
            for (int k = 0; k < 8; ++k) packed += (v[k] > T ? 1u : 0u) + (v[k] == T ? 0x10000u : 0u); }
        unsigned incl = packed;
#pragma unroll
        for (int o = 1; o < 64; o <<= 1) { const unsigned t = __shfl_up(incl, o); if (F.lane >= o) incl += t; }
        if (F.lane == 63) wsum[F.wave] = incl;
        __syncthreads();
        unsigned base = 0u;
#pragma unroll
        for (int w = 0; w < 8; ++w) if (w < F.wave) base += wsum[w];
        unsigned rg = ((incl - packed) + base) & 0xffffu, re = ((incl - packed) + base) >> 16; const unsigned totalgt = (unsigned)cap - need;
        if (own) {
#pragma unroll
            for (int k = 0; k < 8; ++k) { const int tok = tokbase + 8 * F.tid + k; int slot = -1;
                if (v[k] > T) { slot = (int)rg; ++rg; } else if (v[k] == T) { if (re < need) slot = (int)(totalgt + re); ++re; }
                if (slot >= 0) { GW[rowbase + slot] = __uint_as_float(v[k]); SLOT[(size_t)tok * 16 + e] = rowbase + slot; sel[slot] = tok; } else SLOT[(size_t)tok * 16 + e] = -1; } }
        __syncthreads();
        for (int i0 = F.wave; i0 < cap; i0 += 8 * NWAVES) {
            v4u x[8];
#pragma unroll
            for (int q = 0; q < 8; ++q) { const int i = i0 + q * NWAVES; const int tok = sel[i < cap ? i : i0]; x[q] = ((const v4u*)(H8 + (size_t)tok * D))[F.lane]; }
#pragma unroll
            for (int q = 0; q < 8; ++q) { const int i = i0 + q * NWAVES; if (i < cap) ((v4u*)(XG + (size_t)(rowbase + i) * D))[F.lane] = x[q]; } }
        __syncthreads();
    }
    if (F.G == 256) { if (F.vcu >= 128) tr_moe_items(F, cwg, cwu, cwd, cwgu, cwdn, clo, chi, (F.vcu - 128) * NWAVES + F.wave, 128 * NWAVES); }
    else tr_moe_items(F, cwg, cwu, cwd, cwgu, cwdn, clo, chi, F.vcu * NWAVES + F.wave, F.G * NWAVES);
}

struct CombineIn { int sv; v2u xr[4]; };
__device__ __forceinline__ void combine_issue(CombineIn& ci, const bf16* xres_row, const int* slot_row, int lane) {
    ci.sv = slot_row[lane & 15];
#pragma unroll
    for (int j = 0; j < 4; ++j) ci.xr[j] = ((const v2u*)xres_row)[lane + 64 * j];
}
__device__ __forceinline__ void combine_finish(f32x4 (&v)[4], const CombineIn& ci, const bf16* Y, const float* GW, const float* gt2, int lane) {
    f32x4 acc[4];
#pragma unroll
    for (int j = 0; j < 4; ++j) acc[j] = (f32x4){0.f, 0.f, 0.f, 0.f};
    const int sv = ci.sv;
    unsigned mask = (unsigned)(__builtin_amdgcn_ballot_w64(sv >= 0) & 0xffffull);
    while (mask) {
        v2u w[4][4]; float gte[4];
#pragma unroll
        for (int q = 0; q < 4; ++q) {
            gte[q] = 0.f;
#pragma unroll
            for (int j = 0; j < 4; ++j) w[q][j] = (v2u){0u, 0u};
            if (mask) { const int e = __builtin_ctz(mask); mask &= mask - 1u; const int s = __builtin_amdgcn_readlane(sv, e);
                gte[q] = GW[s]; const v2u* yr = (const v2u*)(Y + (size_t)s * D);
#pragma unroll
                for (int j = 0; j < 4; ++j) w[q][j] = yr[lane + 64 * j]; } }
#pragma unroll
        for (int q = 0; q < 4; ++q)
#pragma unroll
            for (int j = 0; j < 4; ++j) acc[j] += (f32x4){bflo(w[q][j].x), bfhi(w[q][j].x), bflo(w[q][j].y), bfhi(w[q][j].y)} * gte[q];
    }
#pragma unroll
    for (int j = 0; j < 4; ++j) v[j] = (f32x4){bflo(ci.xr[j].x), bfhi(ci.xr[j].x), bflo(ci.xr[j].y), bfhi(ci.xr[j].y)} + ((const f32x4*)gt2)[lane + 64 * j] * acc[j];
}

template <int R> __device__ __forceinline__ void cmb_rows(const Frame& F, const Args& A, int m0, const LAS float* WabT, RowCoef& C, int& curb, float alog, float dtb) {
    const float* MOD0 = (const float*)(A.ws + WS_MOD); const float* MOD1 = MOD0 + 9 * 6144;
    bf16* XRES = (bf16*)(A.ws + WS_XRES); bf16* H = (bf16*)(A.ws + WS_H); const bf16* Y = (const bf16*)(A.ws + WS_XG); const int* SLOT = (const int*)(A.ws + WS_SLOT);
    float* Gb = (float*)(A.ws + WS_G); float* Bb = (float*)(A.ws + WS_BETA);
    f32x4 vv[R][4]; CombineIn ci[R];
#pragma unroll
    for (int t = 0; t < R; ++t) combine_issue(ci[t], XRES + (size_t)(m0 + t) * D, SLOT + (size_t)(m0 + t) * 16, F.lane);
#pragma unroll
    for (int t = 0; t < R; ++t) { const int m = m0 + t; const int mb = modrow(m);
        if (mb != curb) { load_coef(C, A.in[17], MOD1 + (size_t)mb * 6144, MOD1 + (size_t)mb * 6144 + 1024, F.lane); curb = mb; }
        combine_finish(vv[t], ci[t], Y, (const float*)(A.ws + WS_GW), MOD0 + (size_t)mb * 6144 + 5 * 1024, F.lane);
        store_row_bf16(XRES + (size_t)m * D, vv[t], F.lane);
        const float rstd = row_rstd(vv[t]);
#pragma unroll
        for (int j = 0; j < 4; ++j) vv[t][j] = vv[t][j] * rstd * C.a[j] + C.b[j];
        store_row_bf16(H + (size_t)m * D, vv[t], F.lane); }
    const LAS float* wab = WabT; asm volatile("" : "+v"(wab));
    float av[R], bv[R];
    proj16xR<R>(vv, wab, F.lane, av); proj16xR<R>(vv, wab + 16 * 1024, F.lane, bv);
    if ((F.lane & 3) == 0) { const int jj = F.lane >> 2;
#pragma unroll
        for (int t = 0; t < R; ++t) { const int m = m0 + t; const float xx = av[t] + dtb; const float sp = fmaxf(xx, 0.f) + log1pf(expf(-fabsf(xx))); Gb[(size_t)m * 16 + jj] = -expf(alog) * sp; Bb[(size_t)m * 16 + jj] = 1.0f / (1.0f + expf(-bv[t])); } }
}
__device__ __forceinline__ void phase_combine0(const Frame& F, const Args& A) {
    const int gw = F.vcu * NWAVES + F.wave, NGW = F.G * NWAVES;
    tr_moe_items(F, A.in[26], A.in[27], A.in[28], A.ws + WS_WGU1, A.ws + WS_WD1, L1_ATT + L1_G2 + L1_WIN, L1_ATT + L1_G2 + L1_WIN + L1_CMB, gw, NGW);
    __syncthreads();
    LAS float* WabT = (LAS float*)F.lds;
    for (int idx = F.tid; idx < 32768; idx += NTHR) { const int k = idx >> 5, j = idx & 31; WabT[j * 1024 + k] = A.in[18][(size_t)k * LDWIN + 4096 + j]; }
    __syncthreads();
    const int rpw = (MTOT + NGW - 1) / NGW;
    int curb = -1; RowCoef C;
    const float alog = A.in[20][(F.lane >> 2) & 15], dtb = A.in[21][(F.lane >> 2) & 15];
    const int mbeg = gw * rpw, cnt = (MTOT - mbeg) < rpw ? (MTOT - mbeg) : rpw;
    int r = 0;
    for (; r + 4 <= cnt; r += 4) cmb_rows<4>(F, A, mbeg + r, WabT, C, curb, alog, dtb);
    for (; r < cnt; ++r) cmb_rows<1>(F, A, mbeg + r, WabT, C, curb, alog, dtb);
    __syncthreads();
}

__device__ __forceinline__ void phase_conv(const Frame& F, const Args& A) {
    const int gw = F.vcu * NWAVES + F.wave, NGW = F.G * NWAVES;
    const bf16* P = (const bf16*)(A.ws + WS_PQKV); const float* cw = A.in[19];
    bf16* out0 = (bf16*)(A.ws + WS_QN);
    const int nchunk = NGW / 2, rpc = (MTOT + nchunk - 1) / nchunk;
    const int half = gw & 1, chunk = gw >> 1;
    const int mbeg = chunk * rpc, cnt = (MTOT - mbeg) < rpc ? (MTOT - mbeg) : rpc;
    if (cnt <= 0) return;
    float w[3][3][8];
#pragma unroll
    for (int ii = 0; ii < 3; ++ii) { const int c = 512 * (3 * half + ii) + 8 * F.lane;
#pragma unroll
        for (int j = 0; j < 3; ++j) { const f32x4 a = *(const f32x4*)(cw + j * 3072 + c), bq = *(const f32x4*)(cw + j * 3072 + c + 4);
            w[ii][j][0] = a.x; w[ii][j][1] = a.y; w[ii][j][2] = a.z; w[ii][j][3] = a.w; w[ii][j][4] = bq.x; w[ii][j][5] = bq.y; w[ii][j][6] = bq.z; w[ii][j][7] = bq.w; } }
    v4u xp[3], xc[3], xn[3], xnn[3];
    const int cbase = 512 * 3 * half + 8 * F.lane;
#pragma unroll
    for (int ii = 0; ii < 3; ++ii) { xp[ii] = (v4u){0u, 0u, 0u, 0u}; xc[ii] = *(const v4u*)(P + (size_t)mbeg * 3072 + cbase + 512 * ii); xn[ii] = (v4u){0u, 0u, 0u, 0u}; xnn[ii] = (v4u){0u, 0u, 0u, 0u}; }
    if (mbeg > 0) {
#pragma unroll
        for (int ii = 0; ii < 3; ++ii) xp[ii] = *(const v4u*)(P + (size_t)(mbeg - 1) * 3072 + cbase + 512 * ii); }
    if (mbeg + 1 < MTOT) {
#pragma unroll
        for (int ii = 0; ii < 3; ++ii) xn[ii] = *(const v4u*)(P + (size_t)(mbeg + 1) * 3072 + cbase + 512 * ii); }
    for (int r = 0; r < cnt; ++r) { const int m = mbeg + r;
        bool hp, hn; if (m < MLAT) { const int n = m & 4095; hp = n > 0; hn = n < SEQ - 1; } else { const int l = (m - MLAT) & 255; hp = l > 0; hn = l < CTXL - 1; }
        if (m + 2 < MTOT) {
#pragma unroll
            for (int ii = 0; ii < 3; ++ii) xnn[ii] = *(const v4u*)(P + (size_t)(m + 2) * 3072 + cbase + 512 * ii); }
#pragma unroll
        for (int ii = 0; ii < 3; ++ii) { const int i = 3 * half + ii;
            const v4u a = hp ? xp[ii] : (v4u){0u, 0u, 0u, 0u}, c = xc[ii], e = hn ? xn[ii] : (v4u){0u, 0u, 0u, 0u};
            float y[8];
            y[0] = bflo(a.x) * w[ii][0][0] + bflo(c.x) * w[ii][1][0] + bflo(e.x) * w[ii][2][0]; y[1] = bfhi(a.x) * w[ii][0][1] + bfhi(c.x) * w[ii][1][1] + bfhi(e.x) * w[ii][2][1];
            y[2] = bflo(a.y) * w[ii][0][2] + bflo(c.y) * w[ii][1][2] + bflo(e.y) * w[ii][2][2]; y[3] = bfhi(a.y) * w[ii][0][3] + bfhi(c.y) * w[ii][1][3] + bfhi(e.y) * w[ii][2][3];
            y[4] = bflo(a.z) * w[ii][0][4] + bflo(c.z) * w[ii][1][4] + bflo(e.z) * w[ii][2][4]; y[5] = bfhi(a.z) * w[ii][0][5] + bfhi(c.z) * w[ii][1][5] + bfhi(e.z) * w[ii][2][5];
            y[6] = bflo(a.w) * w[ii][0][6] + bflo(c.w) * w[ii][1][6] + bflo(e.w) * w[ii][2][6]; y[7] = bfhi(a.w) * w[ii][0][7] + bfhi(c.w) * w[ii][1][7] + bfhi(e.w) * w[ii][2][7];
            float ss = 0.f;
#pragma unroll
            for (int t = 0; t < 8; ++t) { y[t] = silu_f(y[t]); ss += y[t] * y[t]; }
            if (i < 4) { ss += __shfl_xor(ss, 1); ss += __shfl_xor(ss, 2); ss += __shfl_xor(ss, 4); ss += __shfl_xor(ss, 8);
                const float sc = (1.0f / sqrtf(ss + EPS)) * (i < 2 ? 0.08838834764831845f : 1.0f);
#pragma unroll
                for (int t = 0; t < 8; ++t) y[t] *= sc; }
            v4u o; o.x = pkbf(y[0], y[1]); o.y = pkbf(y[2], y[3]); o.z = pkbf(y[4], y[5]); o.w = pkbf(y[6], y[7]);
            *(v4u*)(out0 + (size_t)(i >> 1) * (68 * MiB / 2) + (size_t)m * D + ((512 * i + 8 * F.lane) & 1023)) = o;
            xp[ii] = xc[ii]; xc[ii] = xn[ii]; xn[ii] = xnn[ii];
        }
    }
}

constexpr int NCHK = 68, NTASK = NB * 8 * NCHK * 2;
constexpr int TAB_OFF = RING_BYTES + 1024;
typedef short s16x4 __attribute__((ext_vector_type(4)));
typedef short v4i16_t __attribute__((ext_vector_type(4)));
__device__ __forceinline__ size_t gdn_tok0(int b, int cidx) { return cidx < 4 ? (size_t)MLAT + b * CTXL + cidx * 64 : (size_t)b * SEQ + (size_t)(cidx - 4) * 64; }
__device__ __forceinline__ bf16x8 tr_pair(const LAS unsigned char* p, int rowstride4) {
    const s16x4 lo = __builtin_bit_cast(s16x4, __builtin_amdgcn_ds_read_tr16_b64_v4i16((LAS v4i16_t*)p));
    const s16x4 hi = __builtin_bit_cast(s16x4, __builtin_amdgcn_ds_read_tr16_b64_v4i16((LAS v4i16_t*)(p + rowstride4)));
    return (bf16x8){lo[0], lo[1], lo[2], lo[3], hi[0], hi[1], hi[2], hi[3]};
}
__device__ __forceinline__ void st_acc_T(LAS unsigned char* base, int stride, int col, int row0, const f32x16& a, int hh) {
#pragma unroll
    for (int rq = 0; rq < 4; ++rq) { v2u w; w.x = cvtpk(a[4 * rq], a[4 * rq + 1]); w.y = cvtpk(a[4 * rq + 2], a[4 * rq + 3]); *(LAS v2u*)(base + col * stride + (row0 + 8 * rq + 4 * hh) * 2) = w; }
}

__device__ __forceinline__ void phase_gdn_prep(const Frame& F, const Args& A) {
    const bf16* QN = (const bf16*)(A.ws + WS_QN); const bf16* KN = (const bf16*)(A.ws + WS_KN);
    const float* Gb = (const float*)(A.ws + WS_G); const float* Bb = (const float*)(A.ws + WS_BETA);
    bf16* TB = (bf16*)(A.ws + WS_TB); bf16* TG = (bf16*)(A.ws + WS_TG); bf16* QKD = (bf16*)(A.ws + WS_QKD); float* GC = (float*)(A.ws + WS_GC);
    LAS float* As = (LAS float*)(F.lds + F.wave * 16384);
    LAS float* tab = (LAS float*)(F.lds + TAB_OFF + F.wave * 512);
    const int gw = F.vcu * NWAVES + F.wave, NGW = F.G * NWAVES;
    for (int task = gw; task < NTASK; task += NGW) {
        int ln = F.lane; asm volatile("" : "+v"(ln));
        const int r = ln & 31, hh = ln >> 5;
        const int dir = task & 1, t2 = task >> 1, cidx = t2 % NCHK, bh = t2 / NCHK, h = bh & 7, b = bh >> 3;
        const size_t m0 = gdn_tok0(b, cidx);
        { const size_t mi = m0 + (dir ? 63 - ln : ln);
          float gc = Gb[mi * 16 + dir * 8 + h]; const float bt = Bb[mi * 16 + dir * 8 + h];
#pragma unroll
          for (int o = 1; o < 64; o <<= 1) { const float t = __shfl_up(gc, o); if (ln >= o) gc += t; }
          tab[ln] = gc; tab[64 + ln] = bt; GC[(size_t)task * 64 + ln] = gc; }
        bf16x8 kf[2][8], qf[2][8];
        LAS unsigned char* tl8 = (LAS unsigned char*)As;
        const int l4 = ln >> 4, l15 = ln & 15, rr = ln & 31, h2 = ln >> 5;
#pragma unroll
        for (int which = 0; which < 2; ++which) { const bf16* src = which ? KN : QN;
#pragma unroll
            for (int hb = 0; hb < 2; ++hb) { v4u st[8];
#pragma unroll
                for (int i = 0; i < 8; ++i) { const int row = 32 * hb + 4 * i + l4; const size_t m = m0 + (dir ? 63 - row : row); st[i] = *(const v4u*)(src + m * D + h * 128 + l15 * 8); }
#pragma unroll
                for (int i = 0; i < 8; ++i) { const int row = 32 * hb + 4 * i + l4; *(LAS v4u*)(tl8 + (row * 16 + (l15 ^ (row & 15))) * 16) = st[i]; }
                asm volatile("" ::: "memory"); }
            LDS_WAIT();
#pragma unroll
            for (int ti = 0; ti < 2; ++ti) { const int row = 32 * ti + rr;
#pragma unroll
                for (int s = 0; s < 8; ++s) { const bf16x8 f = *(const LAS bf16x8*)(tl8 + (row * 16 + ((2 * s + h2) ^ (row & 15))) * 16); if (which) kf[ti][s] = f; else qf[ti][s] = f; } }
            LDS_WAIT();
        }
#pragma unroll
        for (int tile = 0; tile < 3; ++tile) { const int ti = tile == 0 ? 0 : 1, tj = tile == 2 ? 1 : 0;
            f32x16 acc;
#pragma unroll
            for (int i = 0; i < 16; ++i) acc[i] = 0.f;
#pragma unroll
            for (int s = 0; s < 8; ++s) acc = MFMA32(kf[ti][s], kf[tj][s], acc);
            const int j = 32 * tj + r; const float gcj = tab[j];
#pragma unroll
            for (int i16 = 0; i16 < 16; ++i16) { const int i = 32 * ti + (i16 & 3) + 8 * (i16 >> 2) + 4 * hh;
                As[i * 64 + j] = (i > j) ? tab[64 + i] * acc[i16] * __expf(tab[i] - gcj) : 0.f; } }
        bf16* qkd = QKD + (size_t)task * 4096;
#pragma unroll
        for (int ti = 0; ti < 2; ++ti) { const int row = 32 * ti + r;
            const float gci = tab[row];
#pragma unroll
            for (int tj = 0; tj < 2; ++tj) {
                if (tj > ti) { *(v4u*)(qkd + row * 64 + 32 + 16 * hh) = (v4u){0u, 0u, 0u, 0u}; *(v4u*)(qkd + row * 64 + 32 + 16 * hh + 8) = (v4u){0u, 0u, 0u, 0u}; continue; }
                f32x16 acc;
#pragma unroll
                for (int i = 0; i < 16; ++i) acc[i] = 0.f;
#pragma unroll
                for (int s = 0; s < 8; ++s) acc = MFMA32(kf[tj][s], qf[ti][s], acc);
#pragma unroll
                for (int rq = 0; rq < 4; ++rq) { const int j0 = 32 * tj + 8 * rq + 4 * hh; float v[4];
#pragma unroll
                    for (int e = 0; e < 4; ++e) { const int j = j0 + e; v[e] = (row >= j) ? acc[4 * rq + e] * __expf(gci - tab[j]) : 0.f; }
                    v2u w; w.x = cvtpk(v[0], v[1]); w.y = cvtpk(v[2], v[3]); *(v2u*)(qkd + row * 64 + j0) = w; }
            } }
        LDS_WAIT();
        float Tc[64];
#pragma unroll
        for (int i = 0; i < 64; ++i) { float acc = (ln == i) ? 1.f : 0.f;
#pragma unroll
            for (int jq = 0; jq < (i + 3) / 4; ++jq) { const f32x4 a4 = *(const LAS f32x4*)(As + i * 64 + 4 * jq);
                if (4 * jq + 0 < i) acc -= a4.x * Tc[4 * jq + 0];
                if (4 * jq + 1 < i) acc -= a4.y * Tc[4 * jq + 1];
                if (4 * jq + 2 < i) acc -= a4.z * Tc[4 * jq + 2];
                if (4 * jq + 3 < i) acc -= a4.w * Tc[4 * jq + 3]; }
            Tc[i] = acc; }
        { const float sb = tab[64 + ln], sg = -sb * __expf(tab[ln]);
          bf16* tb = TB + (size_t)task * 4096 + ln; bf16* tg = TG + (size_t)task * 4096 + ln;
#pragma unroll
          for (int i = 0; i < 64; ++i) { tb[i * 64] = (bf16)(cvtpk(Tc[i] * sb, 0.f) & 0xffffu); tg[i * 64] = (bf16)(cvtpk(Tc[i] * sg, 0.f) & 0xffffu); } }
        LDS_WAIT();
    }
    if (F.G == 256 && F.vcu >= 64) tr_moe_items(F, A.in[26], A.in[27], A.in[28], A.ws + WS_WGU1, A.ws + WS_WD1, L1_ATT + L1_G2 + L1_WIN + L1_CMB, L1_ATT + L1_G2 + L1_WIN + L1_CMB + L1_PREP, (F.vcu - 64) * NWAVES + F.wave, 192 * NWAVES);
    else if (F.G != 256) tr_moe_items(F, A.in[26], A.in[27], A.in[28], A.ws + WS_WGU1, A.ws + WS_WD1, L1_ATT + L1_G2 + L1_WIN + L1_CMB, L1_ATT + L1_G2 + L1_WIN + L1_CMB + L1_PREP, F.vcu * NWAVES + F.wave, F.G * NWAVES);
}

constexpr int G_QS = 0, G_KS = 17408, G_VS = 37888, G_TBS = 50176, G_TGS = 59392, G_QKS = 68608, G_WS = 77824, G_SS = 95232, G_VNS = 112640, G_VSS = 121856;
constexpr int G_SQ = 272, G_SK = 320, G_SV = 192, G_ST = 144;
__device__ __forceinline__ void phase_gdn_scan(const Frame& F, const Args& A) {
    const bf16* QN = (const bf16*)(A.ws + WS_QN); const bf16* KN = (const bf16*)(A.ws + WS_KN); const bf16* VV = (const bf16*)(A.ws + WS_VV);
    const bf16* TB = (const bf16*)(A.ws + WS_TB); const bf16* TG = (const bf16*)(A.ws + WS_TG); const bf16* QKD = (const bf16*)(A.ws + WS_QKD); const float* GC = (const float*)(A.ws + WS_GC);
    bf16* OF = (bf16*)A.out; bf16* OB = OF + (size_t)MLAT * D;
    LAS unsigned char* L = F.lds; LAS float* tab = (LAS float*)(F.lds + TAB_OFF);
    const int w = F.wave, r = F.lane & 31, hh = F.lane >> 5, g16 = F.lane >> 4, q4 = (F.lane & 15) >> 2, p4 = F.lane & 3;
    const int dkt = w >> 1, tt1 = w & 1, dvtS = w & 1;
    const int ttv = (w & 3) >> 1, dvtv = w & 1;
    const int dvto = (w & 3) >> 1, tto = w & 1;
    const int trrow = 8 * (g16 >> 1) + q4, trcol = 16 * (g16 & 1) + 4 * p4;
    for (int unit = F.vcu; unit < 256; unit += F.G) {
        const int half = unit & 1, dir = (unit >> 1) & 1, h = (unit >> 2) & 7, b = unit >> 5;
        bf16* O = dir ? OB : OF;
        f32x16 accS;
#pragma unroll
        for (int i = 0; i < 16; ++i) accS[i] = 0.f;
        v4u pre[8]; float gcv = 0.f, gcl = 0.f;
#define GDN_LOAD(S_) do { const int cidx_ = dir ? ((S_) < 4 ? 3 - (S_) : 71 - (S_)) : (S_); const size_t m0_ = gdn_tok0(b, cidx_); const size_t task_ = ((size_t)((b * 8 + h) * NCHK + cidx_)) * 2 + dir; \
        _Pragma("unroll") for (int e_ = 0; e_ < 2; ++e_) { const int ci_ = F.tid + 512 * e_, row_ = ci_ >> 4, c16_ = ci_ & 15; const size_t m_ = m0_ + (dir ? 63 - row_ : row_); \
            pre[e_] = *(const v4u*)(QN + m_ * D + h * 128 + c16_ * 8); pre[2 + e_] = *(const v4u*)(KN + m_ * D + h * 128 + c16_ * 8); } \
        { const int row_ = F.tid >> 3, c16_ = F.tid & 7; const size_t m_ = m0_ + (dir ? 63 - row_ : row_); pre[4] = *(const v4u*)(VV + m_ * D + h * 128 + half * 64 + c16_ * 8); \
          pre[5] = *(const v4u*)(TB + task_ * 4096 + F.tid * 8); pre[6] = *(const v4u*)(TG + task_ * 4096 + F.tid * 8); pre[7] = *(const v4u*)(QKD + task_ * 4096 + F.tid * 8); } \
        gcv = GC[task_ * 64 + (F.tid & 63)]; gcl = GC[task_ * 64 + 63]; } while (0)
#define GDN_STAGE() do { \
        _Pragma("unroll") for (int e_ = 0; e_ < 2; ++e_) { const int ci_ = F.tid + 512 * e_, row_ = ci_ >> 4, c16_ = ci_ & 15; \
            *(LAS v4u*)(L + G_QS + row_ * G_SQ + c16_ * 16) = pre[e_]; *(LAS v4u*)(L + G_KS + row_ * G_SK + c16_ * 16) = pre[2 + e_]; } \
        { const int row_ = F.tid >> 3, c16_ = F.tid & 7; *(LAS v4u*)(L + G_VS + row_ * G_SV + c16_ * 16) = pre[4]; \
          *(LAS v4u*)(L + G_TBS + row_ * G_ST + c16_ * 16) = pre[5]; *(LAS v4u*)(L + G_TGS + row_ * G_ST + c16_ * 16) = pre[6]; *(LAS v4u*)(L + G_QKS + row_ * G_ST + c16_ * 16) = pre[7]; } \
        if (F.tid < 64) { tab[F.tid] = __expf(gcv); tab[64 + F.tid] = __expf(gcl - gcv); if (F.tid == 0) tab[128] = __expf(gcl); } } while (0)
#define GDN_STAGE_A() do { \
        _Pragma("unroll") for (int e_ = 0; e_ < 2; ++e_) { const int ci_ = F.tid + 512 * e_, row_ = ci_ >> 4, c16_ = ci_ & 15; *(LAS v4u*)(L + G_KS + row_ * G_SK + c16_ * 16) = pre[2 + e_]; } \
        { const int row_ = F.tid >> 3, c16_ = F.tid & 7; *(LAS v4u*)(L + G_VS + row_ * G_SV + c16_ * 16) = pre[4]; \
          *(LAS v4u*)(L + G_TBS + row_ * G_ST + c16_ * 16) = pre[5]; *(LAS v4u*)(L + G_TGS + row_ * G_ST + c16_ * 16) = pre[6]; } } while (0)
#define GDN_STAGE_B() do { \
        _Pragma("unroll") for (int e_ = 0; e_ < 2; ++e_) { const int ci_ = F.tid + 512 * e_, row_ = ci_ >> 4, c16_ = ci_ & 15; *(LAS v4u*)(L + G_QS + row_ * G_SQ + c16_ * 16) = pre[e_]; } \
        { const int row_ = F.tid >> 3, c16_ = F.tid & 7; *(LAS v4u*)(L + G_QKS + row_ * G_ST + c16_ * 16) = pre[7]; } \
        if (F.tid < 64) { tab[F.tid] = __expf(gcv); tab[64 + F.tid] = __expf(gcl - gcv); if (F.tid == 0) tab[128] = __expf(gcl); } } while (0)
        GDN_LOAD(0); GDN_STAGE();
        __syncthreads();
        for (int s = 0; s < NCHK; ++s) {
            const int cidx = dir ? (s < 4 ? 3 - s : 71 - s) : s; const size_t m0 = gdn_tok0(b, cidx);
            if (s + 1 < NCHK) GDN_LOAD(s + 1);
            bf16x8 kT[4];
#pragma unroll
            for (int ks = 0; ks < 4; ++ks) kT[ks] = tr_pair(L + G_KS + (16 * ks + trrow) * G_SK + (32 * dkt + trcol) * 2, 4 * G_SK);
            { f32x16 accw;
#pragma unroll
              for (int i = 0; i < 16; ++i) accw[i] = 0.f;
#pragma unroll
              for (int ks = 0; ks < 4; ++ks) { const bf16x8 bq = *(const LAS bf16x8*)(L + G_TGS + (32 * tt1 + r) * G_ST + (16 * ks + 8 * hh) * 2); accw = MFMA32(kT[ks], bq, accw); }
              st_acc_T(L + G_WS, G_SQ, 32 * tt1 + r, 32 * dkt, accw, hh); }
            f32x16 accv;
#pragma unroll
            for (int i = 0; i < 16; ++i) accv[i] = 0.f;
            if (w < 4) {
#pragma unroll
                for (int ks = 0; ks < 4; ++ks) { const bf16x8 a = *(const LAS bf16x8*)(L + G_TBS + (32 * ttv + r) * G_ST + (16 * ks + 8 * hh) * 2);
                    const bf16x8 bv = tr_pair(L + G_VS + (16 * ks + trrow) * G_SV + (32 * dvtv + trcol) * 2, 4 * G_SV); accv = MFMA32(a, bv, accv); }
            }
            st_acc_T(L + G_SS, G_SQ, 32 * dvtS + r, 32 * dkt, accS, hh);
            __syncthreads();
            if (s + 1 < NCHK) GDN_STAGE_A();
            f32x16 acco;
#pragma unroll
            for (int i = 0; i < 16; ++i) acco[i] = 0.f;
            if (w < 4) {
#pragma unroll
                for (int ks = 0; ks < 8; ++ks) { const bf16x8 a = *(const LAS bf16x8*)(L + G_WS + (32 * ttv + r) * G_SQ + (16 * ks + 8 * hh) * 2);
                    const bf16x8 bs = *(const LAS bf16x8*)(L + G_SS + (32 * dvtv + r) * G_SQ + (16 * ks + 8 * hh) * 2); accv = MFMA32(a, bs, accv); }
                st_acc_T(L + G_VNS, G_ST, 32 * dvtv + r, 32 * ttv, accv, hh);
                f32x16 sc;
#pragma unroll
                for (int rq = 0; rq < 4; ++rq) { const f32x4 e4 = *(const LAS f32x4*)(tab + 64 + 32 * ttv + 8 * rq + 4 * hh);
                    sc[4 * rq] = accv[4 * rq] * e4.x; sc[4 * rq + 1] = accv[4 * rq + 1] * e4.y; sc[4 * rq + 2] = accv[4 * rq + 2] * e4.z; sc[4 * rq + 3] = accv[4 * rq + 3] * e4.w; }
                st_acc_T(L + G_VSS, G_ST, 32 * dvtv + r, 32 * ttv, sc, hh);
            } else {
#pragma unroll
                for (int ks = 0; ks < 8; ++ks) { const bf16x8 a = *(const LAS bf16x8*)(L + G_SS + (32 * dvto + r) * G_SQ + (16 * ks + 8 * hh) * 2);
                    const bf16x8 bq = *(const LAS bf16x8*)(L + G_QS + (32 * tto + r) * G_SQ + (16 * ks + 8 * hh) * 2); acco = MFMA32(a, bq, acco); }
                const float egi = tab[32 * tto + r];
#pragma unroll
                for (int i = 0; i < 16; ++i) acco[i] *= egi;
            }
            __syncthreads();
            if (w >= 4) {
#pragma unroll
                for (int ks = 0; ks < 4; ++ks) { const bf16x8 a = *(const LAS bf16x8*)(L + G_VNS + (32 * dvto + r) * G_ST + (16 * ks + 8 * hh) * 2);
                    const bf16x8 bq = *(const LAS bf16x8*)(L + G_QKS + (32 * tto + r) * G_ST + (16 * ks + 8 * hh) * 2); acco = MFMA32(a, bq, acco); }
                if (cidx >= 4) { const int i = 32 * tto + r; const size_t m = m0 + (dir ? 63 - i : i);
                    bf16* op = O + m * D + h * 128 + half * 64 + 32 * dvto + 4 * hh;
#pragma unroll
                    for (int rq = 0; rq < 4; ++rq) { v2u ww; ww.x = cvtpk(acco[4 * rq], acco[4 * rq + 1]); ww.y = cvtpk(acco[4 * rq + 2], acco[4 * rq + 3]); *(v2u*)(op + 8 * rq) = ww; } }
            }
            { const float egl = tab[128];
#pragma unroll
              for (int i = 0; i < 16; ++i) accS[i] *= egl;
#pragma unroll
              for (int ks = 0; ks < 4; ++ks) { const bf16x8 bv = *(const LAS bf16x8*)(L + G_VSS + (32 * dvtS + r) * G_ST + (16 * ks + 8 * hh) * 2); accS = MFMA32(kT[ks], bv, accS); } }
            __syncthreads();
            if (s + 1 < NCHK) GDN_STAGE_B();
        }
        __syncthreads();
#undef GDN_LOAD
#undef GDN_STAGE
#undef GDN_STAGE_A
#undef GDN_STAGE_B
    }
}

__device__ __forceinline__ void phase_readout(const Frame& F, const Args& A) {
    const int gw = F.vcu * NWAVES + F.wave, NGW = F.G * NWAVES;
    const bf16* OF = (const bf16*)A.out; const bf16* OB = OF + (size_t)MLAT * D; const bf16* Z = (const bf16*)(A.ws + WS_Z); bf16* RO = (bf16*)(A.ws + WS_RO);
    const f32x4 on = ((const f32x4*)A.in[22])[F.lane & 31];
    const int rpw = (MLAT + NGW - 1) / NGW;
    const int mbeg = gw * rpw, cnt = (MLAT - mbeg) < rpw ? (MLAT - mbeg) : rpw;
    for (int r = 0; r < cnt; r += 2) {
        v2u wf[2][4], wb[2][4], zw[2][4];
#pragma unroll
        for (int t = 0; t < 2; ++t) { const int m = mbeg + ((r + t < cnt) ? r + t : r);
#pragma unroll
            for (int j = 0; j < 4; ++j) { wf[t][j] = ((const v2u*)(OF + (size_t)m * D))[F.lane + 64 * j]; wb[t][j] = ((const v2u*)(OB + (size_t)m * D))[F.lane + 64 * j]; zw[t][j] = ((const v2u*)(Z + (size_t)m * D))[F.lane + 64 * j]; } }
#pragma unroll
        for (int t = 0; t < 2; ++t) { const int m = mbeg + r + t;
            f32x4 v[4];
#pragma unroll
            for (int j = 0; j < 4; ++j) {
                v[j] = (f32x4){bflo(wf[t][j].x) + bflo(wb[t][j].x), bfhi(wf[t][j].x) + bfhi(wb[t][j].x), bflo(wf[t][j].y) + bflo(wb[t][j].y), bfhi(wf[t][j].y) + bfhi(wb[t][j].y)};
                float ss = (v[j].x * v[j].x + v[j].y * v[j].y) + (v[j].z * v[j].z + v[j].w * v[j].w);
                ss += __shfl_xor(ss, 1); ss += __shfl_xor(ss, 2); ss += __shfl_xor(ss, 4); ss += __shfl_xor(ss, 8); ss += __shfl_xor(ss, 16);
                const float rs = 1.0f / sqrtf(ss * (1.0f / 128.0f) + EPS);
                v[j].x = v[j].x * rs * on.x * silu_f(bflo(zw[t][j].x)); v[j].y = v[j].y * rs * on.y * silu_f(bfhi(zw[t][j].x)); v[j].z = v[j].z * rs * on.z * silu_f(bflo(zw[t][j].y)); v[j].w = v[j].w * rs * on.w * silu_f(bfhi(zw[t][j].y)); }
            if (r + t < cnt) store_row_bf16(RO + (size_t)m * D, v, F.lane); }
    }
}


struct EpiNull { static constexpr bool PERM = false, AFTER_DRAIN = false; float* sink;
    __device__ __forceinline__ void operator()(const f32x4 (&acc)[2][2][4][2], const pg8::Unit&, int, int, int, int) const { float s = 0.f;
#pragma unroll
        for (int a = 0; a < 2; ++a)
#pragma unroll
            for (int b = 0; b < 2; ++b)
#pragma unroll
                for (int mm = 0; mm < 4; ++mm)
#pragma unroll
                    for (int n = 0; n < 2; ++n) s += acc[a][b][mm][n][0] + acc[a][b][mm][n][3];
        if (s == 12345.678f) sink[threadIdx.x] = s; }
};
struct ProbeOrder { int nunits, nM, G, c, mode;
    __device__ void init(int nunits_, int nM_, int G_, int c_, int mode_) { nunits = nunits_; nM = nM_; G = G_; c = c_; mode = mode_; }
    __device__ bool next(int i, pg8::Unit& u) const { const int L = i * G + c; if (L >= nunits) return false; if (mode == 0) { u.pm = L % nM; u.pn = L / nM; } else if (mode == 1) { u.pm = 0; u.pn = 0; } else { u.pm = L % nM; u.pn = 0; } return true; }
    __device__ __forceinline__ void a_ready(const pg8::Unit&) const {}
    __device__ __forceinline__ void done(const pg8::Unit&) const {}
    __device__ __forceinline__ const char* aptr(const pg8::Gemm& g, const pg8::Unit& u, size_t tstep) const { return (const char*)g.A + (size_t)u.pm * tstep; }
    __device__ __forceinline__ const char* bptr(const pg8::Gemm& g, const pg8::Unit& u, size_t tstep) const { return (const char*)g.Bt + (size_t)u.pn * tstep; }
};
__device__ __forceinline__ void phase_final(const Frame& F, const Args& A) {
    const int gw = F.vcu * NWAVES + F.wave, NGW = F.G * NWAVES;
    const float* MOD1 = (const float*)(A.ws + WS_MOD) + 9 * 6144;
    const bf16* XRES = (const bf16*)(A.ws + WS_XRES); const bf16* Y = (const bf16*)(A.ws + WS_XG); const int* SLOT = (const int*)(A.ws + WS_SLOT);
    f32x4 fg[4];
#pragma unroll
    for (int j = 0; j < 4; ++j) fg[j] = ((const f32x4*)A.in[29])[F.lane + 64 * j];
    const int rpw = (MLAT + NGW - 1) / NGW;
    const int mbeg = gw * rpw, cnt = (MLAT - mbeg) < rpw ? (MLAT - mbeg) : rpw;
    for (int r = 0; r < cnt; r += 2) {
        f32x4 vv[2][4]; CombineIn ci[2];
#pragma unroll
        for (int t = 0; t < 2; ++t) { const int m = mbeg + ((r + t < cnt) ? r + t : r); combine_issue(ci[t], XRES + (size_t)m * D, SLOT + (size_t)m * 16, F.lane); }
#pragma unroll
        for (int t = 0; t < 2; ++t) { const int m = mbeg + ((r + t < cnt) ? r + t : r);
            combine_finish(vv[t], ci[t], Y, (const float*)(A.ws + WS_GW), MOD1 + (size_t)(m >> 12) * 6144 + 5 * 1024, F.lane); }
#pragma unroll
        for (int t = 0; t < 2; ++t) { const int m = mbeg + r + t; const float rstd = row_rstd(vv[t]);
            if (r + t < cnt) {
#pragma unroll
                for (int j = 0; j < 4; ++j) ((f32x4*)(A.out + (size_t)m * D))[F.lane + 64 * j] = vv[t][j] * rstd * fg[j]; } }
    }
}

#ifndef MK_ONE_LAUNCH
#define MK_ONE_LAUNCH 1
#endif
__global__ void __launch_bounds__(NWAVES * 64, 2) fwd_kernel(Args args) {
    extern __shared__ __attribute__((aligned(16))) unsigned char lds[];
    Frame F;
    F.lds = (LAS unsigned char*)lds;
    F.MISC = (volatile LAS unsigned*)(F.lds + MISC_OFF);
    F.tid = threadIdx.x; F.lane = F.tid & 63; F.wave = __builtin_amdgcn_readfirstlane(F.tid >> 6);
    F.G = gridDim.x; { const int bx = blockIdx.x; F.vcu = (F.G % 8 == 0) ? (bx % 8) * (F.G / 8) + bx / 8 : bx; }
    unsigned char* ws = args.ws;
    gu32* ctl = (gu32*)(ws + WS_CTL);
    for (int u = F.tid; u < (LDS_BYTES - LDSCTL_OFF) / 4; u += NWAVES * 64) ((LAS unsigned*)(F.lds + LDSCTL_OFF))[u] = 0u;
    __syncthreads();
    XcdBarrier bar; bar.bar = (unsigned*)(ctl + CW_BAR); bar.x = 0; bar.st = nullptr;
    const int lo = args.ph_lo, hi = args.ph_hi;
    if (hi - lo > 1) bar = xcd_barrier_post((unsigned*)(ctl + CW_BAR), F.MISC + 8);
#ifndef PROBE_REP
#define PROBE_REP 0u
#endif
#define IN(k) (lo <= (k) && (k) < hi)
#define SEAM(k) do { if (IN(k) && IN((k) + 1)) xcd_barrier(bar); } while (0)

    const float* MOD0 = (const float*)(ws + WS_MOD); const float* MOD1 = MOD0 + 9 * 6144;
    bf16* XRES = (bf16*)(ws + WS_XRES);

    if (IN(0)) { phase_prologue(F, args); } SEAM(0);
    if (IN(1)) { phase_modnorm0(F, args); } SEAM(1);
    if (IN(2)) {
        pg8::Gemm g{(const pg8::bf16_t*)(ws + WS_H), (const pg8::bf16_t*)(ws + WS_WQKV), MTOT, NQKV, D}; QKVOrder S; S.init(F.G, (int)blockIdx.x);
        EpiQKV E{(bf16*)(ws + WS_Q), (bf16*)(ws + WS_K), (bf16*)(ws + WS_V), (const float*)(ws + WS_ROPE), (const float*)(ws + WS_ROPE) + 1024, QSCALE};
        pg8::gemm_phase<EpiQKV, QKVOrder, true, true>(F.lds, g, S, E);
        if (F.G == 256) { const int lid = (int)blockIdx.x / 8, x = (int)blockIdx.x % 8;
            if (lid >= 6) tr_moe_items(F, args.in[12], args.in[13], args.in[14], ws + WS_WGU, ws + WS_WD, L0_PRO, L0_PRO + L0_QKV, (x * 26 + lid - 6) * NWAVES + F.wave, 208 * NWAVES); }
        else tr_moe_items(F, args.in[12], args.in[13], args.in[14], ws + WS_WGU, ws + WS_WD, L0_PRO, L0_PRO + L0_QKV, F.vcu * NWAVES + F.wave, F.G * NWAVES);
    } SEAM(2);
    if (IN(3)) { phase_attn_v2(F, args); } SEAM(3);
    if (IN(4)) {
        pg8::Gemm g{(const pg8::bf16_t*)(ws + WS_ATT), (const pg8::bf16_t*)(ws + WS_WO0), MTOT, D, D}; pg8::StaticOrder S; S.init(MTOT, D, F.G, (int)blockIdx.x);
        EpiResid<false> E{args.in[0], args.in[2], XRES, MOD0 + 2 * 1024};
        pg8::gemm_phase<EpiResid<false>, pg8::StaticOrder, true, true>(F.lds, g, S, E);
        if (F.G == 256) { if (blockIdx.x >= 32) tr_moe_items(F, args.in[12], args.in[13], args.in[14], ws + WS_WGU, ws + WS_WD, L0_PRO + L0_QKV, L0_PRO + L0_QKV + L0_WO, ((int)blockIdx.x - 32) * NWAVES + F.wave, 224 * NWAVES); }
        else tr_moe_items(F, args.in[12], args.in[13], args.in[14], ws + WS_WGU, ws + WS_WD, L0_PRO + L0_QKV, L0_PRO + L0_QKV + L0_WO, F.vcu * NWAVES + F.wave, F.G * NWAVES);
    } SEAM(4);
    if (IN(5)) { phase_norm_router(F, args, XRES, MTOT, args.in[10], MOD0, args.in[11]); } SEAM(5);
    if (IN(6)) { phase_topk(F, args, true, EROWS0, args.in[12], args.in[13], args.in[14], ws + WS_WGU, ws + WS_WD, IT_MOE - L0_TOPK, IT_MOE); } SEAM(6);
    if (IN(7)) {
        pg8::Gemm g{(const pg8::bf16_t*)(ws + WS_XG), (const pg8::bf16_t*)(ws + WS_WGU), NE * EROWS0, NE * 4096, D / 2}; GroupOrder<EROWS0 / 256, 16> S; S.init(F.G, (int)blockIdx.x);
        EpiSwiGLU E{ws + WS_HID};
        pg8::gemm_phase<EpiSwiGLU, decltype(S), true, true, true>(F.lds, g, S, E);
    } SEAM(7);
    if (IN(8)) {
        pg8::Gemm g{(const pg8::bf16_t*)(ws + WS_HID), (const pg8::bf16_t*)(ws + WS_WD), NE * EROWS0, NE * 1024, FF / 2}; GroupOrder<EROWS0 / 256, 4> S; S.init(F.G, (int)blockIdx.x);
        EpiY E{(bf16*)(ws + WS_XG)};
        pg8::gemm_phase<EpiY, decltype(S), true, true, true>(F.lds, g, S, E);
        if (F.G == 256) { const int lid = (int)blockIdx.x / 8, x = (int)blockIdx.x % 8;
            if (lid >= 8) tr_moe_items(F, args.in[26], args.in[27], args.in[28], ws + WS_WGU1, ws + WS_WD1, L1_ATT, L1_ATT + L1_G2, (x * 24 + lid - 8) * NWAVES + F.wave, 192 * NWAVES); }
        else tr_moe_items(F, args.in[26], args.in[27], args.in[28], ws + WS_WGU1, ws + WS_WD1, L1_ATT, L1_ATT + L1_G2, F.vcu * NWAVES + F.wave, F.G * NWAVES);
    } SEAM(8);
    if (IN(9)) { phase_combine0(F, args); } SEAM(9);
    if (IN(10)) {
        pg8::Gemm g{(const pg8::bf16_t*)(ws + WS_H), (const pg8::bf16_t*)(ws + WS_WIN), MTOT, NWIN, D}; pg8::StaticOrder S; S.init(MTOT, NWIN, F.G, (int)blockIdx.x);
        EpiP E{(bf16*)(ws + WS_PQKV), (bf16*)(ws + WS_Z)};
        pg8::gemm_phase<EpiP, pg8::StaticOrder, true, true>(F.lds, g, S, E);
        if (F.G == 256) { if (blockIdx.x >= 128) tr_moe_items(F, args.in[26], args.in[27], args.in[28], ws + WS_WGU1, ws + WS_WD1, L1_ATT + L1_G2, L1_ATT + L1_G2 + L1_WIN, ((int)blockIdx.x - 128) * NWAVES + F.wave, 128 * NWAVES); }
        else tr_moe_items(F, args.in[26], args.in[27], args.in[28], ws + WS_WGU1, ws + WS_WD1, L1_ATT + L1_G2, L1_ATT + L1_G2 + L1_WIN, F.vcu * NWAVES + F.wave, F.G * NWAVES);
    } SEAM(10);
    if (IN(11)) { phase_conv(F, args); } SEAM(11);
    if (IN(12)) { phase_gdn_prep(F, args); } SEAM(12);
    if (IN(13)) { phase_gdn_scan(F, args); } SEAM(13);
    if (IN(14)) { phase_readout(F, args); } SEAM(14);
    if (IN(15)) {
        pg8::Gemm g{(const pg8::bf16_t*)(ws + WS_RO), (const pg8::bf16_t*)(ws + WS_WO1), MLAT, D, D}; pg8::StaticOrder S; S.init(MLAT, D, F.G, (int)blockIdx.x);
        EpiResid<true> E{XRES, XRES + (size_t)MLAT * D, XRES, MOD1 + 2 * 1024};
        pg8::gemm_phase<EpiResid<true>, pg8::StaticOrder, true, true>(F.lds, g, S, E);
    } SEAM(15);
    if (IN(16)) { phase_norm_router(F, args, XRES, MLAT, args.in[24], MOD1, args.in[25]); } SEAM(16);
    if (IN(17)) { phase_topk(F, args, false, EROWS1, args.in[26], args.in[27], args.in[28], ws + WS_WGU1, ws + WS_WD1, IT_MOE - L1_TOPK, IT_MOE); } SEAM(17);
    if (IN(18)) {
        pg8::Gemm g{(const pg8::bf16_t*)(ws + WS_XG), (const pg8::bf16_t*)(ws + WS_WGU1), NE * EROWS1, NE * 4096, D / 2}; GroupOrder<EROWS1 / 256, 16> S; S.init(F.G, (int)blockIdx.x);
        EpiSwiGLU E{ws + WS_HID};
        pg8::gemm_phase<EpiSwiGLU, decltype(S), true, true, true>(F.lds, g, S, E);
    } SEAM(18);
    if (IN(19)) {
        pg8::Gemm g{(const pg8::bf16_t*)(ws + WS_HID), (const pg8::bf16_t*)(ws + WS_WD1), NE * EROWS1, NE * 1024, FF / 2}; GroupOrder<EROWS1 / 256, 4> S; S.init(F.G, (int)blockIdx.x);
        EpiY E{(bf16*)(ws + WS_XG)};
        pg8::gemm_phase<EpiY, decltype(S), true, true, true>(F.lds, g, S, E);
    } SEAM(19);
    if (IN(20)) { phase_final(F, args); }
#ifdef PROBE_GEMM
    if (IN(21)) {
        EpiNull E{(float*)(ws + 960 * MiB)};
#if PROBE_GEMM == 1 || PROBE_GEMM == 2 || PROBE_GEMM == 7
        { pg8::Gemm g{(const pg8::bf16_t*)(ws + WS_H), (const pg8::bf16_t*)(ws + WS_WIN), MTOT, NWIN, D}; ProbeOrder S; S.init(2176, 136, F.G, (int)blockIdx.x, PROBE_GEMM == 1 ? 0 : (PROBE_GEMM == 2 ? 1 : 2));
          pg8::gemm_phase<EpiNull, ProbeOrder, true, true>(F.lds, g, S, E); }
#elif PROBE_GEMM == 8 || PROBE_GEMM == 9
        { pg8::Gemm g{(const pg8::bf16_t*)(ws + WS_H), (const pg8::bf16_t*)(ws + WS_WIN), MTOT, NWIN, PROBE_GEMM == 8 ? 512 : 256}; ProbeOrder S; S.init(2176, 136, F.G, (int)blockIdx.x, 1);
          pg8::gemm_phase<EpiNull, ProbeOrder, true, true>(F.lds, g, S, E); }
#elif PROBE_GEMM == 10 || PROBE_GEMM == 11
        { pg8::Gemm g{(const pg8::bf16_t*)(ws + WS_XG), (const pg8::bf16_t*)(ws + WS_WGU), NE * EROWS0, NE * 4096, PROBE_GEMM == 10 ? 256 : 1024}; ProbeOrder S; S.init(4352, 272, F.G, (int)blockIdx.x, 1);
          pg8::gemm_phase<EpiNull, ProbeOrder, true, true, true>(F.lds, g, S, E); }
#elif PROBE_GEMM == 3 || PROBE_GEMM == 4
        { pg8::Gemm g{(const pg8::bf16_t*)(ws + WS_HID), (const pg8::bf16_t*)(ws + WS_WD), NE * EROWS0, NE * 1024, FF / 2}; ProbeOrder S; S.init(1088, 272, F.G, (int)blockIdx.x, PROBE_GEMM == 3 ? 0 : 1);
          pg8::gemm_phase<EpiNull, ProbeOrder, true, true, true>(F.lds, g, S, E); }
#elif PROBE_GEMM == 5 || PROBE_GEMM == 6
        { pg8::Gemm g{(const pg8::bf16_t*)(ws + WS_XG), (const pg8::bf16_t*)(ws + WS_WGU), NE * EROWS0, NE * 4096, D / 2}; ProbeOrder S; S.init(4352, 272, F.G, (int)blockIdx.x, PROBE_GEMM == 5 ? 0 : 1);
          pg8::gemm_phase<EpiNull, ProbeOrder, true, true, true>(F.lds, g, S, E); }
#endif
    }
#endif
#undef IN
#undef SEAM
}

extern "C" void kernel_launch(void* const* d_in, const int* in_sizes, int n_in, void* d_out, int out_size, void* d_ws, size_t ws_size, hipStream_t stream) {
    static int grid = 0;
    if (grid == 0) {
        if (n_in != 30 || in_sizes[0] != MLAT * D || out_size != MLAT * D || ws_size < WS_END) { fprintf(stderr, "kernel_launch: unexpected shapes (n_in %d, in0 %d, out %d, ws %zu); nothing launched\n", n_in, n_in > 0 ? in_sizes[0] : -1, out_size, ws_size); grid = -1; return; }
        int dev = 0, cus = 0, per_cu = 0;
        if (hipGetDevice(&dev) != hipSuccess || hipDeviceGetAttribute(&cus, hipDeviceAttributeMultiprocessorCount, dev) != hipSuccess) { grid = -1; return; }
        if (hipFuncSetAttribute((const void*)fwd_kernel, hipFuncAttributeMaxDynamicSharedMemorySize, LDS_BYTES) != hipSuccess) { fprintf(stderr, "kernel_launch: hipFuncSetAttribute failed\n"); grid = -1; return; }
        if (hipOccupancyMaxActiveBlocksPerMultiprocessor(&per_cu, (const void*)fwd_kernel, NWAVES * 64, LDS_BYTES) != hipSuccess || per_cu < 1) { fprintf(stderr, "kernel_launch: occupancy query says %d blocks per CU\n", per_cu); }
        (void)hipGetLastError();
        grid = cus;
        if (grid % 8 != 0) { fprintf(stderr, "kernel_launch: CU count %d is not a multiple of 8\n", grid); grid = -1; return; }
    }
    if (grid < 0) return;
    if (hipMemsetAsync((char*)d_ws + WS_CTL, 0, CTL_ZERO_BYTES, stream) != hipSuccess) return;
    Args a{};
    for (int i = 0; i < 30; ++i) a.in[i] = (const float*)d_in[i];
    a.out = (float*)d_out; a.ws = (unsigned char*)d_ws;
#if MK_ONE_LAUNCH
    a.ph_lo = 0; a.ph_hi = NPH;
    hipLaunchKernelGGL(fwd_kernel, dim3(grid), dim3(NWAVES * 64), LDS_BYTES, stream, a);
#else
#ifdef PROBE_GEMM
    const int nph_launch = NPH + 1;
#else
    const int nph_launch = NPH;
#endif
    for (int p = 0; p < nph_launch; ++p) for (int rep = 0; rep < (((PROBE_REP >> p) & 1u) ? 2 : 1); ++rep) { a.ph_lo = p; a.ph_hi = p + 1; hipLaunchKernelGGL(fwd_kernel, dim3(grid), dim3(NWAVES * 64), LDS_BYTES, stream, a); }
#endif
}
```

```cpp
#include <hip/hip_runtime.h>
#include <cstdio>
#include <cstdint>
#define MK_ONE_LAUNCH 1
namespace pg8 {
#define PG8_LAS __attribute__((address_space(3)))
typedef unsigned short bf16_t;
typedef short bf16x8 __attribute__((ext_vector_type(8)));
typedef float f32x4 __attribute__((ext_vector_type(4)));
typedef unsigned u32x4 __attribute__((ext_vector_type(4)));
constexpr int BM = 256, BK = 64, HALF = 128, HTB = HALF * BK * 2  , STAGE_BYTES = 8 * HTB, NXCD = 8, WGM = 8;

__host__ __device__ __forceinline__ int lds_byte(int r, int c) { const int st = (r >> 4) * 2 + (c >> 5), rr = r & 15, cc = c & 31, ob = rr * 64 + cc * 2; return st * 1024 + (ob ^ (((ob >> 9) & 1) << 5)); }
__host__ __device__ __forceinline__ void stage_rc(int b, int& R, int& C) { const int st = b / 1024, sb = b % 1024, swz = sb ^ (((sb >> 9) & 1) << 5); R = (st >> 1) * 16 + swz / 64; C = (st & 1) * 32 + (swz % 64) / 2; }
__host__ __device__ __forceinline__ int perm32(int rho) { const int n = rho >> 4, i = rho & 15; return 8 * (i >> 2) + 4 * n + (i & 3); }

struct Unit { int pm, pn; };
struct Gemm { const bf16_t* A; const bf16_t* Bt; int M, N, K; };

struct StaticOrder {
    int nM, nN, nwg, G, c;
    __host__ __device__ void init(int M, int N, int G_, int c_) { nM = M / BM; nN = N / BM; nwg = nM * nN; G = G_; c = c_; }
    __host__ __device__ bool next(int i, Unit& u) const {
        const long L = (long)i * G + c; if (L >= nwg) return false;
        int wgid = (int)L; { const int q = nwg / NXCD, r = nwg % NXCD, xcd = wgid % NXCD, off = wgid / NXCD; wgid = (xcd < r ? xcd * (q + 1) : r * (q + 1) + (xcd - r) * q) + off; }
        const int nig = WGM * nN, gid = wgid / nig, fm = gid * WGM, gsz = (nM - fm) < WGM ? (nM - fm) : WGM;
        u.pm = fm + ((wgid % nig) % gsz); u.pn = (wgid % nig) / gsz; return true;
    }
    __device__ __forceinline__ void a_ready(const Unit&) const {}
    __device__ __forceinline__ void done(const Unit&) const {}
    __device__ __forceinline__ const char* aptr(const Gemm& g, const Unit& u, size_t tstep) const { return (const char*)g.A + (size_t)u.pm * tstep; }
    __device__ __forceinline__ const char* bptr(const Gemm& g, const Unit& u, size_t tstep) const { return (const char*)g.Bt + (size_t)u.pn * tstep; }
};

__device__ __forceinline__ unsigned cvt_pk_bf16(float lo, float hi) { unsigned r; asm volatile("v_cvt_pk_bf16_f32 %0, %1, %2" : "=v"(r) : "v"(lo), "v"(hi)); return r; }
typedef int v8i32 __attribute__((ext_vector_type(8)));
__device__ __forceinline__ v8i32 ld8(const PG8_LAS unsigned char* p) { typedef int v4i __attribute__((ext_vector_type(4))); const v4i x = *(const PG8_LAS v4i*)p, y = *(const PG8_LAS v4i*)(p + 1024); return (v8i32){x[0], x[1], x[2], x[3], y[0], y[1], y[2], y[3]}; }
__device__ __forceinline__ void mfma8(f32x4& acc, const v8i32& a, const v8i32& b, int sc) { asm volatile("v_mfma_scale_f32_16x16x128_f8f6f4 %0, %1, %2, %0, %3, %3 op_sel_hi:[0,0,0]" : "+v"(acc) : "v"(a), "v"(b), "v"(sc)); }
template <class Epi, class Sched, bool ALIGN_EPI = false, bool SP2 = false, bool FP8 = false>
__device__ __forceinline__ void gemm_phase(PG8_LAS unsigned char* lds, const Gemm g, const Sched& S, const Epi& E) {
    const int tid = threadIdx.x, wid = __builtin_amdgcn_readfirstlane(tid >> 6), lane = tid & 63, wr = wid >> 2, wc = wid & 3, fr = lane & 15, fq = lane >> 4;
    const int K = g.K, nt = K / BK;
    unsigned voffA[2], voffB[2];
#pragma unroll
    for (int i = 0; i < 2; ++i) { int R, C; stage_rc(tid * 16 + i * 8192, R, C); const int Rb = Epi::PERM ? ((R & ~31) + perm32(R & 31)) : R;
        voffA[i] = (unsigned)(R * K + C) * 2u; voffB[i] = (unsigned)(Rb * K + C) * 2u; }
    const size_t kstep = (size_t)(BK * 2);
    const size_t hstep = (size_t)HALF * K * 2;
    const size_t tstep = 2 * hstep;
    const unsigned ldsw = (unsigned)wid * 1024u;
    const int aoff = lds_byte(wr * 64 + fr, fq * 8), boff = lds_byte(wc * 32 + fr, fq * 8);
#define PG8_SA(b, h) (((b) * 2 + (h)) * HTB)
#define PG8_SB(b, h) ((4 + (b) * 2 + (h)) * HTB)
#define PG8_STAGE(bufoff, gbase, voff) do { _Pragma("unroll") for (int _i = 0; _i < 2; ++_i) \
        __builtin_amdgcn_global_load_lds((const unsigned*)((const char*)(gbase) + (voff)[_i]), (PG8_LAS unsigned*)(lds + (bufoff) + ldsw + _i * 8192), 16, 0, 0); } while (0)
#define PG8_LDA(dst, b, h) do { if constexpr (FP8) { _Pragma("unroll") for (int m = 0; m < 4; ++m) dst##8[m] = ld8(lds + PG8_SA(b, h) + aoff + m * 2048); } else { \
        _Pragma("unroll") for (int m = 0; m < 4; ++m) _Pragma("unroll") for (int k = 0; k < 2; ++k) dst[m][k] = *(const PG8_LAS bf16x8*)(lds + PG8_SA(b, h) + aoff + m * 2048 + k * 1024); } } while (0)
#define PG8_LDB(dst, b, h) do { if constexpr (FP8) { _Pragma("unroll") for (int n = 0; n < 2; ++n) dst##8[n] = ld8(lds + PG8_SB(b, h) + boff + n * 2048); } else { \
        _Pragma("unroll") for (int n = 0; n < 2; ++n) _Pragma("unroll") for (int k = 0; k < 2; ++k) dst[n][k] = *(const PG8_LAS bf16x8*)(lds + PG8_SB(b, h) + boff + n * 2048 + k * 1024); } } while (0)
#define PG8_MMA(ai, bj, At, Bt) do { if constexpr (FP8) __builtin_amdgcn_sched_barrier(0); __builtin_amdgcn_s_setprio(1); if constexpr (FP8) { _Pragma("unroll") for (int m = 0; m < 4; ++m) _Pragma("unroll") for (int n = 0; n < 2; ++n) \
        mfma8(acc[ai][bj][m][n], Bt##8[n], At##8[m], sc8); } else { \
        _Pragma("unroll") for (int m = 0; m < 4; ++m) _Pragma("unroll") for (int n = 0; n < 2; ++n) _Pragma("unroll") for (int k = 0; k < 2; ++k) \
        acc[ai][bj][m][n] = __builtin_amdgcn_mfma_f32_16x16x32_bf16(Bt[n][k], At[m][k], acc[ai][bj][m][n], 0, 0, 0); } __builtin_amdgcn_s_setprio(0); if constexpr (FP8) __builtin_amdgcn_sched_barrier(0); } while (0)
#define PG8_WAIT_V(n) asm volatile("s_waitcnt vmcnt(" #n ")" ::: "memory")
#define PG8_WAIT_L(n) asm volatile("s_waitcnt lgkmcnt(" #n ")" ::: "memory")
#define PG8_BAR __builtin_amdgcn_s_barrier()
#define PG8_SCHED __builtin_amdgcn_sched_barrier(0)
    Unit cur, nxt; int ui = 0;
    if (!S.next(0, cur)) return;
    f32x4 acc[2][2][4][2];
#pragma unroll
    for (int a = 0; a < 2; ++a)
#pragma unroll
        for (int b = 0; b < 2; ++b)
#pragma unroll
            for (int m = 0; m < 4; ++m)
#pragma unroll
                for (int n = 0; n < 2; ++n) acc[a][b][m][n] = (f32x4){0.f, 0.f, 0.f, 0.f};
    bf16x8 At[4][2], B0[2][2], B1[2][2]; v8i32 At8[4], B08[2], B18[2]; int sc8 = 0x7f7f7f7f; asm volatile("" : "+v"(sc8));
    const char* cA = S.aptr(g, cur, tstep); const char* cB = S.bptr(g, cur, tstep);
    S.a_ready(cur);
    if constexpr (SP2) {
        PG8_STAGE(PG8_SB(0, 0), cB, voffB); PG8_STAGE(PG8_SB(0, 1), cB + hstep, voffB); PG8_STAGE(PG8_SA(0, 0), cA, voffA); PG8_STAGE(PG8_SA(0, 1), cA + hstep, voffA);
        if (wr == 1) PG8_BAR;
        PG8_WAIT_V(2); PG8_BAR;
        PG8_STAGE(PG8_SB(1, 0), cB + kstep, voffB); PG8_STAGE(PG8_SA(1, 0), cA + kstep, voffA); PG8_STAGE(PG8_SB(1, 1), cB + hstep + kstep, voffB);
        PG8_WAIT_V(6); PG8_BAR;
    } else {
        PG8_STAGE(PG8_SB(0, 0), cB, voffB); PG8_STAGE(PG8_SA(0, 0), cA, voffA); PG8_STAGE(PG8_SB(0, 1), cB + hstep, voffB); PG8_STAGE(PG8_SA(0, 1), cA + hstep, voffA);
        if (wr == 1) PG8_BAR;
        PG8_WAIT_V(4); PG8_BAR;
        PG8_STAGE(PG8_SB(1, 0), cB + kstep, voffB); PG8_STAGE(PG8_SA(1, 0), cA + kstep, voffA); PG8_STAGE(PG8_SB(1, 1), cB + hstep + kstep, voffB);
        PG8_WAIT_V(6); PG8_BAR;
    }
    for (;;) {
        const bool has_next = S.next(ui + 1, nxt);
        const char* nA = has_next ? S.aptr(g, nxt, tstep) : cA; const char* nB = has_next ? S.bptr(g, nxt, tstep) : cB;
#pragma unroll 1
        for (int t = 0; t < nt; t += 2) {
            const bool last = (t == nt - 2);
            const char* a1 = cA + (size_t)(t + 1) * kstep;
            const char* a2 = last ? nA : cA + (size_t)(t + 2) * kstep; const char* b2 = last ? nB : cB + (size_t)(t + 2) * kstep;
            const char* a3 = a2 + kstep; const char* b3 = b2 + kstep;
            if (last && has_next) S.a_ready(nxt);
            if constexpr (SP2) {
            PG8_LDB(B0, 0, 0); PG8_LDB(B1, 0, 1); PG8_SCHED; PG8_LDA(At, 0, 0); PG8_STAGE(PG8_SA(1, 1), a1 + hstep, voffA);
            PG8_WAIT_V(8); PG8_WAIT_L(0); PG8_BAR; PG8_MMA(0, 0, At, B0); PG8_MMA(0, 1, At, B1); PG8_BAR; PG8_SCHED;
            PG8_LDA(At, 0, 1); PG8_STAGE(PG8_SB(0, 0), b2, voffB); PG8_STAGE(PG8_SB(0, 1), b2 + hstep, voffB); PG8_STAGE(PG8_SA(0, 0), a2, voffA);
            PG8_WAIT_V(8); PG8_WAIT_L(0); PG8_BAR; PG8_MMA(1, 0, At, B0); PG8_MMA(1, 1, At, B1); PG8_BAR; PG8_SCHED;
            PG8_LDB(B0, 1, 0); PG8_LDB(B1, 1, 1); PG8_SCHED; PG8_LDA(At, 1, 0); PG8_STAGE(PG8_SA(0, 1), a2 + hstep, voffA);
            PG8_WAIT_V(8); PG8_WAIT_L(0); PG8_BAR; PG8_MMA(0, 0, At, B0); PG8_MMA(0, 1, At, B1); PG8_BAR; PG8_SCHED;
            PG8_LDA(At, 1, 1); PG8_STAGE(PG8_SB(1, 0), b3, voffB); PG8_STAGE(PG8_SB(1, 1), b3 + hstep, voffB); PG8_STAGE(PG8_SA(1, 0), a3, voffA);
            PG8_WAIT_V(8); PG8_WAIT_L(0); PG8_BAR; PG8_MMA(1, 0, At, B0); PG8_MMA(1, 1, At, B1); PG8_BAR; PG8_SCHED;
            } else {
            PG8_LDB(B0, 0, 0); PG8_SCHED; PG8_LDA(At, 0, 0); PG8_STAGE(PG8_SA(1, 1), a1 + hstep, voffA);
            PG8_WAIT_L(8); PG8_BAR; PG8_WAIT_L(0); PG8_MMA(0, 0, At, B0); PG8_BAR; PG8_SCHED;
            PG8_LDB(B1, 0, 1); PG8_STAGE(PG8_SB(0, 0), b2, voffB);
            PG8_BAR; PG8_WAIT_L(0); PG8_MMA(0, 1, At, B1); PG8_BAR;
            PG8_LDA(At, 0, 1); PG8_STAGE(PG8_SA(0, 0), a2, voffA);
            PG8_BAR; PG8_WAIT_L(0); PG8_MMA(1, 0, At, B0); PG8_BAR; PG8_SCHED;
            PG8_STAGE(PG8_SB(0, 1), b2 + hstep, voffB);
            PG8_WAIT_V(6); PG8_BAR; PG8_MMA(1, 1, At, B1); PG8_BAR;
            PG8_LDB(B0, 1, 0); PG8_SCHED; PG8_LDA(At, 1, 0); PG8_STAGE(PG8_SA(0, 1), a2 + hstep, voffA);
            PG8_WAIT_L(8); PG8_BAR; PG8_WAIT_L(0); PG8_MMA(0, 0, At, B0); PG8_BAR; PG8_SCHED;
            PG8_LDB(B1, 1, 1); PG8_STAGE(PG8_SB(1, 0), b3, voffB);
            PG8_BAR; PG8_WAIT_L(0); PG8_MMA(0, 1, At, B1); PG8_BAR;
            PG8_LDA(At, 1, 1); PG8_STAGE(PG8_SA(1, 0), a3, voffA);
            PG8_BAR; PG8_WAIT_L(0); PG8_MMA(1, 0, At, B0); PG8_BAR; PG8_SCHED;
            PG8_STAGE(PG8_SB(1, 1), b3 + hstep, voffB);
            PG8_WAIT_V(6); PG8_BAR; PG8_MMA(1, 1, At, B1); PG8_BAR;
            }
        }
        if constexpr (FP8) asm volatile("s_nop 15\n\ts_nop 15" ::: "memory");
        if constexpr (ALIGN_EPI) { if (wr == 0) PG8_BAR; }
        if constexpr (!Epi::AFTER_DRAIN) { E(acc, cur, wr, wc, fr, fq); S.done(cur); }
        if (!has_next) break;
#pragma unroll
        for (int a = 0; a < 2; ++a)
#pragma unroll
            for (int b = 0; b < 2; ++b)
#pragma unroll
                for (int m = 0; m < 4; ++m)
#pragma unroll
                    for (int n = 0; n < 2; ++n) acc[a][b][m][n] = (f32x4){0.f, 0.f, 0.f, 0.f};
        cur = nxt; cA = nA; cB = nB; ++ui;
        if constexpr (ALIGN_EPI) { if (wr == 1) PG8_BAR; }
    }
    PG8_WAIT_V(0);
    if constexpr (!ALIGN_EPI) { if (wr == 0) PG8_BAR; }
    PG8_BAR;
    if constexpr (Epi::AFTER_DRAIN) { E.fused(acc, cur, wr, wc, fr, fq, lds, wid, lane); S.done(cur); }
#undef PG8_SA
#undef PG8_SB
#undef PG8_STAGE
#undef PG8_LDA
#undef PG8_LDB
#undef PG8_MMA
#undef PG8_WAIT_V
#undef PG8_WAIT_L
#undef PG8_BAR
#undef PG8_SCHED
}
}

constexpr int D = 1024, NB = 8, SEQ = 4096, CTXL = 256;
constexpr int MLAT = NB * SEQ, MCTX = NB * CTXL, MTOT = MLAT + MCTX;
constexpr int NE = 16, FF = 2048, CAPL = 512, CAPC = 32;
constexpr int EROWS0 = NB * (CAPL + CAPC);
constexpr int EROWS1 = NB * CAPL;
constexpr int NQKV = 1536, NWIN = 4096, LDWIN = 4128;
constexpr float EPS = 1e-6f;
constexpr int NWAVES = 8, NTHR = 512;
constexpr int NPH = 21;

constexpr size_t MiB = 1u << 20;
constexpr size_t WS_CTL = 0, CTL_ZERO_BYTES = 1 * MiB;
constexpr size_t WS_MOD = 1 * MiB;
constexpr size_t WS_ROPE = 1 * MiB + 512 * 1024;
constexpr size_t WS_WQKV = 2 * MiB, WS_WO0 = 5 * MiB, WS_WIN = 7 * MiB, WS_WO1 = 15 * MiB;
constexpr size_t WS_WGU = 17 * MiB, WS_WD = 81 * MiB, WS_WGU1 = 113 * MiB, WS_WD1 = 177 * MiB;
constexpr size_t WS_XRES = 209 * MiB;
constexpr size_t WS_H = 345 * MiB;
constexpr size_t WS_H8 = WS_H;
constexpr size_t WS_AFF = 413 * MiB;
constexpr size_t WS_GW = 416 * MiB;
constexpr size_t WS_SLOT = 417 * MiB;
constexpr size_t WS_G = 420 * MiB, WS_BETA = 423 * MiB;
constexpr size_t WS_R = 427 * MiB;
constexpr size_t WS_Q = WS_R, WS_K = WS_R + 68 * MiB, WS_V = WS_R + 85 * MiB, WS_ATT = WS_R + 102 * MiB;
constexpr size_t WS_XG = WS_R, WS_HID = WS_R + 136 * MiB;
constexpr size_t WS_PQKV = WS_R, WS_Z = WS_R + 204 * MiB, WS_QN = WS_R + 272 * MiB, WS_KN = WS_R + 340 * MiB, WS_VV = WS_R + 408 * MiB;
constexpr size_t WS_TB = WS_R, WS_TG = WS_R + 68 * MiB, WS_QKD = WS_R + 136 * MiB, WS_GC = WS_AFF;
constexpr size_t WS_RO = WS_R;
constexpr size_t WS_END = WS_R + 476 * MiB;
constexpr int CW_BAR = 4096;

constexpr int RING_BYTES = 131072;
constexpr int LDSCTL_OFF = RING_BYTES, MISC_OFF = LDSCTL_OFF + 320;
constexpr int LDS_BYTES = 147456;

#define GAS __attribute__((address_space(1)))
#define LAS __attribute__((address_space(3)))
typedef unsigned short bf16;
typedef unsigned v4u __attribute__((ext_vector_type(4)));
typedef unsigned v2u __attribute__((ext_vector_type(2)));
typedef float f32x4 __attribute__((ext_vector_type(4)));
typedef short bf16x8 __attribute__((ext_vector_type(8)));
typedef GAS unsigned gu32;
typedef GAS unsigned long long gu64;
#define RLX_AGENT __ATOMIC_RELAXED, __HIP_MEMORY_SCOPE_AGENT
#define LDS_WAIT() asm volatile("s_waitcnt lgkmcnt(0)" ::: "memory")
#define VM_WAIT() asm volatile("s_waitcnt vmcnt(0)" ::: "memory")

#define XB_TMO      128
#define XB_XCNT(j)  (256  + 64 * (j))
#define XB_XSUB(j)  (1280 + 64 * (j))
#define XB_XGEN(j)  (2304 + 64 * (j))
#define XB_TOP      3328
#define XB_TOPGEN   3392
#define XCD_BAR_WORDS 3456
#define XB_SPIN_CAP (1u << 18)

__device__ __forceinline__ unsigned xb_ld(unsigned* p)              { return __hip_atomic_load(p, __ATOMIC_RELAXED, __HIP_MEMORY_SCOPE_AGENT); }
__device__ __forceinline__ unsigned xb_add(unsigned* p, unsigned v) { return __hip_atomic_fetch_add(p, v, __ATOMIC_RELAXED, __HIP_MEMORY_SCOPE_AGENT); }
__device__ __forceinline__ unsigned xb_xcc_id() { return (unsigned)__builtin_amdgcn_s_getreg((3 << 11) | 20) & 0xFu; }
#define XB_SPIN(cond, bar) do { unsigned _sp = 0; while (cond) { __builtin_amdgcn_s_sleep(1); \
    if ((++_sp & 255u) == 0u) { if (xb_ld(&(bar)[XB_TMO])) break; if (_sp > XB_SPIN_CAP) { atomicAdd(&(bar)[XB_TMO], 1u); break; } } } } while (0)

struct XcdBarrier {
    unsigned* bar; unsigned x;
    volatile LAS unsigned* st;
};

__device__ __forceinline__ XcdBarrier xcd_barrier_post(unsigned* bar, volatile LAS unsigned* st) {
    XcdBarrier b; b.bar = bar; b.x = xb_xcc_id(); b.st = st;
    if (threadIdx.x == 0) (void)xb_add(&bar[XB_XCNT(b.x)], 1u);
    return b;
}
__device__ __forceinline__ void xcd_barrier_complete(unsigned* bar, unsigned x, unsigned& nloc, unsigned& nx) {
    const unsigned G = gridDim.x * gridDim.y * gridDim.z;
    unsigned sum, cnt, mine, sp = 0u;
    for (;;) {
        sum = 0u; cnt = 0u; mine = 0u;
#pragma unroll
        for (unsigned j = 0; j < 16; ++j) { const unsigned c = xb_ld(&bar[XB_XCNT(j)]); sum += c; cnt += (c > 0u) ? 1u : 0u; mine = (j == x) ? c : mine; }
        if (sum == G) break;
        __builtin_amdgcn_s_sleep(1);
        if ((++sp & 255u) == 0u) { if (xb_ld(&bar[XB_TMO])) break; if (sp > XB_SPIN_CAP) { atomicAdd(&bar[XB_TMO], 1u); break; } }
    }
    nloc = mine > 0u ? mine : 1u; nx = cnt > 0u ? cnt : 1u;
}

__device__ __forceinline__ void xcd_barrier(const XcdBarrier& b) {
    asm volatile("s_waitcnt vmcnt(0)" ::: "memory");
    __syncthreads();
    if (threadIdx.x == 0) {
        unsigned* bar = b.bar;
        __builtin_amdgcn_s_waitcnt(0);
        unsigned nloc = b.st[0], nx = b.st[1];
        if (nloc == 0u) { xcd_barrier_complete(bar, b.x, nloc, nx); b.st[0] = nloc; b.st[1] = nx; }
        const unsigned old = xb_add(&bar[XB_XSUB(b.x)], 1u);
        const unsigned gen = old / nloc;
        if (old + 1u == (gen + 1u) * nloc) {
            __builtin_amdgcn_fence(__ATOMIC_RELEASE, "agent");
            asm volatile("s_waitcnt vmcnt(0)" ::: "memory");
            const unsigned og = xb_add(&bar[XB_TOP], 1u);
            const unsigned tg = og / nx;
            if (og + 1u == (tg + 1u) * nx) xb_add(&bar[XB_TOPGEN], 1u);
            else XB_SPIN(xb_ld(&bar[XB_TOPGEN]) == tg, bar);
            __builtin_amdgcn_fence(__ATOMIC_ACQUIRE, "agent");
            xb_add(&bar[XB_XGEN(b.x)], 1u);
            asm volatile("s_waitcnt vmcnt(0)" ::: "memory");
        } else {
            XB_SPIN(xb_ld(&bar[XB_XGEN(b.x)]) == gen, bar);
            __builtin_amdgcn_fence(__ATOMIC_ACQUIRE, "agent");
            asm volatile("s_waitcnt vmcnt(0)" ::: "memory");
        }
    }
    __syncthreads();
}

struct Args { const float* in[30]; float* out; unsigned char* ws; int ph_lo, ph_hi; };
struct Frame { LAS unsigned char* lds; volatile LAS unsigned* MISC; int tid, lane, wave, vcu, G; };

__device__ __forceinline__ float wave_sum(float v) {
#pragma unroll
    for (int o = 1; o < 64; o <<= 1) v += __shfl_xor(v, o);
    return v;
}
template <int N> __device__ __forceinline__ float fold_sum(float (&p)[N], int lane) {
    int o = 32;
#pragma unroll
    for (int n = N; n > 1; n >>= 1) { const unsigned um = (lane & o) ? 0xffffffffu : 0u;
#pragma unroll
        for (int k = 0; k < n / 2; ++k) { const unsigned a = __float_as_uint(p[k]), b = __float_as_uint(p[k + n / 2]);
            const float send = __uint_as_float((a & um) | (b & ~um)), keep = __uint_as_float((b & um) | (a & ~um)); p[k] = keep + __shfl_xor(send, o); }
        o >>= 1; }
    float v = p[0];
#pragma unroll
    for (int oo = 32; oo >= 1; oo >>= 1) if (oo <= o) v += __shfl_xor(v, oo);
    return v;
}
__device__ __forceinline__ float proj16(const f32x4 (&v)[4], const LAS float* w16, int lane) {
    float pj[16];
#pragma unroll
    for (int e = 0; e < 16; ++e) { float s = 0.f;
#pragma unroll
        for (int j = 0; j < 4; ++j) { const f32x4 w = ((const LAS f32x4*)(w16 + e * 1024))[lane + 64 * j]; s += (v[j].x * w.x + v[j].y * w.y) + (v[j].z * w.z + v[j].w * w.w); }
        pj[e] = s; }
    return fold_sum<16>(pj, lane);
}
template <int R> __device__ __forceinline__ void proj16xR(const f32x4 (&v)[R][4], const LAS float* w16, int lane, float (&out)[R]) {
    float p[R][16];
#pragma unroll
    for (int e = 0; e < 16; ++e) { float s[R];
#pragma unroll
        for (int t = 0; t < R; ++t) s[t] = 0.f;
#pragma unroll
        for (int j = 0; j < 4; ++j) { const f32x4 w = ((const LAS f32x4*)(w16 + e * 1024))[lane + 64 * j];
#pragma unroll
            for (int t = 0; t < R; ++t) s[t] += (v[t][j].x * w.x + v[t][j].y * w.y) + (v[t][j].z * w.z + v[t][j].w * w.w); }
#pragma unroll
        for (int t = 0; t < R; ++t) p[t][e] = s[t]; }
#pragma unroll
    for (int t = 0; t < R; ++t) out[t] = fold_sum<16>(p[t], lane);
}
__device__ __forceinline__ void proj16x2(const f32x4 (&v0)[4], const f32x4 (&v1)[4], const LAS float* w16, int lane, float& r0, float& r1) {
    float p0[16], p1[16];
#pragma unroll
    for (int e = 0; e < 16; ++e) { float s0 = 0.f, s1 = 0.f;
#pragma unroll
        for (int j = 0; j < 4; ++j) { const f32x4 w = ((const LAS f32x4*)(w16 + e * 1024))[lane + 64 * j];
            s0 += (v0[j].x * w.x + v0[j].y * w.y) + (v0[j].z * w.z + v0[j].w * w.w); s1 += (v1[j].x * w.x + v1[j].y * w.y) + (v1[j].z * w.z + v1[j].w * w.w); }
        p0[e] = s0; p1[e] = s1; }
    r0 = fold_sum<16>(p0, lane); r1 = fold_sum<16>(p1, lane);
}
__device__ __forceinline__ float bflo(unsigned w) { return __uint_as_float(w << 16); }
__device__ __forceinline__ float bfhi(unsigned w) { return __uint_as_float(w & 0xffff0000u); }
__device__ __forceinline__ unsigned pkbf(float lo, float hi) { return pg8::cvt_pk_bf16(lo, hi); }
__device__ __forceinline__ float silu_f(float x) { return x * __builtin_amdgcn_rcpf(1.f + __expf(-x)); }
__device__ __forceinline__ unsigned pk4f8(float a, float b, float c, float d) { int v = __builtin_amdgcn_cvt_pk_fp8_f32(a, b, 0, false); v = __builtin_amdgcn_cvt_pk_fp8_f32(c, d, v, true); return (unsigned)v; }
constexpr float W8S = 64.f, W8I = 1.f / 64.f;
__device__ __forceinline__ int modrow(int m) { return m < MLAT ? (m >> 12) : 8; }

__device__ __forceinline__ void tr_item(const float* W, size_t ldw, int k0, size_t srccol0, bool permq, bf16* WT, size_t K, size_t dstrow0, LAS float* scr, int lane) {
    const int nl = lane & 31;
    size_t col = srccol0 + nl;
    if (permq) { const int nd = (int)col; const int s = nd & 63, j = (s & 31) >> 1; col = (size_t)((nd - s) + (s & 32) + ((s & 1) ? 16 + j : j)); }
    float t[32];
#pragma unroll
    for (int i = 0; i < 32; ++i) t[i] = W[(size_t)(k0 + 2 * i + (lane >> 5)) * ldw + col];
#pragma unroll
    for (int i = 0; i < 32; ++i) scr[(2 * i + (lane >> 5)) * 33 + nl] = t[i];
    LDS_WAIT(); asm volatile("" ::: "memory");
    const int c = lane & 7;
#pragma unroll
    for (int j = 0; j < 4; ++j) { const int n = (lane >> 3) + 8 * j; const LAS float* s = scr + (8 * c) * 33 + n;
        v4u o; o.x = pkbf(s[0 * 33], s[1 * 33]); o.y = pkbf(s[2 * 33], s[3 * 33]); o.z = pkbf(s[4 * 33], s[5 * 33]); o.w = pkbf(s[6 * 33], s[7 * 33]);
        *(v4u*)(WT + (dstrow0 + n) * K + k0 + 8 * c) = o; }
    LDS_WAIT(); asm volatile("" ::: "memory");
}
__device__ __forceinline__ void tr_item8(const float* W, size_t ldw, int k0, size_t srccol0, unsigned char* WT, size_t K, size_t dstrow0, LAS float* scr, int lane) {
    const int nl = lane & 31; const size_t col = srccol0 + nl;
    float t[32];
#pragma unroll
    for (int i = 0; i < 32; ++i) t[i] = W[(size_t)(k0 + 2 * i + (lane >> 5)) * ldw + col];
#pragma unroll
    for (int i = 0; i < 32; ++i) scr[(2 * i + (lane >> 5)) * 33 + nl] = t[i] * W8S;
    LDS_WAIT(); asm volatile("" ::: "memory");
    const int c = lane & 7;
#pragma unroll
    for (int j = 0; j < 4; ++j) { const int n = (lane >> 3) + 8 * j; const LAS float* s = scr + (8 * c) * 33 + n;
        v2u o; o.x = pk4f8(s[0 * 33], s[1 * 33], s[2 * 33], s[3 * 33]); o.y = pk4f8(s[4 * 33], s[5 * 33], s[6 * 33], s[7 * 33]);
        *(v2u*)(WT + (dstrow0 + n) * K + k0 + 8 * c) = o; }
    LDS_WAIT(); asm volatile("" ::: "memory");
}
constexpr int IT_GU = 16 * 2048, IT_D = 16 * 1024, IT_MOE = IT_GU + IT_D;
__device__ __forceinline__ void tr_moe_items(const Frame& F, const float* wg, const float* wu, const float* wd, unsigned char* wgu, unsigned char* wdn, int lo, int hi, int widx, int nw) {
    LAS float* scr = (LAS float*)(F.lds + F.wave * 16384);
    for (int r = lo + widx; r < hi; r += nw) {
        if (r < IT_GU) { const int e = r >> 11, q = r & 2047, kb = q >> 7, nb = q & 127, n0 = nb * 32, pn = n0 >> 8, w = n0 & 255;
            const float* W = ((w < 128) ? wg : wu) + (size_t)e * 1024 * 2048;
            tr_item8(W, 2048, kb * 64, (size_t)(pn * 128 + (w & 127)), wgu, 1024, (size_t)e * 4096 + n0, scr, F.lane); }
        else { const int rr = r - IT_GU; const int e = rr >> 10, q = rr & 1023, kb = q >> 5, nb = q & 31, n0 = nb * 32;
            tr_item8(wd + (size_t)e * 2048 * 1024, 1024, kb * 64, (size_t)n0, wdn, 2048, (size_t)e * 1024 + n0, scr, F.lane); }
    }
}
constexpr int L0_QKV = 208 * 8 * 9, L0_WO = 224 * 8 * 9, L0_TOPK = 128 * 8 * 5, L0_PRO = IT_MOE - L0_QKV - L0_WO - L0_TOPK;
constexpr int L1_ATT = 128 * 8 * 4, L1_G2 = 192 * 8 * 10, L1_WIN = 128 * 8 * 8, L1_TOPK = 128 * 8 * 5, L1_PREP = 192 * 8 * 5, L1_CMB = IT_MOE - L1_ATT - L1_G2 - L1_WIN - L1_TOPK - L1_PREP;
__device__ __forceinline__ void phase_prologue(const Frame& F, const Args& A) {
    unsigned char* ws = A.ws;
    const int gw = F.vcu * NWAVES + F.wave, NGW = F.G * NWAVES;
    {
        LAS float* sl = (LAS float*)F.lds;
        LAS float* part = sl + 9 * 1024;
        float* MOD = (float*)(ws + WS_MOD);
        if (F.vcu < 192) {
            for (int idx = F.tid; idx < 9 * 1024; idx += NTHR) { const int r = idx >> 10, k = idx & 1023; const float v = r < 8 ? A.in[1][r * 1024 + k] : A.in[3][k]; sl[idx] = silu_f(v); }
        }
        __syncthreads();
        for (int u = F.vcu; u < 192; u += F.G) {
            const int layer = u / 96, cg = u % 96, col = cg * 64 + F.lane;
            const float* W = layer ? A.in[15] : A.in[4]; const float* bias = layer ? A.in[16] : A.in[5];
            float acc[9];
#pragma unroll
            for (int r = 0; r < 9; ++r) acc[r] = 0.f;
            const int k0 = F.wave * 128;
#pragma unroll 8
            for (int k = k0; k < k0 + 128; ++k) { const float w = W[(size_t)k * 6144 + col];
#pragma unroll
                for (int r = 0; r < 9; ++r) acc[r] += sl[r * 1024 + k] * w; }
#pragma unroll
            for (int r = 0; r < 9; ++r) part[(F.wave * 9 + r) * 64 + F.lane] = acc[r];
            __syncthreads();
            for (int idx = F.tid; idx < 576; idx += NTHR) { const int r = idx >> 6, l = idx & 63; float s = 0.f;
#pragma unroll
                for (int w = 0; w < 8; ++w) s += part[(w * 9 + r) * 64 + l];
                MOD[(size_t)(layer * 9 + r) * 6144 + cg * 64 + l] = s + bias[cg * 64 + l]; }
            __syncthreads();
        }
        if (F.vcu == F.G - 1) {
            float* rc = (float*)(ws + WS_ROPE); float* rs = rc + 1024;
            for (int idx = F.tid; idx < 1024; idx += NTHR) { const int pos = idx >> 4, j = idx & 15;
                const float inv = exp2f(-(float)j * (13.287712379549449f / 16.f));
                const float ang = (float)pos * inv; rc[idx] = cosf(ang); rs[idx] = sinf(ang); }
        }
        __syncthreads();
    }
    {
        LAS float* scr = (LAS float*)(F.lds + F.wave * 16384);
        constexpr int I_QKV = 16 * 48, I_WO = 16 * 32, I_WIN = 16 * 128;
        constexpr int NSMALL = I_QKV + 2 * I_WO + I_WIN;
        for (int it = gw; it < NSMALL; it += NGW) {
            int r = it;
            if (r < I_QKV) { const int kb = r / 48, nb = r % 48; tr_item(A.in[7], NQKV, kb * 64, (size_t)nb * 32, nb * 32 < 1280, (bf16*)(ws + WS_WQKV), 1024, (size_t)nb * 32, scr, F.lane); continue; } r -= I_QKV;
            if (r < I_WO) { const int kb = r >> 5, nb = r & 31; tr_item(A.in[9], 1024, kb * 64, (size_t)nb * 32, false, (bf16*)(ws + WS_WO0), 1024, (size_t)nb * 32, scr, F.lane); continue; } r -= I_WO;
            if (r < I_WIN) { const int kb = r >> 7, nb = r & 127; tr_item(A.in[18], LDWIN, kb * 64, (size_t)nb * 32, false, (bf16*)(ws + WS_WIN), 1024, (size_t)nb * 32, scr, F.lane); continue; } r -= I_WIN;
            { const int kb = r >> 5, nb = r & 31; tr_item(A.in[23], 1024, kb * 64, (size_t)nb * 32, false, (bf16*)(ws + WS_WO1), 1024, (size_t)nb * 32, scr, F.lane); }
        }
        constexpr int L0_NOADA = 64 * 8 * 6;
        if (F.G == 256) { if (F.vcu >= 192) tr_moe_items(F, A.in[12], A.in[13], A.in[14], ws + WS_WGU, ws + WS_WD, 0, L0_NOADA, (F.vcu - 192) * NWAVES + F.wave, 64 * NWAVES);
            tr_moe_items(F, A.in[12], A.in[13], A.in[14], ws + WS_WGU, ws + WS_WD, L0_NOADA, L0_PRO, gw, NGW); }
        else tr_moe_items(F, A.in[12], A.in[13], A.in[14], ws + WS_WGU, ws + WS_WD, 0, L0_PRO, gw, NGW);
    }
}

struct RowCoef { f32x4 a[4], b[4]; };
__device__ __forceinline__ void load_coef(RowCoef& C, const float* g, const float* sh, const float* sc, int lane) {
#pragma unroll
    for (int j = 0; j < 4; ++j) { const f32x4 gv = ((const f32x4*)g)[lane + 64 * j], sv = ((const f32x4*)sc)[lane + 64 * j]; C.a[j] = gv * (sv + 1.0f); C.b[j] = ((const f32x4*)sh)[lane + 64 * j]; }
}
__device__ __forceinline__ float row_rstd(const f32x4 (&v)[4]) {
    float s = 0.f;
#pragma unroll
    for (int j = 0; j < 4; ++j) s += (v[j].x * v[j].x + v[j].y * v[j].y) + (v[j].z * v[j].z + v[j].w * v[j].w);
    return 1.0f / sqrtf(wave_sum(s) * (1.0f / 1024.0f) + EPS);
}
__device__ __forceinline__ void store_row_bf16(bf16* row, const f32x4 (&v)[4], int lane) {
#pragma unroll
    for (int j = 0; j < 4; ++j) { v2u w; w.x = pkbf(v[j].x, v[j].y); w.y = pkbf(v[j].z, v[j].w); ((v2u*)row)[lane + 64 * j] = w; }
}

__device__ __forceinline__ void load_row_bf16(f32x4 (&v)[4], const bf16* row, int lane) {
#pragma unroll
    for (int j = 0; j < 4; ++j) { const v2u w = ((const v2u*)row)[lane + 64 * j]; v[j] = (f32x4){bflo(w.x), bfhi(w.x), bflo(w.y), bfhi(w.y)}; }
}
__device__ __forceinline__ void phase_modnorm0(const Frame& F, const Args& A) {
    const int gw = F.vcu * NWAVES + F.wave, NGW = F.G * NWAVES;
    const float* MOD = (const float*)(A.ws + WS_MOD); bf16* H = (bf16*)(A.ws + WS_H);
    const int rpw = (MTOT + NGW - 1) / NGW;
    int curb = -1; RowCoef C;
    const int mbeg = gw * rpw, cnt = (MTOT - mbeg) < rpw ? (MTOT - mbeg) : rpw;
    f32x4 nx[4];
    if (cnt > 0) { const float* xr = mbeg < MLAT ? A.in[0] + (size_t)mbeg * D : A.in[2] + (size_t)(mbeg - MLAT) * D;
#pragma unroll
        for (int j = 0; j < 4; ++j) nx[j] = ((const f32x4*)xr)[F.lane + 64 * j]; }
    for (int r = 0; r < cnt; ++r) { const int m = mbeg + r;
        const int mb = modrow(m);
        if (mb != curb) { load_coef(C, A.in[6], MOD + (size_t)mb * 6144, MOD + (size_t)mb * 6144 + 1024, F.lane); curb = mb; }
        f32x4 v[4];
#pragma unroll
        for (int j = 0; j < 4; ++j) v[j] = nx[j];
        if (r + 1 < cnt) { const int m1 = m + 1; const float* xr = m1 < MLAT ? A.in[0] + (size_t)m1 * D : A.in[2] + (size_t)(m1 - MLAT) * D;
#pragma unroll
            for (int j = 0; j < 4; ++j) nx[j] = ((const f32x4*)xr)[F.lane + 64 * j]; }
        const float rstd = row_rstd(v);
#pragma unroll
        for (int j = 0; j < 4; ++j) v[j] = v[j] * rstd * C.a[j] + C.b[j];
        store_row_bf16(H + (size_t)m * D, v, F.lane);
    }
}

template <int NML, int NNL> struct GroupOrder {
    static constexpr int PER = NML * NNL, BW = 4 * NNL;
    int nx, e0, lid;
    __device__ void init(int G_, int bx) { nx = G_ / 8; e0 = bx % 8; lid = bx / 8; }
    __device__ bool next(int i, pg8::Unit& u) const { const int q = i * nx + lid; if (q >= 2 * PER) return false;
        const int e = e0 + 8 * (q / PER), r = q % PER, band = r / BW, rr = r % BW, brow = (NML - 4 * band) < 4 ? (NML - 4 * band) : 4;
        u.pm = e * NML + 4 * band + rr % brow; u.pn = e * NNL + rr / brow; return true; }
    __device__ __forceinline__ void a_ready(const pg8::Unit&) const {}
    __device__ __forceinline__ void done(const pg8::Unit&) const {}
    __device__ __forceinline__ const char* aptr(const pg8::Gemm& g, const pg8::Unit& u, size_t tstep) const { return (const char*)g.A + (size_t)u.pm * tstep; }
    __device__ __forceinline__ const char* bptr(const pg8::Gemm& g, const pg8::Unit& u, size_t tstep) const { return (const char*)g.Bt + (size_t)u.pn * tstep; }
};
struct QKVOrder {
    int nx, x0, lid;
    __device__ void init(int G_, int bx) { nx = G_ / 8; x0 = bx % 8; lid = bx / 8; }
    __device__ bool next(int i, pg8::Unit& u) const { const int q = i * nx + lid; if (q >= 102) return false; const int tm = 17 * x0 + q / 6, c = q % 6;
        if (c < 5) { u.pm = tm; u.pn = c; } else { u.pm = 1000 + tm; u.pn = 5; } return true; }
    __device__ __forceinline__ void a_ready(const pg8::Unit&) const {}
    __device__ __forceinline__ void done(const pg8::Unit&) const {}
    __device__ __forceinline__ const char* aptr(const pg8::Gemm& g, const pg8::Unit& u, size_t tstep) const { return u.pm >= 1000 ? (const char*)g.Bt + 5 * tstep : (const char*)g.A + (size_t)u.pm * tstep; }
    __device__ __forceinline__ const char* bptr(const pg8::Gemm& g, const pg8::Unit& u, size_t tstep) const { return u.pm >= 1000 ? (const char*)g.A + (size_t)(u.pm - 1000) * tstep : (const char*)g.Bt + (size_t)u.pn * tstep; }
};
struct EpiQKV {
    static constexpr bool PERM = true, AFTER_DRAIN = false;
    bf16 *Q, *K, *V; const float* rc; const float* rs; float QS;
    __device__ __forceinline__ void operator()(const f32x4 (&acc)[2][2][4][2], const pg8::Unit& u, int wr, int wc, int fr, int fq) const {
        if (u.pm >= 1000) {
            const int tok0 = (u.pm - 1000) * 256;
#pragma unroll
            for (int ai = 0; ai < 2; ++ai)
#pragma unroll
                for (int m = 0; m < 4; ++m) { const int dr = ai * 128 + wr * 64 + m * 16 + fr;
#pragma unroll
                    for (int bj = 0; bj < 2; ++bj) { const f32x4 v0 = acc[ai][bj][m][0], v1 = acc[ai][bj][m][1];
                        v4u w; w.x = pkbf(v0[0], v0[1]); w.y = pkbf(v0[2], v0[3]); w.z = pkbf(v1[0], v1[1]); w.w = pkbf(v1[2], v1[3]);
                        *(v4u*)(V + (size_t)dr * MTOT + tok0 + bj * 128 + wc * 32 + 8 * fq) = w; } }
            return; }
        const int pn = u.pn; bf16* base; int ld, coff;
        if (pn < 4) { base = Q; ld = 1024; coff = pn * 256; } else { base = K; ld = 256; coff = 0; }
        const bool rope = (u.pm < MLAT / 256);
        const float sc = pn < 4 ? QS : 1.0f;
        const int iscol = wc & 1;
#pragma unroll
        for (int ai = 0; ai < 2; ++ai)
#pragma unroll
            for (int m = 0; m < 4; ++m) {
                const int r = u.pm * 256 + ai * 128 + wr * 64 + m * 16 + fr;
                f32x4 cv = (f32x4){1.f, 1.f, 1.f, 1.f}, sv = (f32x4){0.f, 0.f, 0.f, 0.f};
                if (rope) { const int n = r & 4095; const int pos = iscol ? (n & 63) : (n >> 6); cv = *(const f32x4*)(rc + pos * 16 + 4 * fq); sv = *(const f32x4*)(rs + pos * 16 + 4 * fq); }
#pragma unroll
                for (int bj = 0; bj < 2; ++bj) {
                    const f32x4 v0 = acc[ai][bj][m][0], v1 = acc[ai][bj][m][1];
                    const float o0 = (v0[0] * cv[0] - v0[1] * sv[0]) * sc, o1 = (v0[1] * cv[0] + v0[0] * sv[0]) * sc;
                    const float o2 = (v0[2] * cv[1] - v0[3] * sv[1]) * sc, o3 = (v0[3] * cv[1] + v0[2] * sv[1]) * sc;
                    const float o4 = (v1[0] * cv[2] - v1[1] * sv[2]) * sc, o5 = (v1[1] * cv[2] + v1[0] * sv[2]) * sc;
                    const float o6 = (v1[2] * cv[3] - v1[3] * sv[3]) * sc, o7 = (v1[3] * cv[3] + v1[2] * sv[3]) * sc;
                    v4u w; w.x = pkbf(o0, o1); w.y = pkbf(o2, o3); w.z = pkbf(o4, o5); w.w = pkbf(o6, o7);
                    *(v4u*)(base + (size_t)r * ld + coff + bj * 128 + wc * 32 + 8 * fq) = w;
                }
            }
    }
};
template <bool XIN_BF16> struct EpiResid {
    static constexpr bool PERM = true, AFTER_DRAIN = false;
    const void* xlat; const void* xctx; bf16* out; const float* gate;
    __device__ __forceinline__ void operator()(const f32x4 (&acc)[2][2][4][2], const pg8::Unit& u, int wr, int wc, int fr, int fq) const {
        const int mb = u.pm < MLAT / 256 ? (u.pm >> 4) : 8;
        const int col0 = u.pn * 256 + wc * 32 + 8 * fq;
        const float* gp = gate + (size_t)mb * 6144 + col0;
        f32x4 gv[2][2];
#pragma unroll
        for (int bj = 0; bj < 2; ++bj)
#pragma unroll
            for (int n = 0; n < 2; ++n) gv[bj][n] = *(const f32x4*)(gp + bj * 128 + n * 4);
#pragma unroll
        for (int ai = 0; ai < 2; ++ai)
#pragma unroll
            for (int m = 0; m < 4; ++m) {
                const int r = u.pm * 256 + ai * 128 + wr * 64 + m * 16 + fr;
                bf16* o = out + (size_t)r * D + col0;
#pragma unroll
                for (int bj = 0; bj < 2; ++bj) { f32x4 x0, x1;
                    if (XIN_BF16) { const v4u w = *(const v4u*)((const bf16*)xlat + (size_t)r * D + col0 + bj * 128);
                        x0 = (f32x4){bflo(w.x), bfhi(w.x), bflo(w.y), bfhi(w.y)}; x1 = (f32x4){bflo(w.z), bfhi(w.z), bflo(w.w), bfhi(w.w)}; }
                    else { const float* xin = (r < MLAT ? (const float*)xlat + (size_t)r * D : (const float*)xctx + (size_t)(r - MLAT) * D) + col0 + bj * 128; x0 = *(const f32x4*)xin; x1 = *(const f32x4*)(xin + 4); }
                    x0 += gv[bj][0] * acc[ai][bj][m][0]; x1 += gv[bj][1] * acc[ai][bj][m][1];
                    v4u w; w.x = pkbf(x0[0], x0[1]); w.y = pkbf(x0[2], x0[3]); w.z = pkbf(x1[0], x1[1]); w.w = pkbf(x1[2], x1[3]);
                    *(v4u*)(o + bj * 128) = w; }
            }
    }
};
struct EpiSwiGLU {
    static constexpr bool PERM = true, AFTER_DRAIN = false;
    unsigned char* HID;
    __device__ __forceinline__ void operator()(const f32x4 (&acc)[2][2][4][2], const pg8::Unit& u, int wr, int wc, int fr, int fq) const {
        asm volatile("" : "+v"(fr), "+v"(fq));
        const int col = (u.pn & 15) * 128 + wc * 32 + 8 * fq;
#pragma unroll
        for (int ai = 0; ai < 2; ++ai)
#pragma unroll
            for (int m = 0; m < 4; ++m) {
                const int r = u.pm * 256 + ai * 128 + wr * 64 + m * 16 + fr;
                const f32x4 g0 = acc[ai][0][m][0] * W8I, g1 = acc[ai][0][m][1] * W8I, u0 = acc[ai][1][m][0] * W8I, u1 = acc[ai][1][m][1] * W8I;
                v2u w; w.x = pk4f8(silu_f(g0[0]) * u0[0], silu_f(g0[1]) * u0[1], silu_f(g0[2]) * u0[2], silu_f(g0[3]) * u0[3]);
                w.y = pk4f8(silu_f(g1[0]) * u1[0], silu_f(g1[1]) * u1[1], silu_f(g1[2]) * u1[2], silu_f(g1[3]) * u1[3]);
                *(v2u*)(HID + (size_t)r * FF + col) = w;
            }
    }
};
struct EpiY {
    static constexpr bool PERM = true, AFTER_DRAIN = false;
    bf16* Y;
    __device__ __forceinline__ void operator()(const f32x4 (&acc)[2][2][4][2], const pg8::Unit& u, int wr, int wc, int fr, int fq) const {
        asm volatile("" : "+v"(fr), "+v"(fq));
        const int col = (u.pn & 3) * 256 + wc * 32 + 8 * fq;
#pragma unroll
        for (int ai = 0; ai < 2; ++ai)
#pragma unroll
            for (int m = 0; m < 4; ++m) {
                const int r = u.pm * 256 + ai * 128 + wr * 64 + m * 16 + fr;
                const float gwt = W8I;
#pragma unroll
                for (int bj = 0; bj < 2; ++bj) { const f32x4 v0 = acc[ai][bj][m][0] * gwt, v1 = acc[ai][bj][m][1] * gwt;
                    v4u w; w.x = pkbf(v0[0], v0[1]); w.y = pkbf(v0[2], v0[3]); w.z = pkbf(v1[0], v1[1]); w.w = pkbf(v1[2], v1[3]);
                    *(v4u*)(Y + (size_t)r * D + col + bj * 128) = w; }
            }
    }
};
struct EpiP {
    static constexpr bool PERM = true, AFTER_DRAIN = false;
    bf16 *P, *Z;
    __device__ __forceinline__ void operator()(const f32x4 (&acc)[2][2][4][2], const pg8::Unit& u, int wr, int wc, int fr, int fq) const {
        bf16* base; int ld, coff;
        if (u.pn < 12) { base = P; ld = 3072; coff = u.pn * 256; } else { base = Z; ld = 1024; coff = (u.pn - 12) * 256; }
#pragma unroll
        for (int ai = 0; ai < 2; ++ai)
#pragma unroll
            for (int m = 0; m < 4; ++m) {
                const int r = u.pm * 256 + ai * 128 + wr * 64 + m * 16 + fr;
#pragma unroll
                for (int bj = 0; bj < 2; ++bj) { const f32x4 v0 = acc[ai][bj][m][0], v1 = acc[ai][bj][m][1];
                    v4u w; w.x = pkbf(v0[0], v0[1]); w.y = pkbf(v0[2], v0[3]); w.z = pkbf(v1[0], v1[1]); w.w = pkbf(v1[2], v1[3]);
                    *(v4u*)(base + (size_t)r * ld + coff + bj * 128 + wc * 32 + 8 * fq) = w; }
            }
    }
};

typedef float f32x16 __attribute__((ext_vector_type(16)));
typedef float f32x2_t __attribute__((ext_vector_type(2)));
typedef __bf16 bf16x2_t __attribute__((ext_vector_type(2)));
__device__ __forceinline__ unsigned cvtpk(float lo, float hi) { f32x2_t v = {lo, hi}; bf16x2_t b = __builtin_convertvector(v, bf16x2_t); return __builtin_bit_cast(unsigned, b); }
#define MFMA32(a, b, c) __builtin_amdgcn_mfma_f32_32x32x16_bf16((a), (b), (c), 0, 0, 0)
constexpr float LOG2E = 1.4426950408889634f;
constexpr float QSCALE = 0.125f * LOG2E;
constexpr int ATT_KROW = 144, ATT_VROW = 136, ATT_KB = 64 * ATT_KROW, ATT_VB = 64 * ATT_VROW;
struct AttU { int b, kvh, qb, hq, n, jlo, nl, T; bool lat; size_t mrow, ctxbase, latbase; };
__device__ __forceinline__ void att_decode(AttU& U, int u, int g, int half, int r) {
    constexpr int NU_LAT = NB * 4 * 64;
    U.lat = u < NU_LAT;
    if (U.lat) { U.b = u >> 8; U.kvh = (u >> 6) & 3; U.qb = u & 63; } else { const int uu = u - NU_LAT; U.b = uu >> 4; U.kvh = (uu >> 2) & 3; U.qb = uu & 3; }
    U.hq = U.kvh * 4 + g; U.n = U.qb * 64 + half * 32 + r;
    U.mrow = U.lat ? (size_t)U.b * SEQ + U.n : (size_t)MLAT + U.b * CTXL + U.n;
    U.jlo = U.lat ? (U.qb - 2 < 0 ? 0 : U.qb - 2) : 0; const int jhi = U.lat ? (U.qb + 2 > 63 ? 63 : U.qb + 2) : -1; U.nl = jhi - U.jlo + 1; U.T = U.nl + 4;
    U.ctxbase = (size_t)MLAT + U.b * CTXL; U.latbase = (size_t)U.b * SEQ;
}
__device__ __forceinline__ void phase_attn_v2(const Frame& F, const Args& A) {
    const bf16* Q = (const bf16*)(A.ws + WS_Q); const bf16* K = (const bf16*)(A.ws + WS_K); const bf16* VT = (const bf16*)(A.ws + WS_V); bf16* O = (bf16*)(A.ws + WS_ATT);
    LAS unsigned char* Kb = F.lds; LAS unsigned char* Vb = F.lds + 2 * ATT_KB;
    const int g = F.wave >> 1, half = F.wave & 1, r = F.lane & 31, hh = F.lane >> 5;
    const int kr = F.tid >> 3, kc = F.tid & 7;
    constexpr int NU = NB * 4 * 64 + NB * 4 * 4;
    int u = F.vcu; bool have = u < NU;
    AttU U{}, Un{}; v4u kreg = (v4u){0u, 0u, 0u, 0u}, vreg = kreg; bf16x8 qfn[4];
#pragma unroll
    for (int ks = 0; ks < 4; ++ks) qfn[ks] = (bf16x8){0, 0, 0, 0, 0, 0, 0, 0};
#define ATT_PREFETCH(UU) do { const size_t rb_ = ((UU).nl > 0) ? (UU).latbase + (size_t)(UU).jlo * 64 : (UU).ctxbase; \
        kreg = *(const v4u*)(K + (rb_ + kr) * 256 + (UU).kvh * 64 + kc * 8); vreg = *(const v4u*)(VT + (size_t)((UU).kvh * 64 + kr) * MTOT + rb_ + kc * 8); \
        _Pragma("unroll") for (int ks_ = 0; ks_ < 4; ++ks_) qfn[ks_] = *(const bf16x8*)(Q + (UU).mrow * 1024 + (UU).hq * 64 + 16 * ks_ + 8 * hh); } while (0)
    if (have) { att_decode(U, u, g, half, r); ATT_PREFETCH(U); }
    while (have) {
        const int b = U.b, kvh = U.kvh, qb = U.qb, hq = U.hq, n = U.n, jlo = U.jlo, nl = U.nl, T = U.T; const size_t mrow = U.mrow, ctxbase = U.ctxbase, latbase = U.latbase; (void)b;
        bf16x8 qf[4];
#pragma unroll
        for (int ks = 0; ks < 4; ++ks) qf[ks] = qfn[ks];
        const float sink2 = A.in[8][hq] * LOG2E;
        float mrun = sink2, lsum = 0.f;
        f32x16 oacc[2];
#pragma unroll
        for (int i = 0; i < 16; ++i) { oacc[0][i] = 0.f; oacc[1][i] = 0.f; }
        *(LAS v4u*)(Kb + kr * ATT_KROW + kc * 16) = kreg;
        *(LAS v2u*)(Vb + kr * ATT_VROW + kc * 16) = (v2u){vreg.x, vreg.y}; *(LAS v2u*)(Vb + kr * ATT_VROW + kc * 16 + 8) = (v2u){vreg.z, vreg.w};
        __syncthreads();
        const int un = u + F.G; const bool hn = un < NU;
        if (hn) att_decode(Un, un, g, half, r);
        for (int t = 0; t < T; ++t) {
            if (t + 1 < T) { const int t1 = t + 1; const size_t rb = (t1 < nl) ? latbase + (size_t)(jlo + t1) * 64 : ctxbase + (size_t)(t1 - nl) * 64;
                kreg = *(const v4u*)(K + (rb + kr) * 256 + kvh * 64 + kc * 8); vreg = *(const v4u*)(VT + (size_t)(kvh * 64 + kr) * MTOT + rb + kc * 8); }
            else if (hn) ATT_PREFETCH(Un);
            const LAS unsigned char* kb = Kb + (t & 1) * ATT_KB; const LAS unsigned char* vb = Vb + (t & 1) * ATT_VB;
            f32x16 st[2];
#pragma unroll
            for (int sub = 0; sub < 2; ++sub) {
#pragma unroll
                for (int i = 0; i < 16; ++i) st[sub][i] = 0.f;
#pragma unroll
                for (int ks = 0; ks < 4; ++ks) { const bf16x8 kf = *(const LAS bf16x8*)(kb + (32 * sub + r) * ATT_KROW + (16 * ks + 8 * hh) * 2); st[sub] = MFMA32(kf, qf[ks], st[sub]); }
            }
            if (t < nl) { const int jt = jlo + t;
                if (jt == qb - 2 || jt == qb + 2) {
#pragma unroll
                    for (int sub = 0; sub < 2; ++sub)
#pragma unroll
                        for (int i = 0; i < 16; ++i) { const int key = jt * 64 + 32 * sub + (i & 3) + 8 * (i >> 2) + 4 * hh; const int d = key - n; if (d > 128 || d < -128) st[sub][i] = -INFINITY; }
                } }
            float mx = st[0][0];
#pragma unroll
            for (int i = 1; i < 16; ++i) mx = fmaxf(mx, st[0][i]);
#pragma unroll
            for (int i = 0; i < 16; ++i) mx = fmaxf(mx, st[1][i]);
            mx = fmaxf(mx, __shfl_xor(mx, 32));
            const float mnew = fmaxf(mrun, mx);
            if (__builtin_amdgcn_ballot_w64(mnew != mrun) != 0ull) {
                const float alpha = __builtin_amdgcn_exp2f(mrun - mnew); mrun = mnew; lsum *= alpha;
#pragma unroll
                for (int i = 0; i < 16; ++i) { oacc[0][i] *= alpha; oacc[1][i] *= alpha; } }
            float ps = 0.f;
#pragma unroll
            for (int sub = 0; sub < 2; ++sub)
#pragma unroll
                for (int i = 0; i < 16; ++i) { const float p = __builtin_amdgcn_exp2f(st[sub][i] - mnew); st[sub][i] = p; ps += p; }
            lsum += ps;
#pragma unroll
            for (int sub = 0; sub < 2; ++sub)
#pragma unroll
                for (int s = 0; s < 2; ++s) {
                    v4u pw; pw.x = cvtpk(st[sub][8 * s], st[sub][8 * s + 1]); pw.y = cvtpk(st[sub][8 * s + 2], st[sub][8 * s + 3]); pw.z = cvtpk(st[sub][8 * s + 4], st[sub][8 * s + 5]); pw.w = cvtpk(st[sub][8 * s + 6], st[sub][8 * s + 7]);
                    const bf16x8 pf = __builtin_bit_cast(bf16x8, pw);
#pragma unroll
                    for (int dt = 0; dt < 2; ++dt) { const LAS unsigned char* vp = vb + (32 * dt + r) * ATT_VROW + (32 * sub + 16 * s + 4 * hh) * 2;
                        const v2u lo = *(const LAS v2u*)vp, hi = *(const LAS v2u*)(vp + 16);
                        const bf16x8 vf = __builtin_bit_cast(bf16x8, (v4u){lo.x, lo.y, hi.x, hi.y});
                        oacc[dt] = MFMA32(vf, pf, oacc[dt]); }
                }
            if (t + 1 < T) { LAS unsigned char* kw = Kb + ((t + 1) & 1) * ATT_KB; LAS unsigned char* vw = Vb + ((t + 1) & 1) * ATT_VB;
                *(LAS v4u*)(kw + kr * ATT_KROW + kc * 16) = kreg;
                *(LAS v2u*)(vw + kr * ATT_VROW + kc * 16) = (v2u){vreg.x, vreg.y}; *(LAS v2u*)(vw + kr * ATT_VROW + kc * 16 + 8) = (v2u){vreg.z, vreg.w}; }
            __syncthreads();
        }
        lsum += __shfl_xor(lsum, 32);
        const float inv = 1.0f / (lsum + __builtin_amdgcn_exp2f(sink2 - mrun));
        bf16* orow = O + mrow * 1024 + hq * 64;
#pragma unroll
        for (int dt = 0; dt < 2; ++dt)
#pragma unroll
            for (int rq = 0; rq < 4; ++rq) { v2u w; w.x = cvtpk(oacc[dt][4 * rq] * inv, oacc[dt][4 * rq + 1] * inv); w.y = cvtpk(oacc[dt][4 * rq + 2] * inv, oacc[dt][4 * rq + 3] * inv);
                *(v2u*)(orow + 32 * dt + 8 * rq + 4 * hh) = w; }
        U = Un; u = un; have = hn;
    }
#undef ATT_PREFETCH
    if (F.G == 256 && F.vcu >= 128) tr_moe_items(F, A.in[26], A.in[27], A.in[28], A.ws + WS_WGU1, A.ws + WS_WD1, 0, L1_ATT, (F.vcu - 128) * NWAVES + F.wave, 128 * NWAVES);
    else if (F.G != 256) tr_moe_items(F, A.in[26], A.in[27], A.in[28], A.ws + WS_WGU1, A.ws + WS_WD1, 0, L1_ATT, F.vcu * NWAVES + F.wave, F.G * NWAVES);
}

template <int R> __device__ __forceinline__ void nr_rows(const Frame& F, const bf16* xres, int m0, const float* g, const float* mod, const LAS float* WrT, unsigned char* H8, float* AFF, float* AFFC, RowCoef& C, int& curb) {
    f32x4 vv[R][4];
#pragma unroll
    for (int t = 0; t < R; ++t) load_row_bf16(vv[t], xres + (size_t)(m0 + t) * D, F.lane);
#pragma unroll
    for (int t = 0; t < R; ++t) { const int m = m0 + t; const int mb = modrow(m);
        if (mb != curb) { load_coef(C, g, mod + (size_t)mb * 6144 + 3 * 1024, mod + (size_t)mb * 6144 + 4 * 1024, F.lane); curb = mb; }
        const float rstd = row_rstd(vv[t]);
#pragma unroll
        for (int j = 0; j < 4; ++j) vv[t][j] = vv[t][j] * rstd * C.a[j] + C.b[j];
#pragma unroll
        for (int j = 0; j < 4; ++j) ((unsigned*)(H8 + (size_t)m * D))[F.lane + 64 * j] = pk4f8(vv[t][j].x, vv[t][j].y, vv[t][j].z, vv[t][j].w); }
    const LAS float* wrt = WrT; asm volatile("" : "+v"(wrt));
    float lgt[R];
    proj16xR<R>(vv, wrt, F.lane, lgt);
#pragma unroll
    for (int t = 0; t < R; ++t) { const float logit = lgt[t];
        float mx = logit;
#pragma unroll
        for (int o = 4; o < 64; o <<= 1) mx = fmaxf(mx, __shfl_xor(mx, o));
        const float ex = expf(logit - mx); float den = ex;
#pragma unroll
        for (int o = 4; o < 64; o <<= 1) den += __shfl_xor(den, o);
        const float mine = ex / den; const int ee = F.lane >> 2; const int m = m0 + t;
        if ((F.lane & 3) == 0) { if (m < MLAT) AFF[((size_t)(m >> 12) * NE + ee) * SEQ + (m & 4095)] = mine; else { const int mm = m - MLAT; AFFC[((size_t)(mm >> 8) * NE + ee) * CTXL + (mm & 255)] = mine; } } }
}
__device__ __forceinline__ void phase_norm_router(const Frame& F, const Args& A, const bf16* xres, int nrows, const float* g, const float* mod, const float* router) {
    LAS float* WrT = (LAS float*)F.lds;
    for (int idx = F.tid; idx < 16384; idx += NTHR) WrT[(idx & 15) * 1024 + (idx >> 4)] = router[idx];
    __syncthreads();
    const int gw = F.vcu * NWAVES + F.wave, NGW = F.G * NWAVES;
    unsigned char* H8 = A.ws + WS_H8; float* AFF = (float*)(A.ws + WS_AFF); float* AFFC = AFF + (size_t)NB * NE * SEQ;
    const int rpw = (nrows + NGW - 1) / NGW;
    int curb = -1; RowCoef C;
    const int mbeg = gw * rpw, cnt = (nrows - mbeg) < rpw ? (nrows - mbeg) : rpw;
    int r = 0;
    for (; r + 4 <= cnt; r += 4) nr_rows<4>(F, xres, mbeg + r, g, mod, WrT, H8, AFF, AFFC, C, curb);
    for (; r < cnt; ++r) nr_rows<1>(F, xres, mbeg + r, g, mod, WrT, H8, AFF, AFFC, C, curb);
    __syncthreads();
}

__device__ __forceinline__ void phase_topk(const Frame& F, const Args& A, bool with_ctx, int erows, const float* cwg, const float* cwu, const float* cwd, unsigned char* cwgu, unsigned char* cwdn, int clo, int chi) {
    LAS unsigned* hist = (LAS unsigned*)F.lds;
    LAS unsigned* ctl = hist + 256;
    LAS unsigned* wsum = hist + 272;
    LAS int* sel = (LAS int*)(hist + 512);
    const float* AFF = (const float*)(A.ws + WS_AFF); const float* AFFC = AFF + (size_t)NB * NE * SEQ;
    float* GW = (float*)(A.ws + WS_GW); int* SLOT = (int*)(A.ws + WS_SLOT);
    const unsigned char* H8 = A.ws + WS_H8; unsigned char* XG = A.ws + WS_XG;
    const int nprob = with_ctx ? 256 : 128;
    for (int p = F.vcu; p < nprob; p += F.G) {
        int b, e, N, cap, rowbase, tokbase; const float* src;
        if (p < 128) { b = p >> 4; e = p & 15; N = SEQ; cap = CAPL; src = AFF + (size_t)(b * NE + e) * SEQ; rowbase = e * erows + b * CAPL; tokbase = b * SEQ; }
        else { const int pp = p - 128; b = pp >> 4; e = pp & 15; N = CTXL; cap = CAPC; src = AFFC + (size_t)(b * NE + e) * CTXL; rowbase = e * erows + NB * CAPL + b * CAPC; tokbase = MLAT + b * CTXL; }
        const bool own = 8 * F.tid < N;
        unsigned v[8];
        { f32x4 x0 = (f32x4){0.f, 0.f, 0.f, 0.f}, x1 = x0; if (own) { x0 = ((const f32x4*)src)[2 * F.tid]; x1 = ((const f32x4*)src)[2 * F.tid + 1]; }
          v[0] = __float_as_uint(x0.x); v[1] = __float_as_uint(x0.y); v[2] = __float_as_uint(x0.z); v[3] = __float_as_uint(x0.w); v[4] = __float_as_uint(x1.x); v[5] = __float_as_uint(x1.y); v[6] = __float_as_uint(x1.z); v[7] = __float_as_uint(x1.w); }
        unsigned prefix = 0u, need = (unsigned)cap;
#pragma unroll
        for (int pass = 0; pass < 4; ++pass) { const int shift = 24 - 8 * pass;
            if (F.tid < 256) hist[F.tid] = 0u;
            __syncthreads();
            if (own) {
#pragma unroll
                for (int k = 0; k < 8; ++k) { const bool match = (pass == 0) ? true : ((v[k] >> ((shift + 8) & 31)) == (prefix >> ((shift + 8) & 31))); if (match) atomicAdd((unsigned*)&hist[(v[k] >> shift) & 255u], 1u); } }
            __syncthreads();
            if (F.wave == 0) { const unsigned c0 = hist[4 * F.lane], c1 = hist[4 * F.lane + 1], c2 = hist[4 * F.lane + 2], c3 = hist[4 * F.lane + 3]; const unsigned tot = (c0 + c1) + (c2 + c3);
                unsigned sv = tot;
#pragma unroll
                for (int o = 1; o < 64; o <<= 1) { const unsigned t = __shfl_down(sv, o); if (F.lane + o < 64) sv += t; }
                const unsigned g3 = sv - tot, g2 = g3 + c3, g1 = g2 + c2, g0 = g1 + c1;
                if (g3 < need && need <= g3 + c3) { ctl[0] = 4 * F.lane + 3; ctl[1] = need - g3; }
                else if (g2 < need && need <= g2 + c2) { ctl[0] = 4 * F.lane + 2; ctl[1] = need - g2; }
                else if (g1 < need && need <= g1 + c1) { ctl[0] = 4 * F.lane + 1; ctl[1] = need - g1; }
                else if (g0 < need && need <= g0 + c0) { ctl[0] = 4 * F.lane; ctl[1] = need - g0; } }
            __syncthreads();
            prefix |= ctl[0] << shift; need = ctl[1]; }
        const unsigned T = prefix;
        unsigned packed = 0u;
        if (own) {
#pragma unroll
            for (int k = 0; k < 8; ++k) packed += (v[k] > T ? 1u : 0u) + (v[k] == T ? 0x10000u : 0u); }
        unsigned incl = packed;
#pragma unroll
        for (int o = 1; o < 64; o <<= 1) { const unsigned t = __shfl_up(incl, o); if (F.lane >= o) incl += t; }
        if (F.lane == 63) wsum[F.wave] = incl;
        __syncthreads();
        unsigned base = 0u;
#pragma unroll
        for (int w = 0; w < 8; ++w) if (w < F.wave) base += wsum[w];
        unsigned rg = ((incl - packed) + base) & 0xffffu, re = ((incl - packed) + base) >> 16; const unsigned totalgt = (unsigned)cap - need;
        if (own) {
#pragma unroll
            for (int k = 0; k < 8; ++k) { const int tok = tokbase + 8 * F.tid + k; int slot = -1;
                if (v[k] > T) { slot = (int)rg; ++rg; } else if (v[k] == T) { if (re < need) slot = (int)(totalgt + re); ++re; }
                if (slot >= 0) { GW[rowbase + slot] = __uint_as_float(v[k]); SLOT[(size_t)tok * 16 + e] = rowbase + slot; sel[slot] = tok; } else SLOT[(size_t)tok * 16 + e] = -1; } }
        __syncthreads();
        for (int i0 = F.wave; i0 < cap; i0 += 8 * NWAVES) {
            v4u x[8];
#pragma unroll
            for (int q = 0; q < 8; ++q) { const int i = i0 + q * NWAVES; const int tok = sel[i < cap ? i : i0]; x[q] = ((const v4u*)(H8 + (size_t)tok * D))[F.lane]; }
#pragma unroll
            for (int q = 0; q < 8; ++q) { const int i = i0 + q * NWAVES; if (i < cap) ((v4u*)(XG + (size_t)(rowbase + i) * D))[F.lane] = x[q]; } }
        __syncthreads();
    }
    if (F.G == 256) { if (F.vcu >= 128) tr_moe_items(F, cwg, cwu, cwd, cwgu, cwdn, clo, chi, (F.vcu - 128) * NWAVES + F.wave, 128 * NWAVES); }
    else tr_moe_items(F, cwg, cwu, cwd, cwgu, cwdn, clo, chi, F.vcu * NWAVES + F.wave, F.G * NWAVES);
}

struct CombineIn { int sv; v2u xr[4]; };
__device__ __forceinline__ void combine_issue(CombineIn& ci, const bf16* xres_row, const int* slot_row, int lane) {
    ci.sv = slot_row[lane & 15];
#pragma unroll
    for (int j = 0; j < 4; ++j) ci.xr[j] = ((const v2u*)xres_row)[lane + 64 * j];
}
__device__ __forceinline__ void combine_finish(f32x4 (&v)[4], const CombineIn& ci, const bf16* Y, const float* GW, const float* gt2, int lane) {
    f32x4 acc[4];
#pragma unroll
    for (int j = 0; j < 4; ++j) acc[j] = (f32x4){0.f, 0.f, 0.f, 0.f};
    const int sv = ci.sv;
    unsigned mask = (unsigned)(__builtin_amdgcn_ballot_w64(sv >= 0) & 0xffffull);
    while (mask) {
        v2u w[4][4]; float gte[4];
#pragma unroll
        for (int q = 0; q < 4; ++q) {
            gte[q] = 0.f;
#pragma unroll
            for (int j = 0; j < 4; ++j) w[q][j] = (v2u){0u, 0u};
            if (mask) { const int e = __builtin_ctz(mask); mask &= mask - 1u; const int s = __builtin_amdgcn_readlane(sv, e);
                gte[q] = GW[s]; const v2u* yr = (const v2u*)(Y + (size_t)s * D);
#pragma unroll
                for (int j = 0; j < 4; ++j) w[q][j] = yr[lane + 64 * j]; } }
#pragma unroll
        for (int q = 0; q < 4; ++q)
#pragma unroll
            for (int j = 0; j < 4; ++j) acc[j] += (f32x4){bflo(w[q][j].x), bfhi(w[q][j].x), bflo(w[q][j].y), bfhi(w[q][j].y)} * gte[q];
    }
#pragma unroll
    for (int j = 0; j < 4; ++j) v[j] = (f32x4){bflo(ci.xr[j].x), bfhi(ci.xr[j].x), bflo(ci.xr[j].y), bfhi(ci.xr[j].y)} + ((const f32x4*)gt2)[lane + 64 * j] * acc[j];
}

template <int R> __device__ __forceinline__ void cmb_rows(const Frame& F, const Args& A, int m0, const LAS float* WabT, RowCoef& C, int& curb, float alog, float dtb) {
    const float* MOD0 = (const float*)(A.ws + WS_MOD); const float* MOD1 = MOD0 + 9 * 6144;
    bf16* XRES = (bf16*)(A.ws + WS_XRES); bf16* H = (bf16*)(A.ws + WS_H); const bf16* Y = (const bf16*)(A.ws + WS_XG); const int* SLOT = (const int*)(A.ws + WS_SLOT);
    float* Gb = (float*)(A.ws + WS_G); float* Bb = (float*)(A.ws + WS_BETA);
    f32x4 vv[R][4]; CombineIn ci[R];
#pragma unroll
    for (int t = 0; t < R; ++t) combine_issue(ci[t], XRES + (size_t)(m0 + t) * D, SLOT + (size_t)(m0 + t) * 16, F.lane);
#pragma unroll
    for (int t = 0; t < R; ++t) { const int m = m0 + t; const int mb = modrow(m);
        if (mb != curb) { load_coef(C, A.in[17], MOD1 + (size_t)mb * 6144, MOD1 + (size_t)mb * 6144 + 1024, F.lane); curb = mb; }
        combine_finish(vv[t], ci[t], Y, (const float*)(A.ws + WS_GW), MOD0 + (size_t)mb * 6144 + 5 * 1024, F.lane);
        store_row_bf16(XRES + (size_t)m * D, vv[t], F.lane);
        const float rstd = row_rstd(vv[t]);
#pragma unroll
        for (int j = 0; j < 4; ++j) vv[t][j] = vv[t][j] * rstd * C.a[j] + C.b[j];
        store_row_bf16(H + (size_t)m * D, vv[t], F.lane); }
    const LAS float* wab = WabT; asm volatile("" : "+v"(wab));
    float av[R], bv[R];
    proj16xR<R>(vv, wab, F.lane, av); proj16xR<R>(vv, wab + 16 * 1024, F.lane, bv);
    if ((F.lane & 3) == 0) { const int jj = F.lane >> 2;
#pragma unroll
        for (int t = 0; t < R; ++t) { const int m = m0 + t; const float xx = av[t] + dtb; const float sp = fmaxf(xx, 0.f) + log1pf(expf(-fabsf(xx))); Gb[(size_t)m * 16 + jj] = -expf(alog) * sp; Bb[(size_t)m * 16 + jj] = 1.0f / (1.0f + expf(-bv[t])); } }
}
__device__ __forceinline__ void phase_combine0(const Frame& F, const Args& A) {
    const int gw = F.vcu * NWAVES + F.wave, NGW = F.G * NWAVES;
    tr_moe_items(F, A.in[26], A.in[27], A.in[28], A.ws + WS_WGU1, A.ws + WS_WD1, L1_ATT + L1_G2 + L1_WIN, L1_ATT + L1_G2 + L1_WIN + L1_CMB, gw, NGW);
    __syncthreads();
    LAS float* WabT = (LAS float*)F.lds;
    for (int idx = F.tid; idx < 32768; idx += NTHR) { const int k = idx >> 5, j = idx & 31; WabT[j * 1024 + k] = A.in[18][(size_t)k * LDWIN + 4096 + j]; }
    __syncthreads();
    const int rpw = (MTOT + NGW - 1) / NGW;
    int curb = -1; RowCoef C;
    const float alog = A.in[20][(F.lane >> 2) & 15], dtb = A.in[21][(F.lane >> 2) & 15];
    const int mbeg = gw * rpw, cnt = (MTOT - mbeg) < rpw ? (MTOT - mbeg) : rpw;
    int r = 0;
    for (; r + 4 <= cnt; r += 4) cmb_rows<4>(F, A, mbeg + r, WabT, C, curb, alog, dtb);
    for (; r < cnt; ++r) cmb_rows<1>(F, A, mbeg + r, WabT, C, curb, alog, dtb);
    __syncthreads();
}

__device__ __forceinline__ void phase_conv(const Frame& F, const Args& A) {
    const int gw = F.vcu * NWAVES + F.wave, NGW = F.G * NWAVES;
    const bf16* P = (const bf16*)(A.ws + WS_PQKV); const float* cw = A.in[19];
    bf16* out0 = (bf16*)(A.ws + WS_QN);
    const int nchunk = NGW / 2, rpc = (MTOT + nchunk - 1) / nchunk;
    const int half = gw & 1, chunk = gw >> 1;
    const int mbeg = chunk * rpc, cnt = (MTOT - mbeg) < rpc ? (MTOT - mbeg) : rpc;
    if (cnt <= 0) return;
    float w[3][3][8];
#pragma unroll
    for (int ii = 0; ii < 3; ++ii) { const int c = 512 * (3 * half + ii) + 8 * F.lane;
#pragma unroll
        for (int j = 0; j < 3; ++j) { const f32x4 a = *(const f32x4*)(cw + j * 3072 + c), bq = *(const f32x4*)(cw + j * 3072 + c + 4);
            w[ii][j][0] = a.x; w[ii][j][1] = a.y; w[ii][j][2] = a.z; w[ii][j][3] = a.w; w[ii][j][4] = bq.x; w[ii][j][5] = bq.y; w[ii][j][6] = bq.z; w[ii][j][7] = bq.w; } }
    v4u xp[3], xc[3], xn[3], xnn[3];
    const int cbase = 512 * 3 * half + 8 * F.lane;
#pragma unroll
    for (int ii = 0; ii < 3; ++ii) { xp[ii] = (v4u){0u, 0u, 0u, 0u}; xc[ii] = *(const v4u*)(P + (size_t)mbeg * 3072 + cbase + 512 * ii); xn[ii] = (v4u){0u, 0u, 0u, 0u}; xnn[ii] = (v4u){0u, 0u, 0u, 0u}; }
    if (mbeg > 0) {
#pragma unroll
        for (int ii = 0; ii < 3; ++ii) xp[ii] = *(const v4u*)(P + (size_t)(mbeg - 1) * 3072 + cbase + 512 * ii); }
    if (mbeg + 1 < MTOT) {
#pragma unroll
        for (int ii = 0; ii < 3; ++ii) xn[ii] = *(const v4u*)(P + (size_t)(mbeg + 1) * 3072 + cbase + 512 * ii); }
    for (int r = 0; r < cnt; ++r) { const int m = mbeg + r;
        bool hp, hn; if (m < MLAT) { const int n = m & 4095; hp = n > 0; hn = n < SEQ - 1; } else { const int l = (m - MLAT) & 255; hp = l > 0; hn = l < CTXL - 1; }
        if (m + 2 < MTOT) {
#pragma unroll
            for (int ii = 0; ii < 3; ++ii) xnn[ii] = *(const v4u*)(P + (size_t)(m + 2) * 3072 + cbase + 512 * ii); }
#pragma unroll
        for (int ii = 0; ii < 3; ++ii) { const int i = 3 * half + ii;
            const v4u a = hp ? xp[ii] : (v4u){0u, 0u, 0u, 0u}, c = xc[ii], e = hn ? xn[ii] : (v4u){0u, 0u, 0u, 0u};
            float y[8];
            y[0] = bflo(a.x) * w[ii][0][0] + bflo(c.x) * w[ii][1][0] + bflo(e.x) * w[ii][2][0]; y[1] = bfhi(a.x) * w[ii][0][1] + bfhi(c.x) * w[ii][1][1] + bfhi(e.x) * w[ii][2][1];
            y[2] = bflo(a.y) * w[ii][0][2] + bflo(c.y) * w[ii][1][2] + bflo(e.y) * w[ii][2][2]; y[3] = bfhi(a.y) * w[ii][0][3] + bfhi(c.y) * w[ii][1][3] + bfhi(e.y) * w[ii][2][3];
            y[4] = bflo(a.z) * w[ii][0][4] + bflo(c.z) * w[ii][1][4] + bflo(e.z) * w[ii][2][4]; y[5] = bfhi(a.z) * w[ii][0][5] + bfhi(c.z) * w[ii][1][5] + bfhi(e.z) * w[ii][2][5];
            y[6] = bflo(a.w) * w[ii][0][6] + bflo(c.w) * w[ii][1][6] + bflo(e.w) * w[ii][2][6]; y[7] = bfhi(a.w) * w[ii][0][7] + bfhi(c.w) * w[ii][1][7] + bfhi(e.w) * w[ii][2][7];
            float ss = 0.f;
#pragma unroll
            for (int t = 0; t < 8; ++t) { y[t] = silu_f(y[t]); ss += y[t] * y[t]; }
            if (i < 4) { ss += __shfl_xor(ss, 1); ss += __shfl_xor(ss, 2); ss += __shfl_xor(ss, 4); ss += __shfl_xor(ss, 8);
                const float sc = (1.0f / sqrtf(ss + EPS)) * (i < 2 ? 0.08838834764831845f : 1.0f);
#pragma unroll
                for (int t = 0; t < 8; ++t) y[t] *= sc; }
            v4u o; o.x = pkbf(y[0], y[1]); o.y = pkbf(y[2], y[3]); o.z = pkbf(y[4], y[5]); o.w = pkbf(y[6], y[7]);
            *(v4u*)(out0 + (size_t)(i >> 1) * (68 * MiB / 2) + (size_t)m * D + ((512 * i + 8 * F.lane) & 1023)) = o;
            xp[ii] = xc[ii]; xc[ii] = xn[ii]; xn[ii] = xnn[ii];
        }
    }
}

constexpr int NCHK = 68, NTASK = NB * 8 * NCHK * 2;
constexpr int TAB_OFF = RING_BYTES + 1024;
typedef short s16x4 __attribute__((ext_vector_type(4)));
typedef short v4i16_t __attribute__((ext_vector_type(4)));
__device__ __forceinline__ size_t gdn_tok0(int b, int cidx) { return cidx < 4 ? (size_t)MLAT + b * CTXL + cidx * 64 : (size_t)b * SEQ + (size_t)(cidx - 4) * 64; }
__device__ __forceinline__ bf16x8 tr_pair(const LAS unsigned char* p, int rowstride4) {
    const s16x4 lo = __builtin_bit_cast(s16x4, __builtin_amdgcn_ds_read_tr16_b64_v4i16((LAS v4i16_t*)p));
    const s16x4 hi = __builtin_bit_cast(s16x4, __builtin_amdgcn_ds_read_tr16_b64_v4i16((LAS v4i16_t*)(p + rowstride4)));
    return (bf16x8){lo[0], lo[1], lo[2], lo[3], hi[0], hi[1], hi[2], hi[3]};
}
__device__ __forceinline__ void st_acc_T(LAS unsigned char* base, int stride, int col, int row0, const f32x16& a, int hh) {
#pragma unroll
    for (int rq = 0; rq < 4; ++rq) { v2u w; w.x = cvtpk(a[4 * rq], a[4 * rq + 1]); w.y = cvtpk(a[4 * rq + 2], a[4 * rq + 3]); *(LAS v2u*)(base + col * stride + (row0 + 8 * rq + 4 * hh) * 2) = w; }
}

__device__ __forceinline__ void phase_gdn_prep(const Frame& F, const Args& A) {
    const bf16* QN = (const bf16*)(A.ws + WS_QN); const bf16* KN = (const bf16*)(A.ws + WS_KN);
    const float* Gb = (const float*)(A.ws + WS_G); const float* Bb = (const float*)(A.ws + WS_BETA);
    bf16* TB = (bf16*)(A.ws + WS_TB); bf16* TG = (bf16*)(A.ws + WS_TG); bf16* QKD = (bf16*)(A.ws + WS_QKD); float* GC = (float*)(A.ws + WS_GC);
    LAS float* As = (LAS float*)(F.lds + F.wave * 16384);
    LAS float* tab = (LAS float*)(F.lds + TAB_OFF + F.wave * 512);
    const int gw = F.vcu * NWAVES + F.wave, NGW = F.G * NWAVES;
    for (int task = gw; task < NTASK; task += NGW) {
        int ln = F.lane; asm volatile("" : "+v"(ln));
        const int r = ln & 31, hh = ln >> 5;
        const int dir = task & 1, t2 = task >> 1, cidx = t2 % NCHK, bh = t2 / NCHK, h = bh & 7, b = bh >> 3;
        const size_t m0 = gdn_tok0(b, cidx);
        { const size_t mi = m0 + (dir ? 63 - ln : ln);
          float gc = Gb[mi * 16 + dir * 8 + h]; const float bt = Bb[mi * 16 + dir * 8 + h];
#pragma unroll
          for (int o = 1; o < 64; o <<= 1) { const float t = __shfl_up(gc, o); if (ln >= o) gc += t; }
          tab[ln] = gc; tab[64 + ln] = bt; GC[(size_t)task * 64 + ln] = gc; }
        bf16x8 kf[2][8], qf[2][8];
        LAS unsigned char* tl8 = (LAS unsigned char*)As;
        const int l4 = ln >> 4, l15 = ln & 15, rr = ln & 31, h2 = ln >> 5;
#pragma unroll
        for (int which = 0; which < 2; ++which) { const bf16* src = which ? KN : QN;
#pragma unroll
            for (int hb = 0; hb < 2; ++hb) { v4u st[8];
#pragma unroll
                for (int i = 0; i < 8; ++i) { const int row = 32 * hb + 4 * i + l4; const size_t m = m0 + (dir ? 63 - row : row); st[i] = *(const v4u*)(src + m * D + h * 128 + l15 * 8); }
#pragma unroll
                for (int i = 0; i < 8; ++i) { const int row = 32 * hb + 4 * i + l4; *(LAS v4u*)(tl8 + (row * 16 + (l15 ^ (row & 15))) * 16) = st[i]; }
                asm volatile("" ::: "memory"); }
            LDS_WAIT();
#pragma unroll
            for (int ti = 0; ti < 2; ++ti) { const int row = 32 * ti + rr;
#pragma unroll
                for (int s = 0; s < 8; ++s) { const bf16x8 f = *(const LAS bf16x8*)(tl8 + (row * 16 + ((2 * s + h2) ^ (row & 15))) * 16); if (which) kf[ti][s] = f; else qf[ti][s] = f; } }
            LDS_WAIT();
        }
#pragma unroll
        for (int tile = 0; tile < 3; ++tile) { const int ti = tile == 0 ? 0 : 1, tj = tile == 2 ? 1 : 0;
            f32x16 acc;
#pragma unroll
            for (int i = 0; i < 16; ++i) acc[i] = 0.f;
#pragma unroll
            for (int s = 0; s < 8; ++s) acc = MFMA32(kf[ti][s], kf[tj][s], acc);
            const int j = 32 * tj + r; const float gcj = tab[j];
#pragma unroll
            for (int i16 = 0; i16 < 16; ++i16) { const int i = 32 * ti + (i16 & 3) + 8 * (i16 >> 2) + 4 * hh;
                As[i * 64 + j] = (i > j) ? tab[64 + i] * acc[i16] * __expf(tab[i] - gcj) : 0.f; } }
        bf16* qkd = QKD + (size_t)task * 4096;
#pragma unroll
        for (int ti = 0; ti < 2; ++ti) { const int row = 32 * ti + r;
            const float gci = tab[row];
#pragma unroll
            for (int tj = 0; tj < 2; ++tj) {
                if (tj > ti) { *(v4u*)(qkd + row * 64 + 32 + 16 * hh) = (v4u){0u, 0u, 0u, 0u}; *(v4u*)(qkd + row * 64 + 32 + 16 * hh + 8) = (v4u){0u, 0u, 0u, 0u}; continue; }
                f32x16 acc;
#pragma unroll
                for (int i = 0; i < 16; ++i) acc[i] = 0.f;
#pragma unroll
                for (int s = 0; s < 8; ++s) acc = MFMA32(kf[tj][s], qf[ti][s], acc);
#pragma unroll
                for (int rq = 0; rq < 4; ++rq) { const int j0 = 32 * tj + 8 * rq + 4 * hh; float v[4];
#pragma unroll
                    for (int e = 0; e < 4; ++e) { const int j = j0 + e; v[e] = (row >= j) ? acc[4 * rq + e] * __expf(gci - tab[j]) : 0.f; }
                    v2u w; w.x = cvtpk(v[0], v[1]); w.y = cvtpk(v[2], v[3]); *(v2u*)(qkd + row * 64 + j0) = w; }
            } }
        LDS_WAIT();
        float Tc[64];
#pragma unroll
        for (int i = 0; i < 64; ++i) { float acc = (ln == i) ? 1.f : 0.f;
#pragma unroll
            for (int jq = 0; jq < (i + 3) / 4; ++jq) { const f32x4 a4 = *(const LAS f32x4*)(As + i * 64 + 4 * jq);
                if (4 * jq + 0 < i) acc -= a4.x * Tc[4 * jq + 0];
                if (4 * jq + 1 < i) acc -= a4.y * Tc[4 * jq + 1];
                if (4 * jq + 2 < i) acc -= a4.z * Tc[4 * jq + 2];
                if (4 * jq + 3 < i) acc -= a4.w * Tc[4 * jq + 3]; }
            Tc[i] = acc; }
        { const float sb = tab[64 + ln], sg = -sb * __expf(tab[ln]);
          bf16* tb = TB + (size_t)task * 4096 + ln; bf16* tg = TG + (size_t)task * 4096 + ln;
#pragma unroll
          for (int i = 0; i < 64; ++i) { tb[i * 64] = (bf16)(cvtpk(Tc[i] * sb, 0.f) & 0xffffu); tg[i * 64] = (bf16)(cvtpk(Tc[i] * sg, 0.f) & 0xffffu); } }
        LDS_WAIT();
    }
    if (F.G == 256 && F.vcu >= 64) tr_moe_items(F, A.in[26], A.in[27], A.in[28], A.ws + WS_WGU1, A.ws + WS_WD1, L1_ATT + L1_G2 + L1_WIN + L1_CMB, L1_ATT + L1_G2 + L1_WIN + L1_CMB + L1_PREP, (F.vcu - 64) * NWAVES + F.wave, 192 * NWAVES);
    else if (F.G != 256) tr_moe_items(F, A.in[26], A.in[27], A.in[28], A.ws + WS_WGU1, A.ws + WS_WD1, L1_ATT + L1_G2 + L1_WIN + L1_CMB, L1_ATT + L1_G2 + L1_WIN + L1_CMB + L1_PREP, F.vcu * NWAVES + F.wave, F.G * NWAVES);
}

constexpr int G_QS = 0, G_KS = 17408, G_VS = 37888, G_TBS = 50176, G_TGS = 59392, G_QKS = 68608, G_WS = 77824, G_SS = 95232, G_VNS = 112640, G_VSS = 121856;
constexpr int G_SQ = 272, G_SK = 320, G_SV = 192, G_ST = 144;
__device__ __forceinline__ void phase_gdn_scan(const Frame& F, const Args& A) {
    const bf16* QN = (const bf16*)(A.ws + WS_QN); const bf16* KN = (const bf16*)(A.ws + WS_KN); const bf16* VV = (const bf16*)(A.ws + WS_VV);
    const bf16* TB = (const bf16*)(A.ws + WS_TB); const bf16* TG = (const bf16*)(A.ws + WS_TG); const bf16* QKD = (const bf16*)(A.ws + WS_QKD); const float* GC = (const float*)(A.ws + WS_GC);
    bf16* OF = (bf16*)A.out; bf16* OB = OF + (size_t)MLAT * D;
    LAS unsigned char* L = F.lds; LAS float* tab = (LAS float*)(F.lds + TAB_OFF);
    const int w = F.wave, r = F.lane & 31, hh = F.lane >> 5, g16 = F.lane >> 4, q4 = (F.lane & 15) >> 2, p4 = F.lane & 3;
    const int dkt = w >> 1, tt1 = w & 1, dvtS = w & 1;
    const int ttv = (w & 3) >> 1, dvtv = w & 1;
    const int dvto = (w & 3) >> 1, tto = w & 1;
    const int trrow = 8 * (g16 >> 1) + q4, trcol = 16 * (g16 & 1) + 4 * p4;
    for (int unit = F.vcu; unit < 256; unit += F.G) {
        const int half = unit & 1, dir = (unit >> 1) & 1, h = (unit >> 2) & 7, b = unit >> 5;
        bf16* O = dir ? OB : OF;
        f32x16 accS;
#pragma unroll
        for (int i = 0; i < 16; ++i) accS[i] = 0.f;
        v4u pre[8]; float gcv = 0.f, gcl = 0.f;
#define GDN_LOAD(S_) do { const int cidx_ = dir ? ((S_) < 4 ? 3 - (S_) : 71 - (S_)) : (S_); const size_t m0_ = gdn_tok0(b, cidx_); const size_t task_ = ((size_t)((b * 8 + h) * NCHK + cidx_)) * 2 + dir; \
        _Pragma("unroll") for (int e_ = 0; e_ < 2; ++e_) { const int ci_ = F.tid + 512 * e_, row_ = ci_ >> 4, c16_ = ci_ & 15; const size_t m_ = m0_ + (dir ? 63 - row_ : row_); \
            pre[e_] = *(const v4u*)(QN + m_ * D + h * 128 + c16_ * 8); pre[2 + e_] = *(const v4u*)(KN + m_ * D + h * 128 + c16_ * 8); } \
        { const int row_ = F.tid >> 3, c16_ = F.tid & 7; const size_t m_ = m0_ + (dir ? 63 - row_ : row_); pre[4] = *(const v4u*)(VV + m_ * D + h * 128 + half * 64 + c16_ * 8); \
          pre[5] = *(const v4u*)(TB + task_ * 4096 + F.tid * 8); pre[6] = *(const v4u*)(TG + task_ * 4096 + F.tid * 8); pre[7] = *(const v4u*)(QKD + task_ * 4096 + F.tid * 8); } \
        gcv = GC[task_ * 64 + (F.tid & 63)]; gcl = GC[task_ * 64 + 63]; } while (0)
#define GDN_STAGE() do { \
        _Pragma("unroll") for (int e_ = 0; e_ < 2; ++e_) { const int ci_ = F.tid + 512 * e_, row_ = ci_ >> 4, c16_ = ci_ & 15; \
            *(LAS v4u*)(L + G_QS + row_ * G_SQ + c16_ * 16) = pre[e_]; *(LAS v4u*)(L + G_KS + row_ * G_SK + c16_ * 16) = pre[2 + e_]; } \
        { const int row_ = F.tid >> 3, c16_ = F.tid & 7; *(LAS v4u*)(L + G_VS + row_ * G_SV + c16_ * 16) = pre[4]; \
          *(LAS v4u*)(L + G_TBS + row_ * G_ST + c16_ * 16) = pre[5]; *(LAS v4u*)(L + G_TGS + row_ * G_ST + c16_ * 16) = pre[6]; *(LAS v4u*)(L + G_QKS + row_ * G_ST + c16_ * 16) = pre[7]; } \
        if (F.tid < 64) { tab[F.tid] = __expf(gcv); tab[64 + F.tid] = __expf(gcl - gcv); if (F.tid == 0) tab[128] = __expf(gcl); } } while (0)
#define GDN_STAGE_A() do { \
        _Pragma("unroll") for (int e_ = 0; e_ < 2; ++e_) { const int ci_ = F.tid + 512 * e_, row_ = ci_ >> 4, c16_ = ci_ & 15; *(LAS v4u*)(L + G_KS + row_ * G_SK + c16_ * 16) = pre[2 + e_]; } \
        { const int row_ = F.tid >> 3, c16_ = F.tid & 7; *(LAS v4u*)(L + G_VS + row_ * G_SV + c16_ * 16) = pre[4]; \
          *(LAS v4u*)(L + G_TBS + row_ * G_ST + c16_ * 16) = pre[5]; *(LAS v4u*)(L + G_TGS + row_ * G_ST + c16_ * 16) = pre[6]; } } while (0)
#define GDN_STAGE_B() do { \
        _Pragma("unroll") for (int e_ = 0; e_ < 2; ++e_) { const int ci_ = F.tid + 512 * e_, row_ = ci_ >> 4, c16_ = ci_ & 15; *(LAS v4u*)(L + G_QS + row_ * G_SQ + c16_ * 16) = pre[e_]; } \
        { const int row_ = F.tid >> 3, c16_ = F.tid & 7; *(LAS v4u*)(L + G_QKS + row_ * G_ST + c16_ * 16) = pre[7]; } \
        if (F.tid < 64) { tab[F.tid] = __expf(gcv); tab[64 + F.tid] = __expf(gcl - gcv); if (F.tid == 0) tab[128] = __expf(gcl); } } while (0)
        GDN_LOAD(0); GDN_STAGE();
        __syncthreads();
        for (int s = 0; s < NCHK; ++s) {
            const int cidx = dir ? (s < 4 ? 3 - s : 71 - s) : s; const size_t m0 = gdn_tok0(b, cidx);
            if (s + 1 < NCHK) GDN_LOAD(s + 1);
            bf16x8 kT[4];
#pragma unroll
            for (int ks = 0; ks < 4; ++ks) kT[ks] = tr_pair(L + G_KS + (16 * ks + trrow) * G_SK + (32 * dkt + trcol) * 2, 4 * G_SK);
            { f32x16 accw;
#pragma unroll
              for (int i = 0; i < 16; ++i) accw[i] = 0.f;
#pragma unroll
              for (int ks = 0; ks < 4; ++ks) { const bf16x8 bq = *(const LAS bf16x8*)(L + G_TGS + (32 * tt1 + r) * G_ST + (16 * ks + 8 * hh) * 2); accw = MFMA32(kT[ks], bq, accw); }
              st_acc_T(L + G_WS, G_SQ, 32 * tt1 + r, 32 * dkt, accw, hh); }
            f32x16 accv;
#pragma unroll
            for (int i = 0; i < 16; ++i) accv[i] = 0.f;
            if (w < 4) {
#pragma unroll
                for (int ks = 0; ks < 4; ++ks) { const bf16x8 a = *(const LAS bf16x8*)(L + G_TBS + (32 * ttv + r) * G_ST + (16 * ks + 8 * hh) * 2);
                    const bf16x8 bv = tr_pair(L + G_VS + (16 * ks + trrow) * G_SV + (32 * dvtv + trcol) * 2, 4 * G_SV); accv = MFMA32(a, bv, accv); }
            }
            st_acc_T(L + G_SS, G_SQ, 32 * dvtS + r, 32 * dkt, accS, hh);
            __syncthreads();
            if (s + 1 < NCHK) GDN_STAGE_A();
            f32x16 acco;
#pragma unroll
            for (int i = 0; i < 16; ++i) acco[i] = 0.f;
            if (w < 4) {
#pragma unroll
                for (int ks = 0; ks < 8; ++ks) { const bf16x8 a = *(const LAS bf16x8*)(L + G_WS + (32 * ttv + r) * G_SQ + (16 * ks + 8 * hh) * 2);
                    const bf16x8 bs = *(const LAS bf16x8*)(L + G_SS + (32 * dvtv + r) * G_SQ + (16 * ks + 8 * hh) * 2); accv = MFMA32(a, bs, accv); }
                st_acc_T(L + G_VNS, G_ST, 32 * dvtv + r, 32 * ttv, accv, hh);
                f32x16 sc;
#pragma unroll
                for (int rq = 0; rq < 4; ++rq) { const f32x4 e4 = *(const LAS f32x4*)(tab + 64 + 32 * ttv + 8 * rq + 4 * hh);
                    sc[4 * rq] = accv[4 * rq] * e4.x; sc[4 * rq + 1] = accv[4 * rq + 1] * e4.y; sc[4 * rq + 2] = accv[4 * rq + 2] * e4.z; sc[4 * rq + 3] = accv[4 * rq + 3] * e4.w; }
                st_acc_T(L + G_VSS, G_ST, 32 * dvtv + r, 32 * ttv, sc, hh);
            } else {
#pragma unroll
                for (int ks = 0; ks < 8; ++ks) { const bf16x8 a = *(const LAS bf16x8*)(L + G_SS + (32 * dvto + r) * G_SQ + (16 * ks + 8 * hh) * 2);
                    const bf16x8 bq = *(const LAS bf16x8*)(L + G_QS + (32 * tto + r) * G_SQ + (16 * ks + 8 * hh) * 2); acco = MFMA32(a, bq, acco); }
                const float egi = tab[32 * tto + r];
#pragma unroll
                for (int i = 0; i < 16; ++i) acco[i] *= egi;
            }
            __syncthreads();
            if (w >= 4) {
#pragma unroll
                for (int ks = 0; ks < 4; ++ks) { const bf16x8 a = *(const LAS bf16x8*)(L + G_VNS + (32 * dvto + r) * G_ST + (16 * ks + 8 * hh) * 2);
                    const bf16x8 bq = *(const LAS bf16x8*)(L + G_QKS + (32 * tto + r) * G_ST + (16 * ks + 8 * hh) * 2); acco = MFMA32(a, bq, acco); }
                if (cidx >= 4) { const int i = 32 * tto + r; const size_t m = m0 + (dir ? 63 - i : i);
                    bf16* op = O + m * D + h * 128 + half * 64 + 32 * dvto + 4 * hh;
#pragma unroll
                    for (int rq = 0; rq < 4; ++rq) { v2u ww; ww.x = cvtpk(acco[4 * rq], acco[4 * rq + 1]); ww.y = cvtpk(acco[4 * rq + 2], acco[4 * rq + 3]); *(v2u*)(op + 8 * rq) = ww; } }
            }
            { const float egl = tab[128];
#pragma unroll
              for (int i = 0; i < 16; ++i) accS[i] *= egl;
#pragma unroll
              for (int ks = 0; ks < 4; ++ks) { const bf16x8 bv = *(const LAS bf16x8*)(L + G_VSS + (32 * dvtS + r) * G_ST + (16 * ks + 8 * hh) * 2); accS = MFMA32(kT[ks], bv, accS); } }
            __syncthreads();
            if (s + 1 < NCHK) GDN_STAGE_B();
        }
        __syncthreads();
#undef GDN_LOAD
#undef GDN_STAGE
#undef GDN_STAGE_A
#undef GDN_STAGE_B
    }
}

__device__ __forceinline__ void phase_readout(const Frame& F, const Args& A) {
    const int gw = F.vcu * NWAVES + F.wave, NGW = F.G * NWAVES;
    const bf16* OF = (const bf16*)A.out; const bf16* OB = OF + (size_t)MLAT * D; const bf16* Z = (const bf16*)(A.ws + WS_Z); bf16* RO = (bf16*)(A.ws + WS_RO);
    const f32x4 on = ((const f32x4*)A.in[22])[F.lane & 31];
    const int rpw = (MLAT + NGW - 1) / NGW;
    const int mbeg = gw * rpw, cnt = (MLAT - mbeg) < rpw ? (MLAT - mbeg) : rpw;
    for (int r = 0; r < cnt; r += 2) {
        v2u wf[2][4], wb[2][4], zw[2][4];
#pragma unroll
        for (int t = 0; t < 2; ++t) { const int m = mbeg + ((r + t < cnt) ? r + t : r);
#pragma unroll
            for (int j = 0; j < 4; ++j) { wf[t][j] = ((const v2u*)(OF + (size_t)m * D))[F.lane + 64 * j]; wb[t][j] = ((const v2u*)(OB + (size_t)m * D))[F.lane + 64 * j]; zw[t][j] = ((const v2u*)(Z + (size_t)m * D))[F.lane + 64 * j]; } }
#pragma unroll
        for (int t = 0; t < 2; ++t) { const int m = mbeg + r + t;
            f32x4 v[4];
#pragma unroll
            for (int j = 0; j < 4; ++j) {
                v[j] = (f32x4){bflo(wf[t][j].x) + bflo(wb[t][j].x), bfhi(wf[t][j].x) + bfhi(wb[t][j].x), bflo(wf[t][j].y) + bflo(wb[t][j].y), bfhi(wf[t][j].y) + bfhi(wb[t][j].y)};
                float ss = (v[j].x * v[j].x + v[j].y * v[j].y) + (v[j].z * v[j].z + v[j].w * v[j].w);
                ss += __shfl_xor(ss, 1); ss += __shfl_xor(ss, 2); ss += __shfl_xor(ss, 4); ss += __shfl_xor(ss, 8); ss += __shfl_xor(ss, 16);
                const float rs = 1.0f / sqrtf(ss * (1.0f / 128.0f) + EPS);
                v[j].x = v[j].x * rs * on.x * silu_f(bflo(zw[t][j].x)); v[j].y = v[j].y * rs * on.y * silu_f(bfhi(zw[t][j].x)); v[j].z = v[j].z * rs * on.z * silu_f(bflo(zw[t][j].y)); v[j].w = v[j].w * rs * on.w * silu_f(bfhi(zw[t][j].y)); }
            if (r + t < cnt) store_row_bf16(RO + (size_t)m * D, v, F.lane); }
    }
}


struct EpiNull { static constexpr bool PERM = false, AFTER_DRAIN = false; float* sink;
    __device__ __forceinline__ void operator()(const f32x4 (&acc)[2][2][4][2], const pg8::Unit&, int, int, int, int) const { float s = 0.f;
#pragma unroll
        for (int a = 0; a < 2; ++a)
#pragma unroll
            for (int b = 0; b < 2; ++b)
#pragma unroll
                for (int mm = 0; mm < 4; ++mm)
#pragma unroll
                    for (int n = 0; n < 2; ++n) s += acc[a][b][mm][n][0] + acc[a][b][mm][n][3];
        if (s == 12345.678f) sink[threadIdx.x] = s; }
};
struct ProbeOrder { int nunits, nM, G, c, mode;
    __device__ void init(int nunits_, int nM_, int G_, int c_, int mode_) { nunits = nunits_; nM = nM_; G = G_; c = c_; mode = mode_; }
    __device__ bool next(int i, pg8::Unit& u) const { const int L = i * G + c; if (L >= nunits) return false; if (mode == 0) { u.pm = L % nM; u.pn = L / nM; } else if (mode == 1) { u.pm = 0; u.pn = 0; } else { u.pm = L % nM; u.pn = 0; } return true; }
    __device__ __forceinline__ void a_ready(const pg8::Unit&) const {}
    __device__ __forceinline__ void done(const pg8::Unit&) const {}
    __device__ __forceinline__ const char* aptr(const pg8::Gemm& g, const pg8::Unit& u, size_t tstep) const { return (const char*)g.A + (size_t)u.pm * tstep; }
    __device__ __forceinline__ const char* bptr(const pg8::Gemm& g, const pg8::Unit& u, size_t tstep) const { return (const char*)g.Bt + (size_t)u.pn * tstep; }
};
__device__ __forceinline__ void phase_final(const Frame& F, const Args& A) {
    const int gw = F.vcu * NWAVES + F.wave, NGW = F.G * NWAVES;
    const float* MOD1 = (const float*)(A.ws + WS_MOD) + 9 * 6144;
    const bf16* XRES = (const bf16*)(A.ws + WS_XRES); const bf16* Y = (const bf16*)(A.ws + WS_XG); const int* SLOT = (const int*)(A.ws + WS_SLOT);
    f32x4 fg[4];
#pragma unroll
    for (int j = 0; j < 4; ++j) fg[j] = ((const f32x4*)A.in[29])[F.lane + 64 * j];
    const int rpw = (MLAT + NGW - 1) / NGW;
    const int mbeg = gw * rpw, cnt = (MLAT - mbeg) < rpw ? (MLAT - mbeg) : rpw;
    for (int r = 0; r < cnt; r += 2) {
        f32x4 vv[2][4]; CombineIn ci[2];
#pragma unroll
        for (int t = 0; t < 2; ++t) { const int m = mbeg + ((r + t < cnt) ? r + t : r); combine_issue(ci[t], XRES + (size_t)m * D, SLOT + (size_t)m * 16, F.lane); }
#pragma unroll
        for (int t = 0; t < 2; ++t) { const int m = mbeg + ((r + t < cnt) ? r + t : r);
            combine_finish(vv[t], ci[t], Y, (const float*)(A.ws + WS_GW), MOD1 + (size_t)(m >> 12) * 6144 + 5 * 1024, F.lane); }
#pragma unroll
        for (int t = 0; t < 2; ++t) { const int m = mbeg + r + t; const float rstd = row_rstd(vv[t]);
            if (r + t < cnt) {
#pragma unroll
                for (int j = 0; j < 4; ++j) ((f32x4*)(A.out + (size_t)m * D))[F.lane + 64 * j] = vv[t][j] * rstd * fg[j]; } }
    }
}

#ifndef MK_ONE_LAUNCH
#define MK_ONE_LAUNCH 1
#endif
__global__ void __launch_bounds__(NWAVES * 64, 2) fwd_kernel(Args args) {
    extern __shared__ __attribute__((aligned(16))) unsigned char lds[];
    Frame F;
    F.lds = (LAS unsigned char*)lds;
    F.MISC = (volatile LAS unsigned*)(F.lds + MISC_OFF);
    F.tid = threadIdx.x; F.lane = F.tid & 63; F.wave = __builtin_amdgcn_readfirstlane(F.tid >> 6);
    F.G = gridDim.x; { const int bx = blockIdx.x; F.vcu = (F.G % 8 == 0) ? (bx % 8) * (F.G / 8) + bx / 8 : bx; }
    unsigned char* ws = args.ws;
    gu32* ctl = (gu32*)(ws + WS_CTL);
    for (int u = F.tid; u < (LDS_BYTES - LDSCTL_OFF) / 4; u += NWAVES * 64) ((LAS unsigned*)(F.lds + LDSCTL_OFF))[u] = 0u;
    __syncthreads();
    XcdBarrier bar; bar.bar = (unsigned*)(ctl + CW_BAR); bar.x = 0; bar.st = nullptr;
    const int lo = args.ph_lo, hi = args.ph_hi;
    if (hi - lo > 1) bar = xcd_barrier_post((unsigned*)(ctl + CW_BAR), F.MISC + 8);
#ifndef PROBE_REP
#define PROBE_REP 0u
#endif
#define IN(k) (lo <= (k) && (k) < hi)
#define SEAM(k) do { if (IN(k) && IN((k) + 1)) xcd_barrier(bar); } while (0)

    const float* MOD0 = (const float*)(ws + WS_MOD); const float* MOD1 = MOD0 + 9 * 6144;
    bf16* XRES = (bf16*)(ws + WS_XRES);

    if (IN(0)) { phase_prologue(F, args); } SEAM(0);
    if (IN(1)) { phase_modnorm0(F, args); } SEAM(1);
    if (IN(2)) {
        pg8::Gemm g{(const pg8::bf16_t*)(ws + WS_H), (const pg8::bf16_t*)(ws + WS_WQKV), MTOT, NQKV, D}; QKVOrder S; S.init(F.G, (int)blockIdx.x);
        EpiQKV E{(bf16*)(ws + WS_Q), (bf16*)(ws + WS_K), (bf16*)(ws + WS_V), (const float*)(ws + WS_ROPE), (const float*)(ws + WS_ROPE) + 1024, QSCALE};
        pg8::gemm_phase<EpiQKV, QKVOrder, true, true>(F.lds, g, S, E);
        if (F.G == 256) { const int lid = (int)blockIdx.x / 8, x = (int)blockIdx.x % 8;
            if (lid >= 6) tr_moe_items(F, args.in[12], args.in[13], args.in[14], ws + WS_WGU, ws + WS_WD, L0_PRO, L0_PRO + L0_QKV, (x * 26 + lid - 6) * NWAVES + F.wave, 208 * NWAVES); }
        else tr_moe_items(F, args.in[12], args.in[13], args.in[14], ws + WS_WGU, ws + WS_WD, L0_PRO, L0_PRO + L0_QKV, F.vcu * NWAVES + F.wave, F.G * NWAVES);
    } SEAM(2);
    if (IN(3)) { phase_attn_v2(F, args); } SEAM(3);
    if (IN(4)) {
        pg8::Gemm g{(const pg8::bf16_t*)(ws + WS_ATT), (const pg8::bf16_t*)(ws + WS_WO0), MTOT, D, D}; pg8::StaticOrder S; S.init(MTOT, D, F.G, (int)blockIdx.x);
        EpiResid<false> E{args.in[0], args.in[2], XRES, MOD0 + 2 * 1024};
        pg8::gemm_phase<EpiResid<false>, pg8::StaticOrder, true, true>(F.lds, g, S, E);
        if (F.G == 256) { if (blockIdx.x >= 32) tr_moe_items(F, args.in[12], args.in[13], args.in[14], ws + WS_WGU, ws + WS_WD, L0_PRO + L0_QKV, L0_PRO + L0_QKV + L0_WO, ((int)blockIdx.x - 32) * NWAVES + F.wave, 224 * NWAVES); }
        else tr_moe_items(F, args.in[12], args.in[13], args.in[14], ws + WS_WGU, ws + WS_WD, L0_PRO + L0_QKV, L0_PRO + L0_QKV + L0_WO, F.vcu * NWAVES + F.wave, F.G * NWAVES);
    } SEAM(4);
    if (IN(5)) { phase_norm_router(F, args, XRES, MTOT, args.in[10], MOD0, args.in[11]); } SEAM(5);
    if (IN(6)) { phase_topk(F, args, true, EROWS0, args.in[12], args.in[13], args.in[14], ws + WS_WGU, ws + WS_WD, IT_MOE - L0_TOPK, IT_MOE); } SEAM(6);
    if (IN(7)) {
        pg8::Gemm g{(const pg8::bf16_t*)(ws + WS_XG), (const pg8::bf16_t*)(ws + WS_WGU), NE * EROWS0, NE * 4096, D / 2}; GroupOrder<EROWS0 / 256, 16> S; S.init(F.G, (int)blockIdx.x);
        EpiSwiGLU E{ws + WS_HID};
        pg8::gemm_phase<EpiSwiGLU, decltype(S), true, true, true>(F.lds, g, S, E);
    } SEAM(7);
    if (IN(8)) {
        pg8::Gemm g{(const pg8::bf16_t*)(ws + WS_HID), (const pg8::bf16_t*)(ws + WS_WD), NE * EROWS0, NE * 1024, FF / 2}; GroupOrder<EROWS0 / 256, 4> S; S.init(F.G, (int)blockIdx.x);
        EpiY E{(bf16*)(ws + WS_XG)};
        pg8::gemm_phase<EpiY, decltype(S), true, true, true>(F.lds, g, S, E);
        if (F.G == 256) { const int lid = (int)blockIdx.x / 8, x = (int)blockIdx.x % 8;
            if (lid >= 8) tr_moe_items(F, args.in[26], args.in[27], args.in[28], ws + WS_WGU1, ws + WS_WD1, L1_ATT, L1_ATT + L1_G2, (x * 24 + lid - 8) * NWAVES + F.wave, 192 * NWAVES); }
        else tr_moe_items(F, args.in[26], args.in[27], args.in[28], ws + WS_WGU1, ws + WS_WD1, L1_ATT, L1_ATT + L1_G2, F.vcu * NWAVES + F.wave, F.G * NWAVES);
    } SEAM(8);
    if (IN(9)) { phase_combine0(F, args); } SEAM(9);
    if (IN(10)) {
        pg8::Gemm g{(const pg8::bf16_t*)(ws + WS_H), (const pg8::bf16_t*)(ws + WS_WIN), MTOT, NWIN, D}; pg8::StaticOrder S; S.init(MTOT, NWIN, F.G, (int)blockIdx.x);
        EpiP E{(bf16*)(ws + WS_PQKV), (bf16*)(ws + WS_Z)};
        pg8::gemm_phase<EpiP, pg8::StaticOrder, true, true>(F.lds, g, S, E);
        if (F.G == 256) { if (blockIdx.x >= 128) tr_moe_items(F, args.in[26], args.in[27], args.in[28], ws + WS_WGU1, ws + WS_WD1, L1_ATT + L1_G2, L1_ATT + L1_G2 + L1_WIN, ((int)blockIdx.x - 128) * NWAVES + F.wave, 128 * NWAVES); }
        else tr_moe_items(F, args.in[26], args.in[27], args.in[28], ws + WS_WGU1, ws + WS_WD1, L1_ATT + L1_G2, L1_ATT + L1_G2 + L1_WIN, F.vcu * NWAVES + F.wave, F.G * NWAVES);
    } SEAM(10);
    if (IN(11)) { phase_conv(F, args); } SEAM(11);
    if (IN(12)) { phase_gdn_prep(F, args); } SEAM(12);
    if (IN(13)) { phase_gdn_scan(F, args); } SEAM(13);
    if (IN(14)) { phase_readout(F, args); } SEAM(14);
    if (IN(15)) {
        pg8::Gemm g{(const pg8::bf16_t*)(ws + WS_RO), (const pg8::bf16_t*)(ws + WS_WO1), MLAT, D, D}; pg8::StaticOrder S; S.init(MLAT, D, F.G, (int)blockIdx.x);
        EpiResid<true> E{XRES, XRES + (size_t)MLAT * D, XRES, MOD1 + 2 * 1024};
        pg8::gemm_phase<EpiResid<true>, pg8::StaticOrder, true, true>(F.lds, g, S, E);
    } SEAM(15);
    if (IN(16)) { phase_norm_router(F, args, XRES, MLAT, args.in[24], MOD1, args.in[25]); } SEAM(16);
    if (IN(17)) { phase_topk(F, args, false, EROWS1, args.in[26], args.in[27], args.in[28], ws + WS_WGU1, ws + WS_WD1, IT_MOE - L1_TOPK, IT_MOE); } SEAM(17);
    if (IN(18)) {
        pg8::Gemm g{(const pg8::bf16_t*)(ws + WS_XG), (const pg8::bf16_t*)(ws + WS_WGU1), NE * EROWS1, NE * 4096, D / 2}; GroupOrder<EROWS1 / 256, 16> S; S.init(F.G, (int)blockIdx.x);
        EpiSwiGLU E{ws + WS_HID};
        pg8::gemm_phase<EpiSwiGLU, decltype(S), true, true, true>(F.lds, g, S, E);
    } SEAM(18);
    if (IN(19)) {
        pg8::Gemm g{(const pg8::bf16_t*)(ws + WS_HID), (const pg8::bf16_t*)(ws + WS_WD1), NE * EROWS1, NE * 1024, FF / 2}; GroupOrder<EROWS1 / 256, 4> S; S.init(F.G, (int)blockIdx.x);
        EpiY E{(bf16*)(ws + WS_XG)};
        pg8::gemm_phase<EpiY, decltype(S), true, true, true>(F.lds, g, S, E);
    } SEAM(19);
    if (IN(20)) { phase_final(F, args); }
#ifdef PROBE_GEMM
    if (IN(21)) {
        EpiNull E{(float*)(ws + 960 * MiB)};
#if PROBE_GEMM == 1 || PROBE_GEMM == 2 || PROBE_GEMM == 7
        { pg8::Gemm g{(const pg8::bf16_t*)(ws + WS_H), (const pg8::bf16_t*)(ws + WS_WIN), MTOT, NWIN, D}; ProbeOrder S; S.init(2176, 136, F.G, (int)blockIdx.x, PROBE_GEMM == 1 ? 0 : (PROBE_GEMM == 2 ? 1 : 2));
          pg8::gemm_phase<EpiNull, ProbeOrder, true, true>(F.lds, g, S, E); }
#elif PROBE_GEMM == 8 || PROBE_GEMM == 9
        { pg8::Gemm g{(const pg8::bf16_t*)(ws + WS_H), (const pg8::bf16_t*)(ws + WS_WIN), MTOT, NWIN, PROBE_GEMM == 8 ? 512 : 256}; ProbeOrder S; S.init(2176, 136, F.G, (int)blockIdx.x, 1);
          pg8::gemm_phase<EpiNull, ProbeOrder, true, true>(F.lds, g, S, E); }
#elif PROBE_GEMM == 10 || PROBE_GEMM == 11
        { pg8::Gemm g{(const pg8::bf16_t*)(ws + WS_XG), (const pg8::bf16_t*)(ws + WS_WGU), NE * EROWS0, NE * 4096, PROBE_GEMM == 10 ? 256 : 1024}; ProbeOrder S; S.init(4352, 272, F.G, (int)blockIdx.x, 1);
          pg8::gemm_phase<EpiNull, ProbeOrder, true, true, true>(F.lds, g, S, E); }
#elif PROBE_GEMM == 3 || PROBE_GEMM == 4
        { pg8::Gemm g{(const pg8::bf16_t*)(ws + WS_HID), (const pg8::bf16_t*)(ws + WS_WD), NE * EROWS0, NE * 1024, FF / 2}; ProbeOrder S; S.init(1088, 272, F.G, (int)blockIdx.x, PROBE_GEMM == 3 ? 0 : 1);
          pg8::gemm_phase<EpiNull, ProbeOrder, true, true, true>(F.lds, g, S, E); }
#elif PROBE_GEMM == 5 || PROBE_GEMM == 6
        { pg8::Gemm g{(const pg8::bf16_t*)(ws + WS_XG), (const pg8::bf16_t*)(ws + WS_WGU), NE * EROWS0, NE * 4096, D / 2}; ProbeOrder S; S.init(4352, 272, F.G, (int)blockIdx.x, PROBE_GEMM == 5 ? 0 : 1);
          pg8::gemm_phase<EpiNull, ProbeOrder, true, true, true>(F.lds, g, S, E); }
#endif
    }
#endif
#undef IN
#undef SEAM
}

extern "C" void kernel_launch(void* const* d_in, const int* in_sizes, int n_in, void* d_out, int out_size, void* d_ws, size_t ws_size, hipStream_t stream) {
    static int grid = 0;
    if (grid == 0) {
        if (n_in != 30 || in_sizes[0] != MLAT * D || out_size != MLAT * D || ws_size < WS_END) { fprintf(stderr, "kernel_launch: unexpected shapes (n_in %d, in0 %d, out %d, ws %zu); nothing launched\n", n_in, n_in > 0 ? in_sizes[0] : -1, out_size, ws_size); grid = -1; return; }
        int dev = 0, cus = 0, per_cu = 0;
        if (hipGetDevice(&dev) != hipSuccess || hipDeviceGetAttribute(&cus, hipDeviceAttributeMultiprocessorCount, dev) != hipSuccess) { grid = -1; return; }
        if (hipFuncSetAttribute((const void*)fwd_kernel, hipFuncAttributeMaxDynamicSharedMemorySize, LDS_BYTES) != hipSuccess) { fprintf(stderr, "kernel_launch: hipFuncSetAttribute failed\n"); grid = -1; return; }
        if (hipOccupancyMaxActiveBlocksPerMultiprocessor(&per_cu, (const void*)fwd_kernel, NWAVES * 64, LDS_BYTES) != hipSuccess || per_cu < 1) { fprintf(stderr, "kernel_launch: occupancy query says %d blocks per CU\n", per_cu); }
        (void)hipGetLastError();
        grid = cus;
        if (grid % 8 != 0) { fprintf(stderr, "kernel_launch: CU count %d is not a multiple of 8\n", grid); grid = -1; return; }
    }
    if (grid < 0) return;
    if (hipMemsetAsync((char*)d_ws + WS_CTL, 0, CTL_ZERO_BYTES, stream) != hipSuccess) return;
    Args a{};
    for (int i = 0; i < 30; ++i) a.in[i] = (const float*)d_in[i];
    a.out = (float*)d_out; a.ws = (unsigned char*)d_ws;
#if MK_ONE_LAUNCH
    a.ph_lo = 0; a.ph_hi = NPH;
    hipLaunchKernelGGL(fwd_kernel, dim3(grid), dim3(NWAVES * 64), LDS_BYTES, stream, a);
#else
#ifdef PROBE_GEMM
    const int nph_launch = NPH + 1;
#else
    const int nph_launch = NPH;
#endif
    for (int p = 0; p < nph_launch; ++p) for (int rep = 0; rep < (((PROBE_REP >> p) & 1u) ? 2 : 1); ++rep) { a.ph_lo = p; a.ph_hi = p + 1; hipLaunchKernelGGL(fwd_kernel, dim3(grid), dim3(NWAVES * 64), LDS_BYTES, stream, a); }
#endif
}
```

```cpp
#include <hip/hip_runtime.h>
#include <cstdio>
#include <cstdint>
#define MK_ONE_LAUNCH 1
namespace pg8 {
#define PG8_LAS __attribute__((address_space(3)))
typedef unsigned short bf16_t;
typedef short bf16x8 __attribute__((ext_vector_type(8)));
typedef float f32x4 __attribute__((ext_vector_type(4)));
typedef unsigned u32x4 __attribute__((ext_vector_type(4)));
constexpr int BM = 256, BK = 64, HALF = 128, HTB = HALF * BK * 2  , STAGE_BYTES = 8 * HTB, NXCD = 8, WGM = 8;

__host__ __device__ __forceinline__ int lds_byte(int r, int c) { const int st = (r >> 4) * 2 + (c >> 5), rr = r & 15, cc = c & 31, ob = rr * 64 + cc * 2; return st * 1024 + (ob ^ (((ob >> 9) & 1) << 5)); }
__host__ __device__ __forceinline__ void stage_rc(int b, int& R, int& C) { const int st = b / 1024, sb = b % 1024, swz = sb ^ (((sb >> 9) & 1) << 5); R = (st >> 1) * 16 + swz / 64; C = (st & 1) * 32 + (swz % 64) / 2; }
__host__ __device__ __forceinline__ int perm32(int rho) { const int n = rho >> 4, i = rho & 15; return 8 * (i >> 2) + 4 * n + (i & 3); }

struct Unit { int pm, pn; };
struct Gemm { const bf16_t* A; const bf16_t* Bt; int M, N, K; };

struct StaticOrder {
    int nM, nN, nwg, G, c;
    __host__ __device__ void init(int M, int N, int G_, int c_) { nM = M / BM; nN = N / BM; nwg = nM * nN; G = G_; c = c_; }
    __host__ __device__ bool next(int i, Unit& u) const {
        const long L = (long)i * G + c; if (L >= nwg) return false;
        int wgid = (int)L; { const int q = nwg / NXCD, r = nwg % NXCD, xcd = wgid % NXCD, off = wgid / NXCD; wgid = (xcd < r ? xcd * (q + 1) : r * (q + 1) + (xcd - r) * q) + off; }
        const int nig = WGM * nN, gid = wgid / nig, fm = gid * WGM, gsz = (nM - fm) < WGM ? (nM - fm) : WGM;
        u.pm = fm + ((wgid % nig) % gsz); u.pn = (wgid % nig) / gsz; return true;
    }
    __device__ __forceinline__ void a_ready(const Unit&) const {}
    __device__ __forceinline__ void done(const Unit&) const {}
    __device__ __forceinline__ const char* aptr(const Gemm& g, const Unit& u, size_t tstep) const { return (const char*)g.A + (size_t)u.pm * tstep; }
    __device__ __forceinline__ const char* bptr(const Gemm& g, const Unit& u, size_t tstep) const { return (const char*)g.Bt + (size_t)u.pn * tstep; }
};

__device__ __forceinline__ unsigned cvt_pk_bf16(float lo, float hi) { unsigned r; asm volatile("v_cvt_pk_bf16_f32 %0, %1, %2" : "=v"(r) : "v"(lo), "v"(hi)); return r; }
typedef int v8i32 __attribute__((ext_vector_type(8)));
__device__ __forceinline__ v8i32 ld8(const PG8_LAS unsigned char* p) { typedef int v4i __attribute__((ext_vector_type(4))); const v4i x = *(const PG8_LAS v4i*)p, y = *(const PG8_LAS v4i*)(p + 1024); return (v8i32){x[0], x[1], x[2], x[3], y[0], y[1], y[2], y[3]}; }
__device__ __forceinline__ void mfma8(f32x4& acc, const v8i32& a, const v8i32& b, int sc) { asm volatile("v_mfma_scale_f32_16x16x128_f8f6f4 %0, %1, %2, %0, %3, %3 op_sel_hi:[0,0,0]" : "+v"(acc) : "v"(a), "v"(b), "v"(sc)); }
template <class Epi, class Sched, bool ALIGN_EPI = false, bool SP2 = false, bool FP8 = false>
__device__ __forceinline__ void gemm_phase(PG8_LAS unsigned char* lds, const Gemm g, const Sched& S, const Epi& E) {
    const int tid = threadIdx.x, wid = __builtin_amdgcn_readfirstlane(tid >> 6), lane = tid & 63, wr = wid >> 2, wc = wid & 3, fr = lane & 15, fq = lane >> 4;
    const int K = g.K, nt = K / BK;
    unsigned voffA[2], voffB[2];
#pragma unroll
    for (int i = 0; i < 2; ++i) { int R, C; stage_rc(tid * 16 + i * 8192, R, C); const int Rb = Epi::PERM ? ((R & ~31) + perm32(R & 31)) : R;
        voffA[i] = (unsigned)(R * K + C) * 2u; voffB[i] = (unsigned)(Rb * K + C) * 2u; }
    const size_t kstep = (size_t)(BK * 2);
    const size_t hstep = (size_t)HALF * K * 2;
    const size_t tstep = 2 * hstep;
    const unsigned ldsw = (unsigned)wid * 1024u;
    const int aoff = lds_byte(wr * 64 + fr, fq * 8), boff = lds_byte(wc * 32 + fr, fq * 8);
#define PG8_SA(b, h) (((b) * 2 + (h)) * HTB)
#define PG8_SB(b, h) ((4 + (b) * 2 + (h)) * HTB)
#define PG8_STAGE(bufoff, gbase, voff) do { _Pragma("unroll") for (int _i = 0; _i < 2; ++_i) \
        __builtin_amdgcn_global_load_lds((const unsigned*)((const char*)(gbase) + (voff)[_i]), (PG8_LAS unsigned*)(lds + (bufoff) + ldsw + _i * 8192), 16, 0, 0); } while (0)
#define PG8_LDA(dst, b, h) do { if constexpr (FP8) { _Pragma("unroll") for (int m = 0; m < 4; ++m) dst##8[m] = ld8(lds + PG8_SA(b, h) + aoff + m * 2048); } else { \
        _Pragma("unroll") for (int m = 0; m < 4; ++m) _Pragma("unroll") for (int k = 0; k < 2; ++k) dst[m][k] = *(const PG8_LAS bf16x8*)(lds + PG8_SA(b, h) + aoff + m * 2048 + k * 1024); } } while (0)
#define PG8_LDB(dst, b, h) do { if constexpr (FP8) { _Pragma("unroll") for (int n = 0; n < 2; ++n) dst##8[n] = ld8(lds + PG8_SB(b, h) + boff + n * 2048); } else { \
        _Pragma("unroll") for (int n = 0; n < 2; ++n) _Pragma("unroll") for (int k = 0; k < 2; ++k) dst[n][k] = *(const PG8_LAS bf16x8*)(lds + PG8_SB(b, h) + boff + n * 2048 + k * 1024); } } while (0)
#define PG8_MMA(ai, bj, At, Bt) do { if constexpr (FP8) __builtin_amdgcn_sched_barrier(0); __builtin_amdgcn_s_setprio(1); if constexpr (FP8) { _Pragma("unroll") for (int m = 0; m < 4; ++m) _Pragma("unroll") for (int n = 0; n < 2; ++n) \
        mfma8(acc[ai][bj][m][n], Bt##8[n], At##8[m], sc8); } else { \
        _Pragma("unroll") for (int m = 0; m < 4; ++m) _Pragma("unroll") for (int n = 0; n < 2; ++n) _Pragma("unroll") for (int k = 0; k < 2; ++k) \
        acc[ai][bj][m][n] = __builtin_amdgcn_mfma_f32_16x16x32_bf16(Bt[n][k], At[m][k], acc[ai][bj][m][n], 0, 0, 0); } __builtin_amdgcn_s_setprio(0); if constexpr (FP8) __builtin_amdgcn_sched_barrier(0); } while (0)
#define PG8_WAIT_V(n) asm volatile("s_waitcnt vmcnt(" #n ")" ::: "memory")
#define PG8_WAIT_L(n) asm volatile("s_waitcnt lgkmcnt(" #n ")" ::: "memory")
#define PG8_BAR __builtin_amdgcn_s_barrier()
#define PG8_SCHED __builtin_amdgcn_sched_barrier(0)
    Unit cur, nxt; int ui = 0;
    if (!S.next(0, cur)) return;
    f32x4 acc[2][2][4][2];
#pragma unroll
    for (int a = 0; a < 2; ++a)
#pragma unroll
        for (int b = 0; b < 2; ++b)
#pragma unroll
            for (int m = 0; m < 4; ++m)
#pragma unroll
                for (int n = 0; n < 2; ++n) acc[a][b][m][n] = (f32x4){0.f, 0.f, 0.f, 0.f};
    bf16x8 At[4][2], B0[2][2], B1[2][2]; v8i32 At8[4], B08[2], B18[2]; int sc8 = 0x7f7f7f7f; asm volatile("" : "+v"(sc8));
    const char* cA = S.aptr(g, cur, tstep); const char* cB = S.bptr(g, cur, tstep);
    S.a_ready(cur);
    if constexpr (SP2) {
        PG8_STAGE(PG8_SB(0, 0), cB, voffB); PG8_STAGE(PG8_SB(0, 1), cB + hstep, voffB); PG8_STAGE(PG8_SA(0, 0), cA, voffA); PG8_STAGE(PG8_SA(0, 1), cA + hstep, voffA);
        if (wr == 1) PG8_BAR;
        PG8_WAIT_V(2); PG8_BAR;
        PG8_STAGE(PG8_SB(1, 0), cB + kstep, voffB); PG8_STAGE(PG8_SA(1, 0), cA + kstep, voffA); PG8_STAGE(PG8_SB(1, 1), cB + hstep + kstep, voffB);
        PG8_WAIT_V(6); PG8_BAR;
    } else {
        PG8_STAGE(PG8_SB(0, 0), cB, voffB); PG8_STAGE(PG8_SA(0, 0), cA, voffA); PG8_STAGE(PG8_SB(0, 1), cB + hstep, voffB); PG8_STAGE(PG8_SA(0, 1), cA + hstep, voffA);
        if (wr == 1) PG8_BAR;
        PG8_WAIT_V(4); PG8_BAR;
        PG8_STAGE(PG8_SB(1, 0), cB + kstep, voffB); PG8_STAGE(PG8_SA(1, 0), cA + kstep, voffA); PG8_STAGE(PG8_SB(1, 1), cB + hstep + kstep, voffB);
        PG8_WAIT_V(6); PG8_BAR;
    }
    for (;;) {
        const bool has_next = S.next(ui + 1, nxt);
        const char* nA = has_next ? S.aptr(g, nxt, tstep) : cA; const char* nB = has_next ? S.bptr(g, nxt, tstep) : cB;
#pragma unroll 1
        for (int t = 0; t < nt; t += 2) {
            const bool last = (t == nt - 2);
            const char* a1 = cA + (size_t)(t + 1) * kstep;
            const char* a2 = last ? nA : cA + (size_t)(t + 2) * kstep; const char* b2 = last ? nB : cB + (size_t)(t + 2) * kstep;
            const char* a3 = a2 + kstep; const char* b3 = b2 + kstep;
            if (last && has_next) S.a_ready(nxt);
            if constexpr (SP2) {
            PG8_LDB(B0, 0, 0); PG8_LDB(B1, 0, 1); PG8_SCHED; PG8_LDA(At, 0, 0); PG8_STAGE(PG8_SA(1, 1), a1 + hstep, voffA);
            PG8_WAIT_V(8); PG8_WAIT_L(0); PG8_BAR; PG8_MMA(0, 0, At, B0); PG8_MMA(0, 1, At, B1); PG8_BAR; PG8_SCHED;
            PG8_LDA(At, 0, 1); PG8_STAGE(PG8_SB(0, 0), b2, voffB); PG8_STAGE(PG8_SB(0, 1), b2 + hstep, voffB); PG8_STAGE(PG8_SA(0, 0), a2, voffA);
            PG8_WAIT_V(8); PG8_WAIT_L(0); PG8_BAR; PG8_MMA(1, 0, At, B0); PG8_MMA(1, 1, At, B1); PG8_BAR; PG8_SCHED;
            PG8_LDB(B0, 1, 0); PG8_LDB(B1, 1, 1); PG8_SCHED; PG8_LDA(At, 1, 0); PG8_STAGE(PG8_SA(0, 1), a2 + hstep, voffA);
            PG8_WAIT_V(8); PG8_WAIT_L(0); PG8_BAR; PG8_MMA(0, 0, At, B0); PG8_MMA(0, 1, At, B1); PG8_BAR; PG8_SCHED;
            PG8_LDA(At, 1, 1); PG8_STAGE(PG8_SB(1, 0), b3, voffB); PG8_STAGE(PG8_SB(1, 1), b3 + hstep, voffB); PG8_STAGE(PG8_SA(1, 0), a3, voffA);
            PG8_WAIT_V(8); PG8_WAIT_L(0); PG8_BAR; PG8_MMA(1, 0, At, B0); PG8_MMA(1, 1, At, B1); PG8_BAR; PG8_SCHED;
            } else {
            PG8_LDB(B0, 0, 0); PG8_SCHED; PG8_LDA(At, 0, 0); PG8_STAGE(PG8_SA(1, 1), a1 + hstep, voffA);
            PG8_WAIT_L(8); PG8_BAR; PG8_WAIT_L(0); PG8_MMA(0, 0, At, B0); PG8_BAR; PG8_SCHED;
            PG8_LDB(B1, 0, 1); PG8_STAGE(PG8_SB(0, 0), b2, voffB);
            PG8_BAR; PG8_WAIT_L(0); PG8_MMA(0, 1, At, B1); PG8_BAR;
            PG8_LDA(At, 0, 1); PG8_STAGE(PG8_SA(0, 0), a2, voffA);
            PG8_BAR; PG8_WAIT_L(0); PG8_MMA(1, 0, At, B0); PG8_BAR; PG8_SCHED;
            PG8_STAGE(PG8_SB(0, 1), b2 + hstep, voffB);
            PG8_WAIT_V(6); PG8_BAR; PG8_MMA(1, 1, At, B1); PG8_BAR;
            PG8_LDB(B0, 1, 0); PG8_SCHED; PG8_LDA(At, 1, 0); PG8_STAGE(PG8_SA(0, 1), a2 + hstep, voffA);
            PG8_WAIT_L(8); PG8_BAR; PG8_WAIT_L(0); PG8_MMA(0, 0, At, B0); PG8_BAR; PG8_SCHED;
            PG8_LDB(B1, 1, 1); PG8_STAGE(PG8_SB(1, 0), b3, voffB);
            PG8_BAR; PG8_WAIT_L(0); PG8_MMA(0, 1, At, B1); PG8_BAR;
            PG8_LDA(At, 1, 1); PG8_STAGE(PG8_SA(1, 0), a3, voffA);
            PG8_BAR; PG8_WAIT_L(0); PG8_MMA(1, 0, At, B0); PG8_BAR; PG8_SCHED;
            PG8_STAGE(PG8_SB(1, 1), b3 + hstep, voffB);
            PG8_WAIT_V(6); PG8_BAR; PG8_MMA(1, 1, At, B1); PG8_BAR;
            }
        }
        if constexpr (FP8) asm volatile("s_nop 15\n\ts_nop 15" ::: "memory");
        if constexpr (ALIGN_EPI) { if (wr == 0) PG8_BAR; }
        if constexpr (!Epi::AFTER_DRAIN) { E(acc, cur, wr, wc, fr, fq); S.done(cur); }
        if (!has_next) break;
#pragma unroll
        for (int a = 0; a < 2; ++a)
#pragma unroll
            for (int b = 0; b < 2; ++b)
#pragma unroll
                for (int m = 0; m < 4; ++m)
#pragma unroll
                    for (int n = 0; n < 2; ++n) acc[a][b][m][n] = (f32x4){0.f, 0.f, 0.f, 0.f};
        cur = nxt; cA = nA; cB = nB; ++ui;
        if constexpr (ALIGN_EPI) { if (wr == 1) PG8_BAR; }
    }
    PG8_WAIT_V(0);
    if constexpr (!ALIGN_EPI) { if (wr == 0) PG8_BAR; }
    PG8_BAR;
    if constexpr (Epi::AFTER_DRAIN) { E.fused(acc, cur, wr, wc, fr, fq, lds, wid, lane); S.done(cur); }
#undef PG8_SA
#undef PG8_SB
#undef PG8_STAGE
#undef PG8_LDA
#undef PG8_LDB
#undef PG8_MMA
#undef PG8_WAIT_V
#undef PG8_WAIT_L
#undef PG8_BAR
#undef PG8_SCHED
}
}

constexpr int D = 1024, NB = 8, SEQ = 4096, CTXL = 256;
constexpr int MLAT = NB * SEQ, MCTX = NB * CTXL, MTOT = MLAT + MCTX;
constexpr int NE = 16, FF = 2048, CAPL = 512, CAPC = 32;
constexpr int EROWS0 = NB * (CAPL + CAPC);
constexpr int EROWS1 = NB * CAPL;
constexpr int NQKV = 1536, NWIN = 4096, LDWIN = 4128;
constexpr float EPS = 1e-6f;
constexpr int NWAVES = 8, NTHR = 512;
constexpr int NPH = 21;

constexpr size_t MiB = 1u << 20;
constexpr size_t WS_CTL = 0, CTL_ZERO_BYTES = 1 * MiB;
constexpr size_t WS_MOD = 1 * MiB;
constexpr size_t WS_ROPE = 1 * MiB + 512 * 1024;
constexpr size_t WS_WQKV = 2 * MiB, WS_WO0 = 5 * MiB, WS_WIN = 7 * MiB, WS_WO1 = 15 * MiB;
constexpr size_t WS_WGU = 17 * MiB, WS_WD = 81 * MiB, WS_WGU1 = 113 * MiB, WS_WD1 = 177 * MiB;
constexpr size_t WS_XRES = 209 * MiB;
constexpr size_t WS_H = 345 * MiB;
constexpr size_t WS_H8 = WS_H;
constexpr size_t WS_AFF = 413 * MiB;
constexpr size_t WS_GW = 416 * MiB;
constexpr size_t WS_SLOT = 417 * MiB;
constexpr size_t WS_G = 420 * MiB, WS_BETA = 423 * MiB;
constexpr size_t WS_R = 427 * MiB;
constexpr size_t WS_Q = WS_R, WS_K = WS_R + 68 * MiB, WS_V = WS_R + 85 * MiB, WS_ATT = WS_R + 102 * MiB;
constexpr size_t WS_XG = WS_R, WS_HID = WS_R + 136 * MiB;
constexpr size_t WS_PQKV = WS_R, WS_Z = WS_R + 204 * MiB, WS_QN = WS_R + 272 * MiB, WS_KN = WS_R + 340 * MiB, WS_VV = WS_R + 408 * MiB;
constexpr size_t WS_TB = WS_R, WS_TG = WS_R + 68 * MiB, WS_QKD = WS_R + 136 * MiB, WS_GC = WS_AFF;
constexpr size_t WS_RO = WS_R;
constexpr size_t WS_END = WS_R + 476 * MiB;
constexpr int CW_BAR = 4096;

constexpr int RING_BYTES = 131072;
constexpr int LDSCTL_OFF = RING_BYTES, MISC_OFF = LDSCTL_OFF + 320;
constexpr int LDS_BYTES = 147456;

#define GAS __attribute__((address_space(1)))
#define LAS __attribute__((address_space(3)))
typedef unsigned short bf16;
typedef unsigned v4u __attribute__((ext_vector_type(4)));
typedef unsigned v2u __attribute__((ext_vector_type(2)));
typedef float f32x4 __attribute__((ext_vector_type(4)));
typedef short bf16x8 __attribute__((ext_vector_type(8)));
typedef GAS unsigned gu32;
typedef GAS unsigned long long gu64;
#define RLX_AGENT __ATOMIC_RELAXED, __HIP_MEMORY_SCOPE_AGENT
#define LDS_WAIT() asm volatile("s_waitcnt lgkmcnt(0)" ::: "memory")
#define VM_WAIT() asm volatile("s_waitcnt vmcnt(0)" ::: "memory")

#define XB_TMO      128
#define XB_XCNT(j)  (256  + 64 * (j))
#define XB_XSUB(j)  (1280 + 64 * (j))
#define XB_XGEN(j)  (2304 + 64 * (j))
#define XB_TOP      3328
#define XB_TOPGEN   3392
#define XCD_BAR_WORDS 3456
#define XB_SPIN_CAP (1u << 18)

__device__ __forceinline__ unsigned xb_ld(unsigned* p)              { return __hip_atomic_load(p, __ATOMIC_RELAXED, __HIP_MEMORY_SCOPE_AGENT); }
__device__ __forceinline__ unsigned xb_add(unsigned* p, unsigned v) { return __hip_atomic_fetch_add(p, v, __ATOMIC_RELAXED, __HIP_MEMORY_SCOPE_AGENT); }
__device__ __forceinline__ unsigned xb_xcc_id() { return (unsigned)__builtin_amdgcn_s_getreg((3 << 11) | 20) & 0xFu; }
#define XB_SPIN(cond, bar) do { unsigned _sp = 0; while (cond) { __builtin_amdgcn_s_sleep(1); \
    if ((++_sp & 255u) == 0u) { if (xb_ld(&(bar)[XB_TMO])) break; if (_sp > XB_SPIN_CAP) { atomicAdd(&(bar)[XB_TMO], 1u); break; } } } } while (0)

struct XcdBarrier {
    unsigned* bar; unsigned x;
    volatile LAS unsigned* st;
};

__device__ __forceinline__ XcdBarrier xcd_barrier_post(unsigned* bar, volatile LAS unsigned* st) {
    XcdBarrier b; b.bar = bar; b.x = xb_xcc_id(); b.st = st;
    if (threadIdx.x == 0) (void)xb_add(&bar[XB_XCNT(b.x)], 1u);
    return b;
}
__device__ __forceinline__ void xcd_barrier_complete(unsigned* bar, unsigned x, unsigned& nloc, unsigned& nx) {
    const unsigned G = gridDim.x * gridDim.y * gridDim.z;
    unsigned sum, cnt, mine, sp = 0u;
    for (;;) {
        sum = 0u; cnt = 0u; mine = 0u;
#pragma unroll
        for (unsigned j = 0; j < 16; ++j) { const unsigned c = xb_ld(&bar[XB_XCNT(j)]); sum += c; cnt += (c > 0u) ? 1u : 0u; mine = (j == x) ? c : mine; }
        if (sum == G) break;
        __builtin_amdgcn_s_sleep(1);
        if ((++sp & 255u) == 0u) { if (xb_ld(&bar[XB_TMO])) break; if (sp > XB_SPIN_CAP) { atomicAdd(&bar[XB_TMO], 1u); break; } }
    }
    nloc = mine > 0u ? mine : 1u; nx = cnt > 0u ? cnt : 1u;
}

__device__ __forceinline__ void xcd_barrier(const XcdBarrier& b) {
    asm volatile("s_waitcnt vmcnt(0)" ::: "memory");
    __syncthreads();
    if (threadIdx.x == 0) {
        unsigned* bar = b.bar;
        __builtin_amdgcn_s_waitcnt(0);
        unsigned nloc = b.st[0], nx = b.st[1];
        if (nloc == 0u) { xcd_barrier_complete(bar, b.x, nloc, nx); b.st[0] = nloc; b.st[1] = nx; }
        const unsigned old = xb_add(&bar[XB_XSUB(b.x)], 1u);
        const unsigned gen = old / nloc;
        if (old + 1u == (gen + 1u) * nloc) {
            __builtin_amdgcn_fence(__ATOMIC_RELEASE, "agent");
            asm volatile("s_waitcnt vmcnt(0)" ::: "memory");
            const unsigned og = xb_add(&bar[XB_TOP], 1u);
            const unsigned tg = og / nx;
            if (og + 1u == (tg + 1u) * nx) xb_add(&bar[XB_TOPGEN], 1u);
            else XB_SPIN(xb_ld(&bar[XB_TOPGEN]) == tg, bar);
            __builtin_amdgcn_fence(__ATOMIC_ACQUIRE, "agent");
            xb_add(&bar[XB_XGEN(b.x)], 1u);
            asm volatile("s_waitcnt vmcnt(0)" ::: "memory");
        } else {
            XB_SPIN(xb_ld(&bar[XB_XGEN(b.x)]) == gen, bar);
            __builtin_amdgcn_fence(__ATOMIC_ACQUIRE, "agent");
            asm volatile("s_waitcnt vmcnt(0)" ::: "memory");
        }
    }
    __syncthreads();
}

struct Args { const float* in[30]; float* out; unsigned char* ws; int ph_lo, ph_hi; };
struct Frame { LAS unsigned char* lds; volatile LAS unsigned* MISC; int tid, lane, wave, vcu, G; };

__device__ __forceinline__ float wave_sum(float v) {
#pragma unroll
    for (int o = 1; o < 64; o <<= 1) v += __shfl_xor(v, o);
    return v;
}
template <int N> __device__ __forceinline__ float fold_sum(float (&p)[N], int lane) {
    int o = 32;
#pragma unroll
    for (int n = N; n > 1; n >>= 1) { const unsigned um = (lane & o) ? 0xffffffffu : 0u;
#pragma unroll
        for (int k = 0; k < n / 2; ++k) { const unsigned a = __float_as_uint(p[k]), b = __float_as_uint(p[k + n / 2]);
            const float send = __uint_as_float((a & um) | (b & ~um)), keep = __uint_as_float((b & um) | (a & ~um)); p[k] = keep + __shfl_xor(send, o); }
        o >>= 1; }
    float v = p[0];
#pragma unroll
    for (int oo = 32; oo >= 1; oo >>= 1) if (oo <= o) v += __shfl_xor(v, oo);
    return v;
}
__device__ __forceinline__ float proj16(const f32x4 (&v)[4], const LAS float* w16, int lane) {
    float pj[16];
#pragma unroll
    for (int e = 0; e < 16; ++e) { float s = 0.f;
#pragma unroll
        for (int j = 0; j < 4; ++j) { const f32x4 w = ((const LAS f32x4*)(w16 + e * 1024))[lane + 64 * j]; s += (v[j].x * w.x + v[j].y * w.y) + (v[j].z * w.z + v[j].w * w.w); }
        pj[e] = s; }
    return fold_sum<16>(pj, lane);
}
template <int R> __device__ __forceinline__ void proj16xR(const f32x4 (&v)[R][4], const LAS float* w16, int lane, float (&out)[R]) {
    float p[R][16];
#pragma unroll
    for (int e = 0; e < 16; ++e) { float s[R];
#pragma unroll
        for (int t = 0; t < R; ++t) s[t] = 0.f;
#pragma unroll
        for (int j = 0; j < 4; ++j) { const f32x4 w = ((const LAS f32x4*)(w16 + e * 1024))[lane + 64 * j];
#pragma unroll
            for (int t = 0; t < R; ++t) s[t] += (v[t][j].x * w.x + v[t][j].y * w.y) + (v[t][j].z * w.z + v[t][j].w * w.w); }
#pragma unroll
        for (int t = 0; t < R; ++t) p[t][e] = s[t]; }
#pragma unroll
    for (int t = 0; t < R; ++t) out[t] = fold_sum<16>(p[t], lane);
}
__device__ __forceinline__ void proj16x2(const f32x4 (&v0)[4], const f32x4 (&v1)[4], const LAS float* w16, int lane, float& r0, float& r1) {
    float p0[16], p1[16];
#pragma unroll
    for (int e = 0; e < 16; ++e) { float s0 = 0.f, s1 = 0.f;
#pragma unroll
        for (int j = 0; j < 4; ++j) { const f32x4 w = ((const LAS f32x4*)(w16 + e * 1024))[lane + 64 * j];
            s0 += (v0[j].x * w.x + v0[j].y * w.y) + (v0[j].z * w.z + v0[j].w * w.w); s1 += (v1[j].x * w.x + v1[j].y * w.y) + (v1[j].z * w.z + v1[j].w * w.w); }
        p0[e] = s0; p1[e] = s1; }
    r0 = fold_sum<16>(p0, lane); r1 = fold_sum<16>(p1, lane);
}
__device__ __forceinline__ float bflo(unsigned w) { return __uint_as_float(w << 16); }
__device__ __forceinline__ float bfhi(unsigned w) { return __uint_as_float(w & 0xffff0000u); }
__device__ __forceinline__ unsigned pkbf(float lo, float hi) { return pg8::cvt_pk_bf16(lo, hi); }
__device__ __forceinline__ float silu_f(float x) { return x * __builtin_amdgcn_rcpf(1.f + __expf(-x)); }
__device__ __forceinline__ unsigned pk4f8(float a, float b, float c, float d) { int v = __builtin_amdgcn_cvt_pk_fp8_f32(a, b, 0, false); v = __builtin_amdgcn_cvt_pk_fp8_f32(c, d, v, true); return (unsigned)v; }
constexpr float W8S = 64.f, W8I = 1.f / 64.f;
__device__ __forceinline__ int modrow(int m) { return m < MLAT ? (m >> 12) : 8; }

__device__ __forceinline__ void tr_item(const float* W, size_t ldw, int k0, size_t srccol0, bool permq, bf16* WT, size_t K, size_t dstrow0, LAS float* scr, int lane) {
    const int nl = lane & 31;
    size_t col = srccol0 + nl;
    if (permq) { const int nd = (int)col; const int s = nd & 63, j = (s & 31) >> 1; col = (size_t)((nd - s) + (s & 32) + ((s & 1) ? 16 + j : j)); }
    float t[32];
#pragma unroll
    for (int i = 0; i < 32; ++i) t[i] = W[(size_t)(k0 + 2 * i + (lane >> 5)) * ldw + col];
#pragma unroll
    for (int i = 0; i < 32; ++i) scr[(2 * i + (lane >> 5)) * 33 + nl] = t[i];
    LDS_WAIT(); asm volatile("" ::: "memory");
    const int c = lane & 7;
#pragma unroll
    for (int j = 0; j < 4; ++j) { const int n = (lane >> 3) + 8 * j; const LAS float* s = scr + (8 * c) * 33 + n;
        v4u o; o.x = pkbf(s[0 * 33], s[1 * 33]); o.y = pkbf(s[2 * 33], s[3 * 33]); o.z = pkbf(s[4 * 33], s[5 * 33]); o.w = pkbf(s[6 * 33], s[7 * 33]);
        *(v4u*)(WT + (dstrow0 + n) * K + k0 + 8 * c) = o; }
    LDS_WAIT(); asm volatile("" ::: "memory");
}
__device__ __forceinline__ void tr_item8(const float* W, size_t ldw, int k0, size_t srccol0, unsigned char* WT, size_t K, size_t dstrow0, LAS float* scr, int lane) {
    const int nl = lane & 31; const size_t col = srccol0 + nl;
    float t[32];
#pragma unroll
    for (int i = 0; i < 32; ++i) t[i] = W[(size_t)(k0 + 2 * i + (lane >> 5)) * ldw + col];
#pragma unroll
    for (int i = 0; i < 32; ++i) scr[(2 * i + (lane >> 5)) * 33 + nl] = t[i] * W8S;
    LDS_WAIT(); asm volatile("" ::: "memory");
    const int c = lane & 7;
#pragma unroll
    for (int j = 0; j < 4; ++j) { const int n = (lane >> 3) + 8 * j; const LAS float* s = scr + (8 * c) * 33 + n;
        v2u o; o.x = pk4f8(s[0 * 33], s[1 * 33], s[2 * 33], s[3 * 33]); o.y = pk4f8(s[4 * 33], s[5 * 33], s[6 * 33], s[7 * 33]);
        *(v2u*)(WT + (dstrow0 + n) * K + k0 + 8 * c) = o; }
    LDS_WAIT(); asm volatile("" ::: "memory");
}
constexpr int IT_GU = 16 * 2048, IT_D = 16 * 1024, IT_MOE = IT_GU + IT_D;
__device__ __forceinline__ void tr_moe_items(const Frame& F, const float* wg, const float* wu, const float* wd, unsigned char* wgu, unsigned char* wdn, int lo, int hi, int widx, int nw) {
    LAS float* scr = (LAS float*)(F.lds + F.wave * 16384);
    for (int r = lo + widx; r < hi; r += nw) {
        if (r < IT_GU) { const int e = r >> 11, q = r & 2047, kb = q >> 7, nb = q & 127, n0 = nb * 32, pn = n0 >> 8, w = n0 & 255;
            const float* W = ((w < 128) ? wg : wu) + (size_t)e * 1024 * 2048;
            tr_item8(W, 2048, kb * 64, (size_t)(pn * 128 + (w & 127)), wgu, 1024, (size_t)e * 4096 + n0, scr, F.lane); }
        else { const int rr = r - IT_GU; const int e = rr >> 10, q = rr & 1023, kb = q >> 5, nb = q & 31, n0 = nb * 32;
            tr_item8(wd + (size_t)e * 2048 * 1024, 1024, kb * 64, (size_t)n0, wdn, 2048, (size_t)e * 1024 + n0, scr, F.lane); }
    }
}
constexpr int L0_QKV = 208 * 8 * 9, L0_WO = 224 * 8 * 9, L0_TOPK = 128 * 8 * 5, L0_PRO = IT_MOE - L0_QKV - L0_WO - L0_TOPK;
constexpr int L1_ATT = 128 * 8 * 4, L1_G2 = 192 * 8 * 10, L1_WIN = 128 * 8 * 8, L1_TOPK = 128 * 8 * 5, L1_PREP = 192 * 8 * 5, L1_CMB = IT_MOE - L1_ATT - L1_G2 - L1_WIN - L1_TOPK - L1_PREP;
__device__ __forceinline__ void phase_prologue(const Frame& F, const Args& A) {
    unsigned char* ws = A.ws;
    const int gw = F.vcu * NWAVES + F.wave, NGW = F.G * NWAVES;
    {
        LAS float* sl = (LAS float*)F.lds;
        LAS float* part = sl + 9 * 1024;
        float* MOD = (float*)(ws + WS_MOD);
        if (F.vcu < 192) {
            for (int idx = F.tid; idx < 9 * 1024; idx += NTHR) { const int r = idx >> 10, k = idx & 1023; const float v = r < 8 ? A.in[1][r * 1024 + k] : A.in[3][k]; sl[idx] = silu_f(v); }
        }
        __syncthreads();
        for (int u = F.vcu; u < 192; u += F.G) {
            const int layer = u / 96, cg = u % 96, col = cg * 64 + F.lane;
            const float* W = layer ? A.in[15] : A.in[4]; const float* bias = layer ? A.in[16] : A.in[5];
            float acc[9];
#pragma unroll
            for (int r = 0; r < 9; ++r) acc[r] = 0.f;
            const int k0 = F.wave * 128;
#pragma unroll 8
            for (int k = k0; k < k0 + 128; ++k) { const float w = W[(size_t)k * 6144 + col];
#pragma unroll
                for (int r = 0; r < 9; ++r) acc[r] += sl[r * 1024 + k] * w; }
#pragma unroll
            for (int r = 0; r < 9; ++r) part[(F.wave * 9 + r) * 64 + F.lane] = acc[r];
            __syncthreads();
            for (int idx = F.tid; idx < 576; idx += NTHR) { const int r = idx >> 6, l = idx & 63; float s = 0.f;
#pragma unroll
                for (int w = 0; w < 8; ++w) s += part[(w * 9 + r) * 64 + l];
                MOD[(size_t)(layer * 9 + r) * 6144 + cg * 64 + l] = s + bias[cg * 64 + l]; }
            __syncthreads();
        }
        if (F.vcu == F.G - 1) {
            float* rc = (float*)(ws + WS_ROPE); float* rs = rc + 1024;
            for (int idx = F.tid; idx < 1024; idx += NTHR) { const int pos = idx >> 4, j = idx & 15;
                const float inv = exp2f(-(float)j * (13.287712379549449f / 16.f));
                const float ang = (float)pos * inv; rc[idx] = cosf(ang); rs[idx] = sinf(ang); }
        }
        __syncthreads();
    }
    {
        LAS float* scr = (LAS float*)(F.lds + F.wave * 16384);
        constexpr int I_QKV = 16 * 48, I_WO = 16 * 32, I_WIN = 16 * 128;
        constexpr int NSMALL = I_QKV + 2 * I_WO + I_WIN;
        for (int it = gw; it < NSMALL; it += NGW) {
            int r = it;
            if (r < I_QKV) { const int kb = r / 48, nb = r % 48; tr_item(A.in[7], NQKV, kb * 64, (size_t)nb * 32, nb * 32 < 1280, (bf16*)(ws + WS_WQKV), 1024, (size_t)nb * 32, scr, F.lane); continue; } r -= I_QKV;
            if (r < I_WO) { const int kb = r >> 5, nb = r & 31; tr_item(A.in[9], 1024, kb * 64, (size_t)nb * 32, false, (bf16*)(ws + WS_WO0), 1024, (size_t)nb * 32, scr, F.lane); continue; } r -= I_WO;
            if (r < I_WIN) { const int kb = r >> 7, nb = r & 127; tr_item(A.in[18], LDWIN, kb * 64, (size_t)nb * 32, false, (bf16*)(ws + WS_WIN), 1024, (size_t)nb * 32, scr, F.lane); continue; } r -= I_WIN;
            { const int kb = r >> 5, nb = r & 31; tr_item(A.in[23], 1024, kb * 64, (size_t)nb * 32, false, (bf16*)(ws + WS_WO1), 1024, (size_t)nb * 32, scr, F.lane); }
        }
        constexpr int L0_NOADA = 64 * 8 * 6;
        if (F.G == 256) { if (F.vcu >= 192) tr_moe_items(F, A.in[12], A.in[13], A.in[14], ws + WS_WGU, ws + WS_WD, 0, L0_NOADA, (F.vcu - 192) * NWAVES + F.wave, 64 * NWAVES);
            tr_moe_items(F, A.in[12], A.in[13], A.in[14], ws + WS_WGU, ws + WS_WD, L0_NOADA, L0_PRO, gw, NGW); }
        else tr_moe_items(F, A.in[12], A.in[13], A.in[14], ws + WS_WGU, ws + WS_WD, 0, L0_PRO, gw, NGW);
    }
}

struct RowCoef { f32x4 a[4], b[4]; };
__device__ __forceinline__ void load_coef(RowCoef& C, const float* g, const float* sh, const float* sc, int lane) {
#pragma unroll
    for (int j = 0; j < 4; ++j) { const f32x4 gv = ((const f32x4*)g)[lane + 64 * j], sv = ((const f32x4*)sc)[lane + 64 * j]; C.a[j] = gv * (sv + 1.0f); C.b[j] = ((const f32x4*)sh)[lane + 64 * j]; }
}
__device__ __forceinline__ float row_rstd(const f32x4 (&v)[4]) {
    float s = 0.f;
#pragma unroll
    for (int j = 0; j < 4; ++j) s += (v[j].x * v[j].x + v[j].y * v[j].y) + (v[j].z * v[j].z + v[j].w * v[j].w);
    return 1.0f / sqrtf(wave_sum(s) * (1.0f / 1024.0f) + EPS);
}
__device__ __forceinline__ void store_row_bf16(bf16* row, const f32x4 (&v)[4], int lane) {
#pragma unroll
    for (int j = 0; j < 4; ++j) { v2u w; w.x = pkbf(v[j].x, v[j].y); w.y = pkbf(v[j].z, v[j].w); ((v2u*)row)[lane + 64 * j] = w; }
}

__device__ __forceinline__ void load_row_bf16(f32x4 (&v)[4], const bf16* row, int lane) {
#pragma unroll
    for (int j = 0; j < 4; ++j) { const v2u w = ((const v2u*)row)[lane + 64 * j]; v[j] = (f32x4){bflo(w.x), bfhi(w.x), bflo(w.y), bfhi(w.y)}; }
}
__device__ __forceinline__ void phase_modnorm0(const Frame& F, const Args& A) {
    const int gw = F.vcu * NWAVES + F.wave, NGW = F.G * NWAVES;
    const float* MOD = (const float*)(A.ws + WS_MOD); bf16* H = (bf16*)(A.ws + WS_H);
    const int rpw = (MTOT + NGW - 1) / NGW;
    int curb = -1; RowCoef C;
    const int mbeg = gw * rpw, cnt = (MTOT - mbeg) < rpw ? (MTOT - mbeg) : rpw;
    f32x4 nx[4];
    if (cnt > 0) { const float* xr = mbeg < MLAT ? A.in[0] + (size_t)mbeg * D : A.in[2] + (size_t)(mbeg - MLAT) * D;
#pragma unroll
        for (int j = 0; j < 4; ++j) nx[j] = ((const f32x4*)xr)[F.lane + 64 * j]; }
    for (int r = 0; r < cnt; ++r) { const int m = mbeg + r;
        const int mb = modrow(m);
        if (mb != curb) { load_coef(C, A.in[6], MOD + (size_t)mb * 6144, MOD + (size_t)mb * 6144 + 1024, F.lane); curb = mb; }
        f32x4 v[4];
#pragma unroll
        for (int j = 0; j < 4; ++j) v[j] = nx[j];
        if (r + 1 < cnt) { const int m1 = m + 1; const float* xr = m1 < MLAT ? A.in[0] + (size_t)m1 * D : A.in[2] + (size_t)(m1 - MLAT) * D;
#pragma unroll
            for (int j = 0; j < 4; ++j) nx[j] = ((const f32x4*)xr)[F.lane + 64 * j]; }
        const float rstd = row_rstd(v);
#pragma unroll
        for (int j = 0; j < 4; ++j) v[j] = v[j] * rstd * C.a[j] + C.b[j];
        store_row_bf16(H + (size_t)m * D, v, F.lane);
    }
}

template <int NML, int NNL> struct GroupOrder {
    static constexpr int PER = NML * NNL, BW = 4 * NNL;
    int nx, e0, lid;
    __device__ void init(int G_, int bx) { nx = G_ / 8; e0 = bx % 8; lid = bx / 8; }
    __device__ bool next(int i, pg8::Unit& u) const { const int q = i * nx + lid; if (q >= 2 * PER) return false;
        const int e = e0 + 8 * (q / PER), r = q % PER, band = r / BW, rr = r % BW, brow = (NML - 4 * band) < 4 ? (NML - 4 * band) : 4;
        u.pm = e * NML + 4 * band + rr % brow; u.pn = e * NNL + rr / brow; return true; }
    __device__ __forceinline__ void a_ready(const pg8::Unit&) const {}
    __device__ __forceinline__ void done(const pg8::Unit&) const {}
    __device__ __forceinline__ const char* aptr(const pg8::Gemm& g, const pg8::Unit& u, size_t tstep) const { return (const char*)g.A + (size_t)u.pm * tstep; }
    __device__ __forceinline__ const char* bptr(const pg8::Gemm& g, const pg8::Unit& u, size_t tstep) const { return (const char*)g.Bt + (size_t)u.pn * tstep; }
};
struct QKVOrder {
    int nx, x0, lid;
    __device__ void init(int G_, int bx) { nx = G_ / 8; x0 = bx % 8; lid = bx / 8; }
    __device__ bool next(int i, pg8::Unit& u) const { const int q = i * nx + lid; if (q >= 102) return false; const int tm = 17 * x0 + q / 6, c = q % 6;
        if (c < 5) { u.pm = tm; u.pn = c; } else { u.pm = 1000 + tm; u.pn = 5; } return true; }
    __device__ __forceinline__ void a_ready(const pg8::Unit&) const {}
    __device__ __forceinline__ void done(const pg8::Unit&) const {}
    __device__ __forceinline__ const char* aptr(const pg8::Gemm& g, const pg8::Unit& u, size_t tstep) const { return u.pm >= 1000 ? (const char*)g.Bt + 5 * tstep : (const char*)g.A + (size_t)u.pm * tstep; }
    __device__ __forceinline__ const char* bptr(const pg8::Gemm& g, const pg8::Unit& u, size_t tstep) const { return u.pm >= 1000 ? (const char*)g.A + (size_t)(u.pm - 1000) * tstep : (const char*)g.Bt + (size_t)u.pn * tstep; }
};
struct EpiQKV {
    static constexpr bool PERM = true, AFTER_DRAIN = false;
    bf16 *Q, *K, *V; const float* rc; const float* rs; float QS;
    __device__ __forceinline__ void operator()(const f32x4 (&acc)[2][2][4][2], const pg8::Unit& u, int wr, int wc, int fr, int fq) const {
        if (u.pm >= 1000) {
            const int tok0 = (u.pm - 1000) * 256;
#pragma unroll
            for (int ai = 0; ai < 2; ++ai)
#pragma unroll
                for (int m = 0; m < 4; ++m) { const int dr = ai * 128 + wr * 64 + m * 16 + fr;
#pragma unroll
                    for (int bj = 0; bj < 2; ++bj) { const f32x4 v0 = acc[ai][bj][m][0], v1 = acc[ai][bj][m][1];
                        v4u w; w.x = pkbf(v0[0], v0[1]); w.y = pkbf(v0[2], v0[3]); w.z = pkbf(v1[0], v1[1]); w.w = pkbf(v1[2], v1[3]);
                        *(v4u*)(V + (size_t)dr * MTOT + tok0 + bj * 128 + wc * 32 + 8 * fq) = w; } }
            return; }
        const int pn = u.pn; bf16* base; int ld, coff;
        if (pn < 4) { base = Q; ld = 1024; coff = pn * 256; } else { base = K; ld = 256; coff = 0; }
        const bool rope = (u.pm < MLAT / 256);
        const float sc = pn < 4 ? QS : 1.0f;
        const int iscol = wc & 1;
#pragma unroll
        for (int ai = 0; ai < 2; ++ai)
#pragma unroll
            for (int m = 0; m < 4; ++m) {
                const int r = u.pm * 256 + ai * 128 + wr * 64 + m * 16 + fr;
                f32x4 cv = (f32x4){1.f, 1.f, 1.f, 1.f}, sv = (f32x4){0.f, 0.f, 0.f, 0.f};
                if (rope) { const int n = r & 4095; const int pos = iscol ? (n & 63) : (n >> 6); cv = *(const f32x4*)(rc + pos * 16 + 4 * fq); sv = *(const f32x4*)(rs + pos * 16 + 4 * fq); }
#pragma unroll
                for (int bj = 0; bj < 2; ++bj) {
                    const f32x4 v0 = acc[ai][bj][m][0], v1 = acc[ai][bj][m][1];
                    const float o0 = (v0[0] * cv[0] - v0[1] * sv[0]) * sc, o1 = (v0[1] * cv[0] + v0[0] * sv[0]) * sc;
                    const float o2 = (v0[2] * cv[1] - v0[3] * sv[1]) * sc, o3 = (v0[3] * cv[1] + v0[2] * sv[1]) * sc;
                    const float o4 = (v1[0] * cv[2] - v1[1] * sv[2]) * sc, o5 = (v1[1] * cv[2] + v1[0] * sv[2]) * sc;
                    const float o6 = (v1[2] * cv[3] - v1[3] * sv[3]) * sc, o7 = (v1[3] * cv[3] + v1[2] * sv[3]) * sc;
                    v4u w; w.x = pkbf(o0, o1); w.y = pkbf(o2, o3); w.z = pkbf(o4, o5); w.w = pkbf(o6, o7);
                    *(v4u*)(base + (size_t)r * ld + coff + bj * 128 + wc * 32 + 8 * fq) = w;
                }
            }
    }
};
template <bool XIN_BF16> struct EpiResid {
    static constexpr bool PERM = true, AFTER_DRAIN = false;
    const void* xlat; const void* xctx; bf16* out; const float* gate;
    __device__ __forceinline__ void operator()(const f32x4 (&acc)[2][2][4][2], const pg8::Unit& u, int wr, int wc, int fr, int fq) const {
        const int mb = u.pm < MLAT / 256 ? (u.pm >> 4) : 8;
        const int col0 = u.pn * 256 + wc * 32 + 8 * fq;
        const float* gp = gate + (size_t)mb * 6144 + col0;
        f32x4 gv[2][2];
#pragma unroll
        for (int bj = 0; bj < 2; ++bj)
#pragma unroll
            for (int n = 0; n < 2; ++n) gv[bj][n] = *(const f32x4*)(gp + bj * 128 + n * 4);
#pragma unroll
        for (int ai = 0; ai < 2; ++ai)
#pragma unroll
            for (int m = 0; m < 4; ++m) {
                const int r = u.pm * 256 + ai * 128 + wr * 64 + m * 16 + fr;
                bf16* o = out + (size_t)r * D + col0;
#pragma unroll
                for (int bj = 0; bj < 2; ++bj) { f32x4 x0, x1;
                    if (XIN_BF16) { const v4u w = *(const v4u*)((const bf16*)xlat + (size_t)r * D + col0 + bj * 128);
                        x0 = (f32x4){bflo(w.x), bfhi(w.x), bflo(w.y), bfhi(w.y)}; x1 = (f32x4){bflo(w.z), bfhi(w.z), bflo(w.w), bfhi(w.w)}; }
                    else { const float* xin = (r < MLAT ? (const float*)xlat + (size_t)r * D : (const float*)xctx + (size_t)(r - MLAT) * D) + col0 + bj * 128; x0 = *(const f32x4*)xin; x1 = *(const f32x4*)(xin + 4); }
                    x0 += gv[bj][0] * acc[ai][bj][m][0]; x1 += gv[bj][1] * acc[ai][bj][m][1];
                    v4u w; w.x = pkbf(x0[0], x0[1]); w.y = pkbf(x0[2], x0[3]); w.z = pkbf(x1[0], x1[1]); w.w = pkbf(x1[2], x1[3]);
                    *(v4u*)(o + bj * 128) = w; }
            }
    }
};
struct EpiSwiGLU {
    static constexpr bool PERM = true, AFTER_DRAIN = false;
    unsigned char* HID;
    __device__ __forceinline__ void operator()(const f32x4 (&acc)[2][2][4][2], const pg8::Unit& u, int wr, int wc, int fr, int fq) const {
        asm volatile("" : "+v"(fr), "+v"(fq));
        const int col = (u.pn & 15) * 128 + wc * 32 + 8 * fq;
#pragma unroll
        for (int ai = 0; ai < 2; ++ai)
#pragma unroll
            for (int m = 0; m < 4; ++m) {
                const int r = u.pm * 256 + ai * 128 + wr * 64 + m * 16 + fr;
                const f32x4 g0 = acc[ai][0][m][0] * W8I, g1 = acc[ai][0][m][1] * W8I, u0 = acc[ai][1][m][0] * W8I, u1 = acc[ai][1][m][1] * W8I;
                v2u w; w.x = pk4f8(silu_f(g0[0]) * u0[0], silu_f(g0[1]) * u0[1], silu_f(g0[2]) * u0[2], silu_f(g0[3]) * u0[3]);
                w.y = pk4f8(silu_f(g1[0]) * u1[0], silu_f(g1[1]) * u1[1], silu_f(g1[2]) * u1[2], silu_f(g1[3]) * u1[3]);
                *(v2u*)(HID + (size_t)r * FF + col) = w;
            }
    }
};
struct EpiY {
    static constexpr bool PERM = true, AFTER_DRAIN = false;
    bf16* Y;
    __device__ __forceinline__ void operator()(const f32x4 (&acc)[2][2][4][2], const pg8::Unit& u, int wr, int wc, int fr, int fq) const {
        asm volatile("" : "+v"(fr), "+v"(fq));
        const int col = (u.pn & 3) * 256 + wc * 32 + 8 * fq;
#pragma unroll
        for (int ai = 0; ai < 2; ++ai)
#pragma unroll
            for (int m = 0; m < 4; ++m) {
                const int r = u.pm * 256 + ai * 128 + wr * 64 + m * 16 + fr;
                const float gwt = W8I;
#pragma unroll
                for (int bj = 0; bj < 2; ++bj) { const f32x4 v0 = acc[ai][bj][m][0] * gwt, v1 = acc[ai][bj][m][1] * gwt;
                    v4u w; w.x = pkbf(v0[0], v0[1]); w.y = pkbf(v0[2], v0[3]); w.z = pkbf(v1[0], v1[1]); w.w = pkbf(v1[2], v1[3]);
                    *(v4u*)(Y + (size_t)r * D + col + bj * 128) = w; }
            }
    }
};
struct EpiP {
    static constexpr bool PERM = true, AFTER_DRAIN = false;
    bf16 *P, *Z;
    __device__ __forceinline__ void operator()(const f32x4 (&acc)[2][2][4][2], const pg8::Unit& u, int wr, int wc, int fr, int fq) const {
        bf16* base; int ld, coff;
        if (u.pn < 12) { base = P; ld = 3072; coff = u.pn * 256; } else { base = Z; ld = 1024; coff = (u.pn - 12) * 256; }
#pragma unroll
        for (int ai = 0; ai < 2; ++ai)
#pragma unroll
            for (int m = 0; m < 4; ++m) {
                const int r = u.pm * 256 + ai * 128 + wr * 64 + m * 16 + fr;
#pragma unroll
                for (int bj = 0; bj < 2; ++bj) { const f32x4 v0 = acc[ai][bj][m][0], v1 = acc[ai][bj][m][1];
                    v4u w; w.x = pkbf(v0[0], v0[1]); w.y = pkbf(v0[2], v0[3]); w.z = pkbf(v1[0], v1[1]); w.w = pkbf(v1[2], v1[3]);
                    *(v4u*)(base + (size_t)r * ld + coff + bj * 128 + wc * 32 + 8 * fq) = w; }
            }
    }
};

typedef float f32x16 __attribute__((ext_vector_type(16)));
typedef float f32x2_t __attribute__((ext_vector_type(2)));
typedef __bf16 bf16x2_t __attribute__((ext_vector_type(2)));
__device__ __forceinline__ unsigned cvtpk(float lo, float hi) { f32x2_t v = {lo, hi}; bf16x2_t b = __builtin_convertvector(v, bf16x2_t); return __builtin_bit_cast(unsigned, b); }
#define MFMA32(a, b, c) __builtin_amdgcn_mfma_f32_32x32x16_bf16((a), (b), (c), 0, 0, 0)
constexpr float LOG2E = 1.4426950408889634f;
constexpr float QSCALE = 0.125f * LOG2E;
constexpr int ATT_KROW = 144, ATT_VROW = 136, ATT_KB = 64 * ATT_KROW, ATT_VB = 64 * ATT_VROW;
struct AttU { int b, kvh, qb, hq, n, jlo, nl, T; bool lat; size_t mrow, ctxbase, latbase; };
__device__ __forceinline__ void att_decode(AttU& U, int u, int g, int half, int r) {
    constexpr int NU_LAT = NB * 4 * 64;
    U.lat = u < NU_LAT;
    if (U.lat) { U.b = u >> 8; U.kvh = (u >> 6) & 3; U.qb = u & 63; } else { const int uu = u - NU_LAT; U.b = uu >> 4; U.kvh = (uu >> 2) & 3; U.qb = uu & 3; }
    U.hq = U.kvh * 4 + g; U.n = U.qb * 64 + half * 32 + r;
    U.mrow = U.lat ? (size_t)U.b * SEQ + U.n : (size_t)MLAT + U.b * CTXL + U.n;
    U.jlo = U.lat ? (U.qb - 2 < 0 ? 0 : U.qb - 2) : 0; const int jhi = U.lat ? (U.qb + 2 > 63 ? 63 : U.qb + 2) : -1; U.nl = jhi - U.jlo + 1; U.T = U.nl + 4;
    U.ctxbase = (size_t)MLAT + U.b * CTXL; U.latbase = (size_t)U.b * SEQ;
}
__device__ __forceinline__ void phase_attn_v2(const Frame& F, const Args& A) {
    const bf16* Q = (const bf16*)(A.ws + WS_Q); const bf16* K = (const bf16*)(A.ws + WS_K); const bf16* VT = (const bf16*)(A.ws + WS_V); bf16* O = (bf16*)(A.ws + WS_ATT);
    LAS unsigned char* Kb = F.lds; LAS unsigned char* Vb = F.lds + 2 * ATT_KB;
    const int g = F.wave >> 1, half = F.wave & 1, r = F.lane & 31, hh = F.lane >> 5;
    const int kr = F.tid >> 3, kc = F.tid & 7;
    constexpr int NU = NB * 4 * 64 + NB * 4 * 4;
    int u = F.vcu; bool have = u < NU;
    AttU U{}, Un{}; v4u kreg = (v4u){0u, 0u, 0u, 0u}, vreg = kreg; bf16x8 qfn[4];
#pragma unroll
    for (int ks = 0; ks < 4; ++ks) qfn[ks] = (bf16x8){0, 0, 0, 0, 0, 0, 0, 0};
#define ATT_PREFETCH(UU) do { const size_t rb_ = ((UU).nl > 0) ? (UU).latbase + (size_t)(UU).jlo * 64 : (UU).ctxbase; \
        kreg = *(const v4u*)(K + (rb_ + kr) * 256 + (UU).kvh * 64 + kc * 8); vreg = *(const v4u*)(VT + (size_t)((UU).kvh * 64 + kr) * MTOT + rb_ + kc * 8); \
        _Pragma("unroll") for (int ks_ = 0; ks_ < 4; ++ks_) qfn[ks_] = *(const bf16x8*)(Q + (UU).mrow * 1024 + (UU).hq * 64 + 16 * ks_ + 8 * hh); } while (0)
    if (have) { att_decode(U, u, g, half, r); ATT_PREFETCH(U); }
    while (have) {
        const int b = U.b, kvh = U.kvh, qb = U.qb, hq = U.hq, n = U.n, jlo = U.jlo, nl = U.nl, T = U.T; const size_t mrow = U.mrow, ctxbase = U.ctxbase, latbase = U.latbase; (void)b;
        bf16x8 qf[4];
#pragma unroll
        for (int ks = 0; ks < 4; ++ks) qf[ks] = qfn[ks];
        const float sink2 = A.in[8][hq] * LOG2E;
        float mrun = sink2, lsum = 0.f;
        f32x16 oacc[2];
#pragma unroll
        for (int i = 0; i < 16; ++i) { oacc[0][i] = 0.f; oacc[1][i] = 0.f; }
        *(LAS v4u*)(Kb + kr * ATT_KROW + kc * 16) = kreg;
        *(LAS v2u*)(Vb + kr * ATT_VROW + kc * 16) = (v2u){vreg.x, vreg.y}; *(LAS v2u*)(Vb + kr * ATT_VROW + kc * 16 + 8) = (v2u){vreg.z, vreg.w};
        __syncthreads();
        const int un = u + F.G; const bool hn = un < NU;
        if (hn) att_decode(Un, un, g, half, r);
        for (int t = 0; t < T; ++t) {
            if (t + 1 < T) { const int t1 = t + 1; const size_t rb = (t1 < nl) ? latbase + (size_t)(jlo + t1) * 64 : ctxbase + (size_t)(t1 - nl) * 64;
                kreg = *(const v4u*)(K + (rb + kr) * 256 + kvh * 64 + kc * 8); vreg = *(const v4u*)(VT + (size_t)(kvh * 64 + kr) * MTOT + rb + kc * 8); }
            else if (hn) ATT_PREFETCH(Un);
            const LAS unsigned char* kb = Kb + (t & 1) * ATT_KB; const LAS unsigned char* vb = Vb + (t & 1) * ATT_VB;
            f32x16 st[2];
#pragma unroll
            for (int sub = 0; sub < 2; ++sub) {
#pragma unroll
                for (int i = 0; i < 16; ++i) st[sub][i] = 0.f;
#pragma unroll
                for (int ks = 0; ks < 4; ++ks) { const bf16x8 kf = *(const LAS bf16x8*)(kb + (32 * sub + r) * ATT_KROW + (16 * ks + 8 * hh) * 2); st[sub] = MFMA32(kf, qf[ks], st[sub]); }
            }
            if (t < nl) { const int jt = jlo + t;
                if (jt == qb - 2 || jt == qb + 2) {
#pragma unroll
                    for (int sub = 0; sub < 2; ++sub)
#pragma unroll
                        for (int i = 0; i < 16; ++i) { const int key = jt * 64 + 32 * sub + (i & 3) + 8 * (i >> 2) + 4 * hh; const int d = key - n; if (d > 128 || d < -128) st[sub][i] = -INFINITY; }
                } }
            float mx = st[0][0];
#pragma unroll
            for (int i = 1; i < 16; ++i) mx = fmaxf(mx, st[0][i]);
#pragma unroll
            for (int i = 0; i < 16; ++i) mx = fmaxf(mx, st[1][i]);
            mx = fmaxf(mx, __shfl_xor(mx, 32));
            const float mnew = fmaxf(mrun, mx);
            if (__builtin_amdgcn_ballot_w64(mnew != mrun) != 0ull) {
                const float alpha = __builtin_amdgcn_exp2f(mrun - mnew); mrun = mnew; lsum *= alpha;
#pragma unroll
                for (int i = 0; i < 16; ++i) { oacc[0][i] *= alpha; oacc[1][i] *= alpha; } }
            float ps = 0.f;
#pragma unroll
            for (int sub = 0; sub < 2; ++sub)
#pragma unroll
                for (int i = 0; i < 16; ++i) { const float p = __builtin_amdgcn_exp2f(st[sub][i] - mnew); st[sub][i] = p; ps += p; }
            lsum += ps;
#pragma unroll
            for (int sub = 0; sub < 2; ++sub)
#pragma unroll
                for (int s = 0; s < 2; ++s) {
                    v4u pw; pw.x = cvtpk(st[sub][8 * s], st[sub][8 * s + 1]); pw.y = cvtpk(st[sub][8 * s + 2], st[sub][8 * s + 3]); pw.z = cvtpk(st[sub][8 * s + 4], st[sub][8 * s + 5]); pw.w = cvtpk(st[sub][8 * s + 6], st[sub][8 * s + 7]);
                    const bf16x8 pf = __builtin_bit_cast(bf16x8, pw);
#pragma unroll
                    for (int dt = 0; dt < 2; ++dt) { const LAS unsigned char* vp = vb + (32 * dt + r) * ATT_VROW + (32 * sub + 16 * s + 4 * hh) * 2;
                        const v2u lo = *(const LAS v2u*)vp, hi = *(const LAS v2u*)(vp + 16);
                        const bf16x8 vf = __builtin_bit_cast(bf16x8, (v4u){lo.x, lo.y, hi.x, hi.y});
                        oacc[dt] = MFMA32(vf, pf, oacc[dt]); }
                }
            if (t + 1 < T) { LAS unsigned char* kw = Kb + ((t + 1) & 1) * ATT_KB; LAS unsigned char* vw = Vb + ((t + 1) & 1) * ATT_VB;
                *(LAS v4u*)(kw + kr * ATT_KROW + kc * 16) = kreg;
                *(LAS v2u*)(vw + kr * ATT_VROW + kc * 16) = (v2u){vreg.x, vreg.y}; *(LAS v2u*)(vw + kr * ATT_VROW + kc * 16 + 8) = (v2u){vreg.z, vreg.w}; }
            __syncthreads();
        }
        lsum += __shfl_xor(lsum, 32);
        const float inv = 1.0f / (lsum + __builtin_amdgcn_exp2f(sink2 - mrun));
        bf16* orow = O + mrow * 1024 + hq * 64;
#pragma unroll
        for (int dt = 0; dt < 2; ++dt)
#pragma unroll
            for (int rq = 0; rq < 4; ++rq) { v2u w; w.x = cvtpk(oacc[dt][4 * rq] * inv, oacc[dt][4 * rq + 1] * inv); w.y = cvtpk(oacc[dt][4 * rq + 2] * inv, oacc[dt][4 * rq + 3] * inv);
                *(v2u*)(orow + 32 * dt + 8 * rq + 4 * hh) = w; }
        U = Un; u = un; have = hn;
    }
#undef ATT_PREFETCH
    if (F.G == 256 && F.vcu >= 128) tr_moe_items(F, A.in[26], A.in[27], A.in[28], A.ws + WS_WGU1, A.ws + WS_WD1, 0, L1_ATT, (F.vcu - 128) * NWAVES + F.wave, 128 * NWAVES);
    else if (F.G != 256) tr_moe_items(F, A.in[26], A.in[27], A.in[28], A.ws + WS_WGU1, A.ws + WS_WD1, 0, L1_ATT, F.vcu * NWAVES + F.wave, F.G * NWAVES);
}

template <int R> __device__ __forceinline__ void nr_rows(const Frame& F, const bf16* xres, int m0, const float* g, const float* mod, const LAS float* WrT, unsigned char* H8, float* AFF, float* AFFC, RowCoef& C, int& curb) {
    f32x4 vv[R][4];
#pragma unroll
    for (int t = 0; t < R; ++t) load_row_bf16(vv[t], xres + (size_t)(m0 + t) * D, F.lane);
#pragma unroll
    for (int t = 0; t < R; ++t) { const int m = m0 + t; const int mb = modrow(m);
        if (mb != curb) { load_coef(C, g, mod + (size_t)mb * 6144 + 3 * 1024, mod + (size_t)mb * 6144 + 4 * 1024, F.lane); curb = mb; }
        const float rstd = row_rstd(vv[t]);
#pragma unroll
        for (int j = 0; j < 4; ++j) vv[t][j] = vv[t][j] * rstd * C.a[j] + C.b[j];
#pragma unroll
        for (int j = 0; j < 4; ++j) ((unsigned*)(H8 + (size_t)m * D))[F.lane + 64 * j] = pk4f8(vv[t][j].x, vv[t][j].y, vv[t][j].z, vv[t][j].w); }
    const LAS float* wrt = WrT; asm volatile("" : "+v"(wrt));
    float lgt[R];
    proj16xR<R>(vv, wrt, F.lane, lgt);
#pragma unroll
    for (int t = 0; t < R; ++t) { const float logit = lgt[t];
        float mx = logit;
#pragma unroll
        for (int o = 4; o < 64; o <<= 1) mx = fmaxf(mx, __shfl_xor(mx, o));
        const float ex = expf(logit - mx); float den = ex;
#pragma unroll
        for (int o = 4; o < 64; o <<= 1) den += __shfl_xor(den, o);
        const float mine = ex / den; const int ee = F.lane >> 2; const int m = m0 + t;
        if ((F.lane & 3) == 0) { if (m < MLAT) AFF[((size_t)(m >> 12) * NE + ee) * SEQ + (m & 4095)] = mine; else { const int mm = m - MLAT; AFFC[((size_t)(mm >> 8) * NE + ee) * CTXL + (mm & 255)] = mine; } } }
}
__device__ __forceinline__ void phase_norm_router(const Frame& F, const Args& A, const bf16* xres, int nrows, const float* g, const float* mod, const float* router) {
    LAS float* WrT = (LAS float*)F.lds;
    for (int idx = F.tid; idx < 16384; idx += NTHR) WrT[(idx & 15) * 1024 + (idx >> 4)] = router[idx];
    __syncthreads();
    const int gw = F.vcu * NWAVES + F.wave, NGW = F.G * NWAVES;
    unsigned char* H8 = A.ws + WS_H8; float* AFF = (float*)(A.ws + WS_AFF); float* AFFC = AFF + (size_t)NB * NE * SEQ;
    const int rpw = (nrows + NGW - 1) / NGW;
    int curb = -1; RowCoef C;
    const int mbeg = gw * rpw, cnt = (nrows - mbeg) < rpw ? (nrows - mbeg) : rpw;
    int r = 0;
    for (; r + 4 <= cnt; r += 4) nr_rows<4>(F, xres, mbeg + r, g, mod, WrT, H8, AFF, AFFC, C, curb);
    for (; r < cnt; ++r) nr_rows<1>(F, xres, mbeg + r, g, mod, WrT, H8, AFF, AFFC, C, curb);
    __syncthreads();
}

__device__ __forceinline__ void phase_topk(const Frame& F, const Args& A, bool with_ctx, int erows, const float* cwg, const float* cwu, const float* cwd, unsigned char* cwgu, unsigned char* cwdn, int clo, int chi) {
    LAS unsigned* hist = (LAS unsigned*)F.lds;
    LAS unsigned* ctl = hist + 256;
    LAS unsigned* wsum = hist + 272;
    LAS int* sel = (LAS int*)(hist + 512);
    const float* AFF = (const float*)(A.ws + WS_AFF); const float* AFFC = AFF + (size_t)NB * NE * SEQ;
    float* GW = (float*)(A.ws + WS_GW); int* SLOT = (int*)(A.ws + WS_SLOT);
    const unsigned char* H8 = A.ws + WS_H8; unsigned char* XG = A.ws + WS_XG;
    const int nprob = with_ctx ? 256 : 128;
    for (int p = F.vcu; p < nprob; p += F.G) {
        int b, e, N, cap, rowbase, tokbase; const float* src;
        if (p < 128) { b = p >> 4; e = p & 15; N = SEQ; cap = CAPL; src = AFF + (size_t)(b * NE + e) * SEQ; rowbase = e * erows + b * CAPL; tokbase = b * SEQ; }
        else { const int pp = p - 128; b = pp >> 4; e = pp & 15; N = CTXL; cap = CAPC; src = AFFC + (size_t)(b * NE + e) * CTXL; rowbase = e * erows + NB * CAPL + b * CAPC; tokbase = MLAT + b * CTXL; }
        const bool own = 8 * F.tid < N;
        unsigned v[8];
        { f32x4 x0 = (f32x4){0.f, 0.f, 0.f, 0.f}, x1 = x0; if (own) { x0 = ((const f32x4*)src)[2 * F.tid]; x1 = ((const f32x4*)src)[2 * F.tid + 1]; }
          v[0] = __float_as_uint(x0.x); v[1] = __float_as_uint(x0.y); v[2] = __float_as_uint(x0.z); v[3] = __float_as_uint(x0.w); v[4] = __float_as_uint(x1.x); v[5] = __float_as_uint(x1.y); v[6] = __float_as_uint(x1.z); v[7] = __float_as_uint(x1.w); }
        unsigned prefix = 0u, need = (unsigned)cap;
#pragma unroll
        for (int pass = 0; pass < 4; ++pass) { const int shift = 24 - 8 * pass;
            if (F.tid < 256) hist[F.tid] = 0u;
            __syncthreads();
            if (own) {
#pragma unroll
                for (int k = 0; k < 8; ++k) { const bool match = (pass == 0) ? true : ((v[k] >> ((shift + 8) & 31)) == (prefix >> ((shift + 8) & 31))); if (match) atomicAdd((unsigned*)&hist[(v[k] >> shift) & 255u], 1u); } }
            __syncthreads();
            if (F.wave == 0) { const unsigned c0 = hist[4 * F.lane], c1 = hist[4 * F.lane + 1], c2 = hist[4 * F.lane + 2], c3 = hist[4 * F.lane + 3]; const unsigned tot = (c0 + c1) + (c2 + c3);
                unsigned sv = tot;
#pragma unroll
                for (int o = 1; o < 64; o <<= 1) { const unsigned t = __shfl_down(sv, o); if (F.lane + o < 64) sv += t; }
                const unsigned g3 = sv - tot, g2 = g3 + c3, g1 = g2 + c2, g0 = g1 + c1;
                if (g3 < need && need <= g3 + c3) { ctl[0] = 4 * F.lane + 3; ctl[1] = need - g3; }
                else if (g2 < need && need <= g2 + c2) { ctl[0] = 4 * F.lane + 2; ctl[1] = need - g2; }
                else if (g1 < need && need <= g1 + c1) { ctl[0] = 4 * F.lane + 1; ctl[1] = need - g1; }
                else if (g0 < need && need <= g0 + c0) { ctl[0] = 4 * F.lane; ctl[1] = need - g0; } }
            __syncthreads();
            prefix |= ctl[0] << shift; need = ctl[1]; }
        const unsigned T = prefix;
        unsigned packed = 0u;
        if (own) {
#pragma unroll
            for (int k = 0; k < 8; ++k) packed += (v[k] > T ? 1u : 0u) + (v[k] == T ? 0x10000u : 0u); }
        unsigned incl = packed;
#pragma unroll
        for (int o = 1; o < 64; o <<= 1) { const unsigned t = __shfl_up(incl, o); if (F.lane >= o) incl += t; }
        if (F.lane == 63) wsum[F.wave] = incl;
        __syncthreads();
        unsigned base = 0u;
#pragma unroll
        for (int w = 0; w < 8; ++w) if (w < F.wave) base += wsum[w];
        unsigned rg = ((incl - packed) + base) & 0xffffu, re = ((incl - packed) + base) >> 16; const unsigned totalgt = (unsigned)cap - need;
        if (own) {
#pragma unroll
            for (int k = 0; k < 8; ++k) { const int tok = tokbase + 8 * F.tid + k; int slot = -1;
                if (v[k] > T) { slot = (int)rg; ++rg; } else if (v[k] == T) { if (re < need) slot = (int)(totalgt + re); ++re; }
                if (slot >= 0) { GW[rowbase + slot] = __uint_as_float(v[k]); SLOT[(size_t)tok * 16 + e] = rowbase + slot; sel[slot] = tok; } else SLOT[(size_t)tok * 16 + e] = -1; } }
        __syncthreads();
        for (int i0 = F.wave; i0 < cap; i0 += 8 * NWAVES) {
            v4u x[8];
#pragma unroll
            for (int q = 0; q < 8; ++q) { const int i = i0 + q * NWAVES; const int tok = sel[i < cap ? i : i0]; x[q] = ((const v4u*)(H8 + (size_t)tok * D))[F.lane]; }
#pragma unroll
            for (int q = 0; q < 8; ++q) { const int i = i0 + q * NWAVES; if (i < cap) ((v4u*)(XG + (size_t)(rowbase + i) * D))[F.lane] = x[q]; } }
        __syncthreads();
    }
    if (F.G == 256) { if (F.vcu >= 128) tr_moe_items(F, cwg, cwu, cwd, cwgu, cwdn, clo, chi, (F.vcu - 128) * NWAVES + F.wave, 128 * NWAVES); }
    else tr_moe_items(F, cwg, cwu, cwd, cwgu, cwdn, clo, chi, F.vcu * NWAVES + F.wave, F.G * NWAVES);
}

struct CombineIn { int sv; v2u xr[4]; };
__device__ __forceinline__ void combine_issue(CombineIn& ci, const bf16* xres_row, const int* slot_row, int lane) {
    ci.sv = slot_row[lane & 15];
#pragma unroll
    for (int j = 0; j < 4; ++j) ci.xr[j] = ((const v2u*)xres_row)[lane + 64 * j];
}
__device__ __forceinline__ void combine_finish(f32x4 (&v)[4], const CombineIn& ci, const bf16* Y, const float* GW, const float* gt2, int lane) {
    f32x4 acc[4];
#pragma unroll
    for (int j = 0; j < 4; ++j) acc[j] = (f32x4){0.f, 0.f, 0.f, 0.f};
    const int sv = ci.sv;
    unsigned mask = (unsigned)(__builtin_amdgcn_ballot_w64(sv >= 0) & 0xffffull);
    while (mask) {
        v2u w[4][4]; float gte[4];
#pragma unroll
        for (int q = 0; q < 4; ++q) {
            gte[q] = 0.f;
#pragma unroll
            for (int j = 0; j < 4; ++j) w[q][j] = (v2u){0u, 0u};
            if (mask) { const int e = __builtin_ctz(mask); mask &= mask - 1u; const int s = __builtin_amdgcn_readlane(sv, e);
                gte[q] = GW[s]; const v2u* yr = (const v2u*)(Y + (size_t)s * D);
#pragma unroll
                for (int j = 0; j < 4; ++j) w[q][j] = yr[lane + 64 * j]; } }
#pragma unroll
        for (int q = 0; q < 4; ++q)
#pragma unroll
            for (int j = 0; j < 4; ++j) acc[j] += (f32x4){bflo(w[q][j].x), bfhi(w[q][j].x), bflo(w[q][j].y), bfhi(w[q][j].y)} * gte[q];
    }
#pragma unroll
    for (int j = 0; j < 4; ++j) v[j] = (f32x4){bflo(ci.xr[j].x), bfhi(ci.xr[j].x), bflo(ci.xr[j].y), bfhi(ci.xr[j].y)} + ((const f32x4*)gt2)[lane + 64 * j] * acc[j];
}

template <int R> __device__ __forceinline__ void cmb_rows(const Frame& F, const Args& A, int m0, const LAS float* WabT, RowCoef& C, int& curb, float alog, float dtb) {
    const float* MOD0 = (const float*)(A.ws + WS_MOD); const float* MOD1 = MOD0 + 9 * 6144;
    bf16* XRES = (bf16*)(A.ws + WS_XRES); bf16* H = (bf16*)(A.ws + WS_H); const bf16* Y = (const bf16*)(A.ws + WS_XG); const int* SLOT = (const int*)(A.ws + WS_SLOT);
    float* Gb = (float*)(A.ws + WS_G); float* Bb = (float*)(A.ws + WS_BETA);
    f32x4 vv[R][4]; CombineIn ci[R];
#pragma unroll
    for (int t = 0; t < R; ++t) combine_issue(ci[t], XRES + (size_t)(m0 + t) * D, SLOT + (size_t)(m0 + t) * 16, F.lane);
#pragma unroll
    for (int t = 0; t < R; ++t) { const int m = m0 + t; const int mb = modrow(m);
        if (mb != curb) { load_coef(C, A.in[17], MOD1 + (size_t)mb * 6144, MOD1 + (size_t)mb * 6144 + 1024, F.lane); curb = mb; }
        combine_finish(vv[t], ci[t], Y, (const float*)(A.ws + WS_GW), MOD0 + (size_t)mb * 6144 + 5 * 1024, F.lane);
        store_row_bf16(XRES + (size_t)m * D, vv[t], F.lane);
        const float rstd = row_rstd(vv[t]);
#pragma unroll
        for (int j = 0; j < 4; ++j) vv[t][j] = vv[t][j] * rstd * C.a[j] + C.b[j];
        store_row_bf16(H + (size_t)m * D, vv[t], F.lane); }
    const LAS float* wab = WabT; asm volatile("" : "+v"(wab));
    float av[R], bv[R];
    proj16xR<R>(vv, wab, F.lane, av); proj16xR<R>(vv, wab + 16 * 1024, F.lane, bv);
    if ((F.lane & 3) == 0) { const int jj = F.lane >> 2;
#pragma unroll
        for (int t = 0; t < R; ++t) { const int m = m0 + t; const float xx = av[t] + dtb; const float sp = fmaxf(xx, 0.f) + log1pf(expf(-fabsf(xx))); Gb[(size_t)m * 16 + jj] = -expf(alog) * sp; Bb[(size_t)m * 16 + jj] = 1.0f / (1.0f + expf(-bv[t])); } }
}
__device__ __forceinline__ void phase_combine0(const Frame& F, const Args& A) {
    const int gw = F.vcu * NWAVES + F.wave, NGW = F.G * NWAVES;
    tr_moe_items(F, A.in[26], A.in[27], A.in[28], A.ws + WS_WGU1, A.ws + WS_WD1, L1_ATT + L1_G2 + L1_WIN, L1_ATT + L1_G2 + L1_WIN + L1_CMB, gw, NGW);
    __syncthreads();
    LAS float* WabT = (LAS float*)F.lds;
    for (int idx = F.tid; idx < 32768; idx += NTHR) { const int k = idx >> 5, j = idx & 31; WabT[j * 1024 + k] = A.in[18][(size_t)k * LDWIN + 4096 + j]; }
    __syncthreads();
    const int rpw = (MTOT + NGW - 1) / NGW;
    int curb = -1; RowCoef C;
    const float alog = A.in[20][(F.lane >> 2) & 15], dtb = A.in[21][(F.lane >> 2) & 15];
    const int mbeg = gw * rpw, cnt = (MTOT - mbeg) < rpw ? (MTOT - mbeg) : rpw;
    int r = 0;
    for (; r + 4 <= cnt; r += 4) cmb_rows<4>(F, A, mbeg + r, WabT, C, curb, alog, dtb);
    for (; r < cnt; ++r) cmb_rows<1>(F, A, mbeg + r, WabT, C, curb, alog, dtb);
    __syncthreads();
}

__device__ __forceinline__ void phase_conv(const Frame& F, const Args& A) {
    const int gw = F.vcu * NWAVES + F.wave, NGW = F.G * NWAVES;
    const bf16* P = (const bf16*)(A.ws + WS_PQKV); const float* cw = A.in[19];
    bf16* out0 = (bf16*)(A.ws + WS_QN);
    const int nchunk = NGW / 2, rpc = (MTOT + nchunk - 1) / nchunk;
    const int half = gw & 1, chunk = gw >> 1;
    const int mbeg = chunk * rpc, cnt = (MTOT - mbeg) < rpc ? (MTOT - mbeg) : rpc;
    if (cnt <= 0) return;
    float w[3][3][8];
#pragma unroll
    for (int ii = 0; ii < 3; ++ii) { const int c = 512 * (3 * half + ii) + 8 * F.lane;
#pragma unroll
        for (int j = 0; j < 3; ++j) { const f32x4 a = *(const f32x4*)(cw + j * 3072 + c), bq = *(const f32x4*)(cw + j * 3072 + c + 4);
            w[ii][j][0] = a.x; w[ii][j][1] = a.y; w[ii][j][2] = a.z; w[ii][j][3] = a.w; w[ii][j][4] = bq.x; w[ii][j][5] = bq.y; w[ii][j][6] = bq.z; w[ii][j][7] = bq.w; } }
    v4u xp[3], xc[3], xn[3], xnn[3];
    const int cbase = 512 * 3 * half + 8 * F.lane;
#pragma unroll
    for (int ii = 0; ii < 3; ++ii) { xp[ii] = (v4u){0u, 0u, 0u, 0u}; xc[ii] = *(const v4u*)(P + (size_t)mbeg * 3072 + cbase + 512 * ii); xn[ii] = (v4u){0u, 0u, 0u, 0u}; xnn[ii] = (v4u){0u, 0u, 0u, 0u}; }
    if (mbeg > 0) {
#pragma unroll
        for (int ii = 0; ii < 3; ++ii) xp[ii] = *(const v4u*)(P + (size_t)(mbeg - 1) * 3072 + cbase + 512 * ii); }
    if (mbeg + 1 < MTOT) {
#pragma unroll
        for (int ii = 0; ii < 3; ++ii) xn[ii] = *(const v4u*)(P + (size_t)(mbeg + 1) * 3072 + cbase + 512 * ii); }
    for (int r = 0; r < cnt; ++r) { const int m = mbeg + r;
        bool hp, hn; if (m < MLAT) { const int n = m & 4095; hp = n > 0; hn = n < SEQ - 1; } else { const int l = (m - MLAT) & 255; hp = l > 0; hn = l < CTXL - 1; }
        if (m + 2 < MTOT) {
#pragma unroll
            for (int ii = 0; ii < 3; ++ii) xnn[ii] = *(const v4u*)(P + (size_t)(m + 2) * 3072 + cbase + 512 * ii); }
#pragma unroll
        for (int ii = 0; ii < 3; ++ii) { const int i = 3 * half + ii;
            const v4u a = hp ? xp[ii] : (v4u){0u, 0u, 0u, 0u}, c = xc[ii], e = hn ? xn[ii] : (v4u){0u, 0u, 0u, 0u};
            float y[8];
            y[0] = bflo(a.x) * w[ii][0][0] + bflo(c.x) * w[ii][1][0] + bflo(e.x) * w[ii][2][0]; y[1] = bfhi(a.x) * w[ii][0][1] + bfhi(c.x) * w[ii][1][1] + bfhi(e.x) * w[ii][2][1];
            y[2] = bflo(a.y) * w[ii][0][2] + bflo(c.y) * w[ii][1][2] + bflo(e.y) * w[ii][2][2]; y[3] = bfhi(a.y) * w[ii][0][3] + bfhi(c.y) * w[ii][1][3] + bfhi(e.y) * w[ii][2][3];
            y[4] = bflo(a.z) * w[ii][0][4] + bflo(c.z) * w[ii][1][4] + bflo(e.z) * w[ii][2][4]; y[5] = bfhi(a.z) * w[ii][0][5] + bfhi(c.z) * w[ii][1][5] + bfhi(e.z) * w[ii][2][5];
            y[6] = bflo(a.w) * w[ii][0][6] + bflo(c.w) * w[ii][1][6] + bflo(e.w) * w[ii][2][6]; y[7] = bfhi(a.w) * w[ii][0][7] + bfhi(c.w) * w[ii][1][7] + bfhi(e.w) * w[ii][2][7];
            float ss = 0.f;
#pragma unroll
            for (int t = 0; t < 8; ++t) { y[t] = silu_f(y[t]); ss += y[t] * y[t]; }
            if (i < 4) { ss += __shfl_xor(ss, 1); ss += __shfl_xor(ss, 2); ss += __shfl_xor(ss, 4); ss += __shfl_xor(ss, 8);
                const float sc = (1.0f / sqrtf(ss + EPS)) * (i < 2 ? 0.08838834764831845f : 1.0f);
#pragma unroll
                for (int t = 0; t < 8; ++t) y[t] *= sc; }
            v4u o; o.x = pkbf(y[0], y[1]); o.y = pkbf(y[2], y[3]); o.z = pkbf(y[4], y[5]); o.w = pkbf(y[6], y[7]);
            *(v4u*)(out0 + (size_t)(i >> 1) * (68 * MiB / 2) + (size_t)m * D + ((512 * i + 8 * F.lane) & 1023)) = o;
            xp[ii] = xc[ii]; xc[ii] = xn[ii]; xn[ii] = xnn[ii];
        }
    }
}

constexpr int NCHK = 68, NTASK = NB * 8 * NCHK * 2;
constexpr int TAB_OFF = RING_BYTES + 1024;
typedef short s16x4 __attribute__((ext_vector_type(4)));
typedef short v4i16_t __attribute__((ext_vector_type(4)));
__device__ __forceinline__ size_t gdn_tok0(int b, int cidx) { return cidx < 4 ? (size_t)MLAT + b * CTXL + cidx * 64 : (size_t)b * SEQ + (size_t)(cidx - 4) * 64; }
__device__ __forceinline__ bf16x8 tr_pair(const LAS unsigned char* p, int rowstride4) {
    const s16x4 lo = __builtin_bit_cast(s16x4, __builtin_amdgcn_ds_read_tr16_b64_v4i16((LAS v4i16_t*)p));
    const s16x4 hi = __builtin_bit_cast(s16x4, __builtin_amdgcn_ds_read_tr16_b64_v4i16((LAS v4i16_t*)(p + rowstride4)));
    return (bf16x8){lo[0], lo[1], lo[2], lo[3], hi[0], hi[1], hi[2], hi[3]};
}
__device__ __forceinline__ void st_acc_T(LAS unsigned char* base, int stride, int col, int row0, const f32x16& a, int hh) {
#pragma unroll
    for (int rq = 0; rq < 4; ++rq) { v2u w; w.x = cvtpk(a[4 * rq], a[4 * rq + 1]); w.y = cvtpk(a[4 * rq + 2], a[4 * rq + 3]); *(LAS v2u*)(base + col * stride + (row0 + 8 * rq + 4 * hh) * 2) = w; }
}

__device__ __forceinline__ void phase_gdn_prep(const Frame& F, const Args& A) {
    const bf16* QN = (const bf16*)(A.ws + WS_QN); const bf16* KN = (const bf16*)(A.ws + WS_KN);
    const float* Gb = (const float*)(A.ws + WS_G); const float* Bb = (const float*)(A.ws + WS_BETA);
    bf16* TB = (bf16*)(A.ws + WS_TB); bf16* TG = (bf16*)(A.ws + WS_TG); bf16* QKD = (bf16*)(A.ws + WS_QKD); float* GC = (float*)(A.ws + WS_GC);
    LAS float* As = (LAS float*)(F.lds + F.wave * 16384);
    LAS float* tab = (LAS float*)(F.lds + TAB_OFF + F.wave * 512);
    const int gw = F.vcu * NWAVES + F.wave, NGW = F.G * NWAVES;
    for (int task = gw; task < NTASK; task += NGW) {
        int ln = F.lane; asm volatile("" : "+v"(ln));
        const int r = ln & 31, hh = ln >> 5;
        const int dir = task & 1, t2 = task >> 1, cidx = t2 % NCHK, bh = t2 / NCHK, h = bh & 7, b = bh >> 3;
        const size_t m0 = gdn_tok0(b, cidx);
        { const size_t mi = m0 + (dir ? 63 - ln : ln);
          float gc = Gb[mi * 16 + dir * 8 + h]; const float bt = Bb[mi * 16 + dir * 8 + h];
#pragma unroll
          for (int o = 1; o < 64; o <<= 1) { const float t = __shfl_up(gc, o); if (ln >= o) gc += t; }
          tab[ln] = gc; tab[64 + ln] = bt; GC[(size_t)task * 64 + ln] = gc; }
        bf16x8 kf[2][8], qf[2][8];
        LAS unsigned char* tl8 = (LAS unsigned char*)As;
        const int l4 = ln >> 4, l15 = ln & 15, rr = ln & 31, h2 = ln >> 5;
#pragma unroll
        for (int which = 0; which < 2; ++which) { const bf16* src = which ? KN : QN;
#pragma unroll
            for (int hb = 0; hb < 2; ++hb) { v4u st[8];
#pragma unroll
                for (int i = 0; i < 8; ++i) { const int row = 32 * hb + 4 * i + l4; const size_t m = m0 + (dir ? 63 - row : row); st[i] = *(const v4u*)(src + m * D + h * 128 + l15 * 8); }
#pragma unroll
                for (int i = 0; i < 8; ++i) { const int row = 32 * hb + 4 * i + l4; *(LAS v4u*)(tl8 + (row * 16 + (l15 ^ (row & 15))) * 16) = st[i]; }
                asm volatile("" ::: "memory"); }
            LDS_WAIT();
#pragma unroll
            for (int ti = 0; ti < 2; ++ti) { const int row = 32 * ti + rr;
#pragma unroll
                for (int s = 0; s < 8; ++s) { const bf16x8 f = *(const LAS bf16x8*)(tl8 + (row * 16 + ((2 * s + h2) ^ (row & 15))) * 16); if (which) kf[ti][s] = f; else qf[ti][s] = f; } }
            LDS_WAIT();
        }
#pragma unroll
        for (int tile = 0; tile < 3; ++tile) { const int ti = tile == 0 ? 0 : 1, tj = tile == 2 ? 1 : 0;
            f32x16 acc;
#pragma unroll
            for (int i = 0; i < 16; ++i) acc[i] = 0.f;
#pragma unroll
            for (int s = 0; s < 8; ++s) acc = MFMA32(kf[ti][s], kf[tj][s], acc);
            const int j = 32 * tj + r; const float gcj = tab[j];
#pragma unroll
            for (int i16 = 0; i16 < 16; ++i16) { const int i = 32 * ti + (i16 & 3) + 8 * (i16 >> 2) + 4 * hh;
                As[i * 64 + j] = (i > j) ? tab[64 + i] * acc[i16] * __expf(tab[i] - gcj) : 0.f; } }
        bf16* qkd = QKD + (size_t)task * 4096;
#pragma unroll
        for (int ti = 0; ti < 2; ++ti) { const int row = 32 * ti + r;
            const float gci = tab[row];
#pragma unroll
            for (int tj = 0; tj < 2; ++tj) {
                if (tj > ti) { *(v4u*)(qkd + row * 64 + 32 + 16 * hh) = (v4u){0u, 0u, 0u, 0u}; *(v4u*)(qkd + row * 64 + 32 + 16 * hh + 8) = (v4u){0u, 0u, 0u, 0u}; continue; }
                f32x16 acc;
#pragma unroll
                for (int i = 0; i < 16; ++i) acc[i] = 0.f;
#pragma unroll
                for (int s = 0; s < 8; ++s) acc = MFMA32(kf[tj][s], qf[ti][s], acc);
#pragma unroll
                for (int rq = 0; rq < 4; ++rq) { const int j0 = 32 * tj + 8 * rq + 4 * hh; float v[4];
#pragma unroll
                    for (int e = 0; e < 4; ++e) { const int j = j0 + e; v[e] = (row >= j) ? acc[4 * rq + e] * __expf(gci - tab[j]) : 0.f; }
                    v2u w; w.x = cvtpk(v[0], v[1]); w.y = cvtpk(v[2], v[3]); *(v2u*)(qkd + row * 64 + j0) = w; }
            } }
        LDS_WAIT();
        float Tc[64];
#pragma unroll
        for (int i = 0; i < 64; ++i) { float acc = (ln == i) ? 1.f : 0.f;
#pragma unroll
            for (int jq = 0; jq < (i + 3) / 4; ++jq) { const f32x4 a4 = *(const LAS f32x4*)(As + i * 64 + 4 * jq);
                if (4 * jq + 0 < i) acc -= a4.x * Tc[4 * jq + 0];
                if (4 * jq + 1 < i) acc -= a4.y * Tc[4 * jq + 1];
                if (4 * jq + 2 < i) acc -= a4.z * Tc[4 * jq + 2];
                if (4 * jq + 3 < i) acc -= a4.w * Tc[4 * jq + 3]; }
            Tc[i] = acc; }
        { const float sb = tab[64 + ln], sg = -sb * __expf(tab[ln]);
          bf16* tb = TB + (size_t)task * 4096 + ln; bf16* tg = TG + (size_t)task * 4096 + ln;
#pragma unroll
          for (int i = 0; i < 64; ++i) { tb[i * 64] = (bf16)(cvtpk(Tc[i] * sb, 0.f) & 0xffffu); tg[i * 64] = (bf16)(cvtpk(Tc[i] * sg, 0.f) & 0xffffu); } }
        LDS_WAIT();
    }
    if (F.G == 256 && F.vcu >= 64) tr_moe_items(F, A.in[26], A.in[27], A.in[28], A.ws + WS_WGU1, A.ws + WS_WD1, L1_ATT + L1_G2 + L1_WIN + L1_CMB, L1_ATT + L1_G2 + L1_WIN + L1_CMB + L1_PREP, (F.vcu - 64) * NWAVES + F.wave, 192 * NWAVES);
    else if (F.G != 256) tr_moe_items(F, A.in[26], A.in[27], A.in[28], A.ws + WS_WGU1, A.ws + WS_WD1, L1_ATT + L1_G2 + L1_WIN + L1_CMB, L1_ATT + L1_G2 + L1_WIN + L1_CMB + L1_PREP, F.vcu * NWAVES + F.wave, F.G * NWAVES);
}

constexpr int G_QS = 0, G_KS = 17408, G_VS = 37888, G_TBS = 50176, G_TGS = 59392, G_QKS = 68608, G_WS = 77824, G_SS = 95232, G_VNS = 112640, G_VSS = 121856;
constexpr int G_SQ = 272, G_SK = 320, G_SV = 192, G_ST = 144;
__device__ __forceinline__ void phase_gdn_scan(const Frame& F, const Args& A) {
    const bf16* QN = (const bf16*)(A.ws + WS_QN); const bf16* KN = (const bf16*)(A.ws + WS_KN); const bf16* VV = (const bf16*)(A.ws + WS_VV);
    const bf16* TB = (const bf16*)(A.ws + WS_TB); const bf16* TG = (const bf16*)(A.ws + WS_TG); const bf16* QKD = (const bf16*)(A.ws + WS_QKD); const float* GC = (const float*)(A.ws + WS_GC);
    bf16* OF = (bf16*)A.out; bf16* OB = OF + (size_t)MLAT * D;
    LAS unsigned char* L = F.lds; LAS float* tab = (LAS float*)(F.lds + TAB_OFF);
    const int w = F.wave, r = F.lane & 31, hh = F.lane >> 5, g16 = F.lane >> 4, q4 = (F.lane & 15) >> 2, p4 = F.lane & 3;
    const int dkt = w >> 1, tt1 = w & 1, dvtS = w & 1;
    const int ttv = (w & 3) >> 1, dvtv = w & 1;
    const int dvto = (w & 3) >> 1, tto = w & 1;
    const int trrow = 8 * (g16 >> 1) + q4, trcol = 16 * (g16 & 1) + 4 * p4;
    for (int unit = F.vcu; unit < 256; unit += F.G) {
        const int half = unit & 1, dir = (unit >> 1) & 1, h = (unit >> 2) & 7, b = unit >> 5;
        bf16* O = dir ? OB : OF;
        f32x16 accS;
#pragma unroll
        for (int i = 0; i < 16; ++i) accS[i] = 0.f;
        v4u pre[8]; float gcv = 0.f, gcl = 0.f;
#define GDN_LOAD_A(S_) do { const int cidx_ = dir ? ((S_) < 4 ? 3 - (S_) : 71 - (S_)) : (S_); const size_t m0_ = gdn_tok0(b, cidx_); const size_t task_ = ((size_t)((b * 8 + h) * NCHK + cidx_)) * 2 + dir; \
        _Pragma("unroll") for (int e_ = 0; e_ < 2; ++e_) { const int ci_ = F.tid + 512 * e_, row_ = ci_ >> 4, c16_ = ci_ & 15; const size_t m_ = m0_ + (dir ? 63 - row_ : row_); \
            pre[2 + e_] = *(const v4u*)(KN + m_ * D + h * 128 + c16_ * 8); } \
        { const int row_ = F.tid >> 3, c16_ = F.tid & 7; const size_t m_ = m0_ + (dir ? 63 - row_ : row_); pre[4] = *(const v4u*)(VV + m_ * D + h * 128 + half * 64 + c16_ * 8); \
          pre[5] = *(const v4u*)(TB + task_ * 4096 + F.tid * 8); pre[6] = *(const v4u*)(TG + task_ * 4096 + F.tid * 8); } } while (0)
#define GDN_LOAD_B(S_) do { const int cidx_ = dir ? ((S_) < 4 ? 3 - (S_) : 71 - (S_)) : (S_); const size_t m0_ = gdn_tok0(b, cidx_); const size_t task_ = ((size_t)((b * 8 + h) * NCHK + cidx_)) * 2 + dir; \
        _Pragma("unroll") for (int e_ = 0; e_ < 2; ++e_) { const int ci_ = F.tid + 512 * e_, row_ = ci_ >> 4, c16_ = ci_ & 15; const size_t m_ = m0_ + (dir ? 63 - row_ : row_); \
            pre[e_] = *(const v4u*)(QN + m_ * D + h * 128 + c16_ * 8); } \
        pre[7] = *(const v4u*)(QKD + task_ * 4096 + F.tid * 8); \
        gcv = GC[task_ * 64 + (F.tid & 63)]; gcl = GC[task_ * 64 + 63]; } while (0)
#define GDN_LOAD(S_) do { GDN_LOAD_A(S_); GDN_LOAD_B(S_); } while (0)
#define GDN_STAGE() do { \
        _Pragma("unroll") for (int e_ = 0; e_ < 2; ++e_) { const int ci_ = F.tid + 512 * e_, row_ = ci_ >> 4, c16_ = ci_ & 15; \
            *(LAS v4u*)(L + G_QS + row_ * G_SQ + c16_ * 16) = pre[e_]; *(LAS v4u*)(L + G_KS + row_ * G_SK + c16_ * 16) = pre[2 + e_]; } \
        { const int row_ = F.tid >> 3, c16_ = F.tid & 7; *(LAS v4u*)(L + G_VS + row_ * G_SV + c16_ * 16) = pre[4]; \
          *(LAS v4u*)(L + G_TBS + row_ * G_ST + c16_ * 16) = pre[5]; *(LAS v4u*)(L + G_TGS + row_ * G_ST + c16_ * 16) = pre[6]; *(LAS v4u*)(L + G_QKS + row_ * G_ST + c16_ * 16) = pre[7]; } \
        if (F.tid < 64) { tab[F.tid] = __expf(gcv); tab[64 + F.tid] = __expf(gcl - gcv); if (F.tid == 0) tab[128] = __expf(gcl); } } while (0)
#define GDN_STAGE_A() do { \
        _Pragma("unroll") for (int e_ = 0; e_ < 2; ++e_) { const int ci_ = F.tid + 512 * e_, row_ = ci_ >> 4, c16_ = ci_ & 15; *(LAS v4u*)(L + G_KS + row_ * G_SK + c16_ * 16) = pre[2 + e_]; } \
        { const int row_ = F.tid >> 3, c16_ = F.tid & 7; *(LAS v4u*)(L + G_VS + row_ * G_SV + c16_ * 16) = pre[4]; \
          *(LAS v4u*)(L + G_TBS + row_ * G_ST + c16_ * 16) = pre[5]; *(LAS v4u*)(L + G_TGS + row_ * G_ST + c16_ * 16) = pre[6]; } } while (0)
#define GDN_STAGE_B() do { \
        _Pragma("unroll") for (int e_ = 0; e_ < 2; ++e_) { const int ci_ = F.tid + 512 * e_, row_ = ci_ >> 4, c16_ = ci_ & 15; *(LAS v4u*)(L + G_QS + row_ * G_SQ + c16_ * 16) = pre[e_]; } \
        { const int row_ = F.tid >> 3, c16_ = F.tid & 7; *(LAS v4u*)(L + G_QKS + row_ * G_ST + c16_ * 16) = pre[7]; } \
        if (F.tid < 64) { tab[F.tid] = __expf(gcv); tab[64 + F.tid] = __expf(gcl - gcv); if (F.tid == 0) tab[128] = __expf(gcl); } } while (0)
        GDN_LOAD(0); GDN_STAGE();
        GDN_LOAD(1);
        __syncthreads();
        for (int s = 0; s < NCHK; ++s) {
            const int cidx = dir ? (s < 4 ? 3 - s : 71 - s) : s; const size_t m0 = gdn_tok0(b, cidx);
            bf16x8 kT[4];
#pragma unroll
            for (int ks = 0; ks < 4; ++ks) kT[ks] = tr_pair(L + G_KS + (16 * ks + trrow) * G_SK + (32 * dkt + trcol) * 2, 4 * G_SK);
            { f32x16 accw;
#pragma unroll
              for (int i = 0; i < 16; ++i) accw[i] = 0.f;
#pragma unroll
              for (int ks = 0; ks < 4; ++ks) { const bf16x8 bq = *(const LAS bf16x8*)(L + G_TGS + (32 * tt1 + r) * G_ST + (16 * ks + 8 * hh) * 2); accw = MFMA32(kT[ks], bq, accw); }
              st_acc_T(L + G_WS, G_SQ, 32 * tt1 + r, 32 * dkt, accw, hh); }
            f32x16 accv;
#pragma unroll
            for (int i = 0; i < 16; ++i) accv[i] = 0.f;
            if (w < 4) {
#pragma unroll
                for (int ks = 0; ks < 4; ++ks) { const bf16x8 a = *(const LAS bf16x8*)(L + G_TBS + (32 * ttv + r) * G_ST + (16 * ks + 8 * hh) * 2);
                    const bf16x8 bv = tr_pair(L + G_VS + (16 * ks + trrow) * G_SV + (32 * dvtv + trcol) * 2, 4 * G_SV); accv = MFMA32(a, bv, accv); }
            }
            st_acc_T(L + G_SS, G_SQ, 32 * dvtS + r, 32 * dkt, accS, hh);
            __syncthreads();
            if (s + 1 < NCHK) GDN_STAGE_A();
            if (s + 2 < NCHK) GDN_LOAD_A(s + 2);
            f32x16 acco;
#pragma unroll
            for (int i = 0; i < 16; ++i) acco[i] = 0.f;
            if (w < 4) {
#pragma unroll
                for (int ks = 0; ks < 8; ++ks) { const bf16x8 a = *(const LAS bf16x8*)(L + G_WS + (32 * ttv + r) * G_SQ + (16 * ks + 8 * hh) * 2);
                    const bf16x8 bs = *(const LAS bf16x8*)(L + G_SS + (32 * dvtv + r) * G_SQ + (16 * ks + 8 * hh) * 2); accv = MFMA32(a, bs, accv); }
                st_acc_T(L + G_VNS, G_ST, 32 * dvtv + r, 32 * ttv, accv, hh);
                f32x16 sc;
#pragma unroll
                for (int rq = 0; rq < 4; ++rq) { const f32x4 e4 = *(const LAS f32x4*)(tab + 64 + 32 * ttv + 8 * rq + 4 * hh);
                    sc[4 * rq] = accv[4 * rq] * e4.x; sc[4 * rq + 1] = accv[4 * rq + 1] * e4.y; sc[4 * rq + 2] = accv[4 * rq + 2] * e4.z; sc[4 * rq + 3] = accv[4 * rq + 3] * e4.w; }
                st_acc_T(L + G_VSS, G_ST, 32 * dvtv + r, 32 * ttv, sc, hh);
            } else {
#pragma unroll
                for (int ks = 0; ks < 8; ++ks) { const bf16x8 a = *(const LAS bf16x8*)(L + G_SS + (32 * dvto + r) * G_SQ + (16 * ks + 8 * hh) * 2);
                    const bf16x8 bq = *(const LAS bf16x8*)(L + G_QS + (32 * tto + r) * G_SQ + (16 * ks + 8 * hh) * 2); acco = MFMA32(a, bq, acco); }
                const float egi = tab[32 * tto + r];
#pragma unroll
                for (int i = 0; i < 16; ++i) acco[i] *= egi;
            }
            __syncthreads();
            if (w >= 4) {
#pragma unroll
                for (int ks = 0; ks < 4; ++ks) { const bf16x8 a = *(const LAS bf16x8*)(L + G_VNS + (32 * dvto + r) * G_ST + (16 * ks + 8 * hh) * 2);
                    const bf16x8 bq = *(const LAS bf16x8*)(L + G_QKS + (32 * tto + r) * G_ST + (16 * ks + 8 * hh) * 2); acco = MFMA32(a, bq, acco); }
                if (cidx >= 4) { const int i = 32 * tto + r; const size_t m = m0 + (dir ? 63 - i : i);
                    bf16* op = O + m * D + h * 128 + half * 64 + 32 * dvto + 4 * hh;
#pragma unroll
                    for (int rq = 0; rq < 4; ++rq) { v2u ww; ww.x = cvtpk(acco[4 * rq], acco[4 * rq + 1]); ww.y = cvtpk(acco[4 * rq + 2], acco[4 * rq + 3]); *(v2u*)(op + 8 * rq) = ww; } }
            }
            { const float egl = tab[128];
#pragma unroll
              for (int i = 0; i < 16; ++i) accS[i] *= egl;
#pragma unroll
              for (int ks = 0; ks < 4; ++ks) { const bf16x8 bv = *(const LAS bf16x8*)(L + G_VSS + (32 * dvtS + r) * G_ST + (16 * ks + 8 * hh) * 2); accS = MFMA32(kT[ks], bv, accS); } }
            __syncthreads();
            if (s + 1 < NCHK) GDN_STAGE_B();
            if (s + 2 < NCHK) GDN_LOAD_B(s + 2);
        }
        __syncthreads();
#undef GDN_LOAD
#undef GDN_LOAD_A
#undef GDN_LOAD_B
#undef GDN_STAGE
#undef GDN_STAGE_A
#undef GDN_STAGE_B
    }
}

__device__ __forceinline__ void phase_readout(const Frame& F, const Args& A) {
    const int gw = F.vcu * NWAVES + F.wave, NGW = F.G * NWAVES;
    const bf16* OF = (const bf16*)A.out; const bf16* OB = OF + (size_t)MLAT * D; const bf16* Z = (const bf16*)(A.ws + WS_Z); bf16* RO = (bf16*)(A.ws + WS_RO);
    const f32x4 on = ((const f32x4*)A.in[22])[F.lane & 31];
    const int rpw = (MLAT + NGW - 1) / NGW;
    const int mbeg = gw * rpw, cnt = (MLAT - mbeg) < rpw ? (MLAT - mbeg) : rpw;
    for (int r = 0; r < cnt; r += 2) {
        v2u wf[2][4], wb[2][4], zw[2][4];
#pragma unroll
        for (int t = 0; t < 2; ++t) { const int m = mbeg + ((r + t < cnt) ? r + t : r);
#pragma unroll
            for (int j = 0; j < 4; ++j) { wf[t][j] = ((const v2u*)(OF + (size_t)m * D))[F.lane + 64 * j]; wb[t][j] = ((const v2u*)(OB + (size_t)m * D))[F.lane + 64 * j]; zw[t][j] = ((const v2u*)(Z + (size_t)m * D))[F.lane + 64 * j]; } }
#pragma unroll
        for (int t = 0; t < 2; ++t) { const int m = mbeg + r + t;
            f32x4 v[4];
#pragma unroll
            for (int j = 0; j < 4; ++j) {
                v[j] = (f32x4){bflo(wf[t][j].x) + bflo(wb[t][j].x), bfhi(wf[t][j].x) + bfhi(wb[t][j].x), bflo(wf[t][j].y) + bflo(wb[t][j].y), bfhi(wf[t][j].y) + bfhi(wb[t][j].y)};
                float ss = (v[j].x * v[j].x + v[j].y * v[j].y) + (v[j].z * v[j].z + v[j].w * v[j].w);
                ss += __shfl_xor(ss, 1); ss += __shfl_xor(ss, 2); ss += __shfl_xor(ss, 4); ss += __shfl_xor(ss, 8); ss += __shfl_xor(ss, 16);
                const float rs = 1.0f / sqrtf(ss * (1.0f / 128.0f) + EPS);
                v[j].x = v[j].x * rs * on.x * silu_f(bflo(zw[t][j].x)); v[j].y = v[j].y * rs * on.y * silu_f(bfhi(zw[t][j].x)); v[j].z = v[j].z * rs * on.z * silu_f(bflo(zw[t][j].y)); v[j].w = v[j].w * rs * on.w * silu_f(bfhi(zw[t][j].y)); }
            if (r + t < cnt) store_row_bf16(RO + (size_t)m * D, v, F.lane); }
    }
}


struct EpiNull { static constexpr bool PERM = false, AFTER_DRAIN = false; float* sink;
    __device__ __forceinline__ void operator()(const f32x4 (&acc)[2][2][4][2], const pg8::Unit&, int, int, int, int) const { float s = 0.f;
#pragma unroll
        for (int a = 0; a < 2; ++a)
#pragma unroll
            for (int b = 0; b < 2; ++b)
#pragma unroll
                for (int mm = 0; mm < 4; ++mm)
#pragma unroll
                    for (int n = 0; n < 2; ++n) s += acc[a][b][mm][n][0] + acc[a][b][mm][n][3];
        if (s == 12345.678f) sink[threadIdx.x] = s; }
};
struct ProbeOrder { int nunits, nM, G, c, mode;
    __device__ void init(int nunits_, int nM_, int G_, int c_, int mode_) { nunits = nunits_; nM = nM_; G = G_; c = c_; mode = mode_; }
    __device__ bool next(int i, pg8::Unit& u) const { const int L = i * G + c; if (L >= nunits) return false; if (mode == 0) { u.pm = L % nM; u.pn = L / nM; } else if (mode == 1) { u.pm = 0; u.pn = 0; } else { u.pm = L % nM; u.pn = 0; } return true; }
    __device__ __forceinline__ void a_ready(const pg8::Unit&) const {}
    __device__ __forceinline__ void done(const pg8::Unit&) const {}
    __device__ __forceinline__ const char* aptr(const pg8::Gemm& g, const pg8::Unit& u, size_t tstep) const { return (const char*)g.A + (size_t)u.pm * tstep; }
    __device__ __forceinline__ const char* bptr(const pg8::Gemm& g, const pg8::Unit& u, size_t tstep) const { return (const char*)g.Bt + (size_t)u.pn * tstep; }
};
__device__ __forceinline__ void phase_final(const Frame& F, const Args& A) {
    const int gw = F.vcu * NWAVES + F.wave, NGW = F.G * NWAVES;
    const float* MOD1 = (const float*)(A.ws + WS_MOD) + 9 * 6144;
    const bf16* XRES = (const bf16*)(A.ws + WS_XRES); const bf16* Y = (const bf16*)(A.ws + WS_XG); const int* SLOT = (const int*)(A.ws + WS_SLOT);
    f32x4 fg[4];
#pragma unroll
    for (int j = 0; j < 4; ++j) fg[j] = ((const f32x4*)A.in[29])[F.lane + 64 * j];
    const int rpw = (MLAT + NGW - 1) / NGW;
    const int mbeg = gw * rpw, cnt = (MLAT - mbeg) < rpw ? (MLAT - mbeg) : rpw;
    for (int r = 0; r < cnt; r += 2) {
        f32x4 vv[2][4]; CombineIn ci[2];
#pragma unroll
        for (int t = 0; t < 2; ++t) { const int m = mbeg + ((r + t < cnt) ? r + t : r); combine_issue(ci[t], XRES + (size_t)m * D, SLOT + (size_t)m * 16, F.lane); }
#pragma unroll
        for (int t = 0; t < 2; ++t) { const int m = mbeg + ((r + t < cnt) ? r + t : r);
            combine_finish(vv[t], ci[t], Y, (const float*)(A.ws + WS_GW), MOD1 + (size_t)(m >> 12) * 6144 + 5 * 1024, F.lane); }
#pragma unroll
        for (int t = 0; t < 2; ++t) { const int m = mbeg + r + t; const float rstd = row_rstd(vv[t]);
            if (r + t < cnt) {
#pragma unroll
                for (int j = 0; j < 4; ++j) ((f32x4*)(A.out + (size_t)m * D))[F.lane + 64 * j] = vv[t][j] * rstd * fg[j]; } }
    }
}

#ifndef MK_ONE_LAUNCH
#define MK_ONE_LAUNCH 1
#endif
__global__ void __launch_bounds__(NWAVES * 64, 2) fwd_kernel(Args args) {
    extern __shared__ __attribute__((aligned(16))) unsigned char lds[];
    Frame F;
    F.lds = (LAS unsigned char*)lds;
    F.MISC = (volatile LAS unsigned*)(F.lds + MISC_OFF);
    F.tid = threadIdx.x; F.lane = F.tid & 63; F.wave = __builtin_amdgcn_readfirstlane(F.tid >> 6);
    F.G = gridDim.x; { const int bx = blockIdx.x; F.vcu = (F.G % 8 == 0) ? (bx % 8) * (F.G / 8) + bx / 8 : bx; }
    unsigned char* ws = args.ws;
    gu32* ctl = (gu32*)(ws + WS_CTL);
    for (int u = F.tid; u < (LDS_BYTES - LDSCTL_OFF) / 4; u += NWAVES * 64) ((LAS unsigned*)(F.lds + LDSCTL_OFF))[u] = 0u;
    __syncthreads();
    XcdBarrier bar; bar.bar = (unsigned*)(ctl + CW_BAR); bar.x = 0; bar.st = nullptr;
    const int lo = args.ph_lo, hi = args.ph_hi;
    if (hi - lo > 1) bar = xcd_barrier_post((unsigned*)(ctl + CW_BAR), F.MISC + 8);
#ifndef PROBE_REP
#define PROBE_REP 0u
#endif
#define IN(k) (lo <= (k) && (k) < hi)
#define SEAM(k) do { if (IN(k) && IN((k) + 1)) xcd_barrier(bar); } while (0)

    const float* MOD0 = (const float*)(ws + WS_MOD); const float* MOD1 = MOD0 + 9 * 6144;
    bf16* XRES = (bf16*)(ws + WS_XRES);

    if (IN(0)) { phase_prologue(F, args); } SEAM(0);
    if (IN(1)) { phase_modnorm0(F, args); } SEAM(1);
    if (IN(2)) {
        pg8::Gemm g{(const pg8::bf16_t*)(ws + WS_H), (const pg8::bf16_t*)(ws + WS_WQKV), MTOT, NQKV, D}; QKVOrder S; S.init(F.G, (int)blockIdx.x);
        EpiQKV E{(bf16*)(ws + WS_Q), (bf16*)(ws + WS_K), (bf16*)(ws + WS_V), (const float*)(ws + WS_ROPE), (const float*)(ws + WS_ROPE) + 1024, QSCALE};
        pg8::gemm_phase<EpiQKV, QKVOrder, true, true>(F.lds, g, S, E);
        if (F.G == 256) { const int lid = (int)blockIdx.x / 8, x = (int)blockIdx.x % 8;
            if (lid >= 6) tr_moe_items(F, args.in[12], args.in[13], args.in[14], ws + WS_WGU, ws + WS_WD, L0_PRO, L0_PRO + L0_QKV, (x * 26 + lid - 6) * NWAVES + F.wave, 208 * NWAVES); }
        else tr_moe_items(F, args.in[12], args.in[13], args.in[14], ws + WS_WGU, ws + WS_WD, L0_PRO, L0_PRO + L0_QKV, F.vcu * NWAVES + F.wave, F.G * NWAVES);
    } SEAM(2);
    if (IN(3)) { phase_attn_v2(F, args); } SEAM(3);
    if (IN(4)) {
        pg8::Gemm g{(const pg8::bf16_t*)(ws + WS_ATT), (const pg8::bf16_t*)(ws + WS_WO0), MTOT, D, D}; pg8::StaticOrder S; S.init(MTOT, D, F.G, (int)blockIdx.x);
        EpiResid<false> E{args.in[0], args.in[2], XRES, MOD0 + 2 * 1024};
        pg8::gemm_phase<EpiResid<false>, pg8::StaticOrder, true, true>(F.lds, g, S, E);
        if (F.G == 256) { if (blockIdx.x >= 32) tr_moe_items(F, args.in[12], args.in[13], args.in[14], ws + WS_WGU, ws + WS_WD, L0_PRO + L0_QKV, L0_PRO + L0_QKV + L0_WO, ((int)blockIdx.x - 32) * NWAVES + F.wave, 224 * NWAVES); }
        else tr_moe_items(F, args.in[12], args.in[13], args.in[14], ws + WS_WGU, ws + WS_WD, L0_PRO + L0_QKV, L0_PRO + L0_QKV + L0_WO, F.vcu * NWAVES + F.wave, F.G * NWAVES);
    } SEAM(4);
    if (IN(5)) { phase_norm_router(F, args, XRES, MTOT, args.in[10], MOD0, args.in[11]); } SEAM(5);
    if (IN(6)) { phase_topk(F, args, true, EROWS0, args.in[12], args.in[13], args.in[14], ws + WS_WGU, ws + WS_WD, IT_MOE - L0_TOPK, IT_MOE); } SEAM(6);
    if (IN(7)) {
        pg8::Gemm g{(const pg8::bf16_t*)(ws + WS_XG), (const pg8::bf16_t*)(ws + WS_WGU), NE * EROWS0, NE * 4096, D / 2}; GroupOrder<EROWS0 / 256, 16> S; S.init(F.G, (int)blockIdx.x);
        EpiSwiGLU E{ws + WS_HID};
        pg8::gemm_phase<EpiSwiGLU, decltype(S), true, true, true>(F.lds, g, S, E);
    } SEAM(7);
    if (IN(8)) {
        pg8::Gemm g{(const pg8::bf16_t*)(ws + WS_HID), (const pg8::bf16_t*)(ws + WS_WD), NE * EROWS0, NE * 1024, FF / 2}; GroupOrder<EROWS0 / 256, 4> S; S.init(F.G, (int)blockIdx.x);
        EpiY E{(bf16*)(ws + WS_XG)};
        pg8::gemm_phase<EpiY, decltype(S), true, true, true>(F.lds, g, S, E);
        if (F.G == 256) { const int lid = (int)blockIdx.x / 8, x = (int)blockIdx.x % 8;
            if (lid >= 8) tr_moe_items(F, args.in[26], args.in[27], args.in[28], ws + WS_WGU1, ws + WS_WD1, L1_ATT, L1_ATT + L1_G2, (x * 24 + lid - 8) * NWAVES + F.wave, 192 * NWAVES); }
        else tr_moe_items(F, args.in[26], args.in[27], args.in[28], ws + WS_WGU1, ws + WS_WD1, L1_ATT, L1_ATT + L1_G2, F.vcu * NWAVES + F.wave, F.G * NWAVES);
    } SEAM(8);
    if (IN(9)) { phase_combine0(F, args); } SEAM(9);
    if (IN(10)) {
        pg8::Gemm g{(const pg8::bf16_t*)(ws + WS_H), (const pg8::bf16_t*)(ws + WS_WIN), MTOT, NWIN, D}; pg8::StaticOrder S; S.init(MTOT, NWIN, F.G, (int)blockIdx.x);
        EpiP E{(bf16*)(ws + WS_PQKV), (bf16*)(ws + WS_Z)};
        pg8::gemm_phase<EpiP, pg8::StaticOrder, true, true>(F.lds, g, S, E);
        if (F.G == 256) { if (blockIdx.x >= 128) tr_moe_items(F, args.in[26], args.in[27], args.in[28], ws + WS_WGU1, ws + WS_WD1, L1_ATT + L1_G2, L1_ATT + L1_G2 + L1_WIN, ((int)blockIdx.x - 128) * NWAVES + F.wave, 128 * NWAVES); }
        else tr_moe_items(F, args.in[26], args.in[27], args.in[28], ws + WS_WGU1, ws + WS_WD1, L1_ATT + L1_G2, L1_ATT + L1_G2 + L1_WIN, F.vcu * NWAVES + F.wave, F.G * NWAVES);
    } SEAM(10);
    if (IN(11)) { phase_conv(F, args); } SEAM(11);
    if (IN(12)) { phase_gdn_prep(F, args); } SEAM(12);
    if (IN(13)) { phase_gdn_scan(F, args); } SEAM(13);
    if (IN(14)) { phase_readout(F, args); } SEAM(14);
    if (IN(15)) {
        pg8::Gemm g{(const pg8::bf16_t*)(ws + WS_RO), (const pg8::bf16_t*)(ws + WS_WO1), MLAT, D, D}; pg8::StaticOrder S; S.init(MLAT, D, F.G, (int)blockIdx.x);
        EpiResid<true> E{XRES, XRES + (size_t)MLAT * D, XRES, MOD1 + 2 * 1024};
        pg8::gemm_phase<EpiResid<true>, pg8::StaticOrder, true, true>(F.lds, g, S, E);
    } SEAM(15);
    if (IN(16)) { phase_norm_router(F, args, XRES, MLAT, args.in[24], MOD1, args.in[25]); } SEAM(16);
    if (IN(17)) { phase_topk(F, args, false, EROWS1, args.in[26], args.in[27], args.in[28], ws + WS_WGU1, ws + WS_WD1, IT_MOE - L1_TOPK, IT_MOE); } SEAM(17);
    if (IN(18)) {
        pg8::Gemm g{(const pg8::bf16_t*)(ws + WS_XG), (const pg8::bf16_t*)(ws + WS_WGU1), NE * EROWS1, NE * 4096, D / 2}; GroupOrder<EROWS1 / 256, 16> S; S.init(F.G, (int)blockIdx.x);
        EpiSwiGLU E{ws + WS_HID};
        pg8::gemm_phase<EpiSwiGLU, decltype(S), true, true, true>(F.lds, g, S, E);
    } SEAM(18);
    if (IN(19)) {
        pg8::Gemm g{(const pg8::bf16_t*)(ws + WS_HID), (const pg8::bf16_t*)(ws + WS_WD1), NE * EROWS1, NE * 1024, FF / 2}; GroupOrder<EROWS1 / 256, 4> S; S.init(F.G, (int)blockIdx.x);
        EpiY E{(bf16*)(ws + WS_XG)};
        pg8::gemm_phase<EpiY, decltype(S), true, true, true>(F.lds, g, S, E);
    } SEAM(19);
    if (IN(20)) { phase_final(F, args); }
#ifdef PROBE_GEMM
    if (IN(21)) {
        EpiNull E{(float*)(ws + 960 * MiB)};
#if PROBE_GEMM == 1 || PROBE_GEMM == 2 || PROBE_GEMM == 7
        { pg8::Gemm g{(const pg8::bf16_t*)(ws + WS_H), (const pg8::bf16_t*)(ws + WS_WIN), MTOT, NWIN, D}; ProbeOrder S; S.init(2176, 136, F.G, (int)blockIdx.x, PROBE_GEMM == 1 ? 0 : (PROBE_GEMM == 2 ? 1 : 2));
          pg8::gemm_phase<EpiNull, ProbeOrder, true, true>(F.lds, g, S, E); }
#elif PROBE_GEMM == 8 || PROBE_GEMM == 9
        { pg8::Gemm g{(const pg8::bf16_t*)(ws + WS_H), (const pg8::bf16_t*)(ws + WS_WIN), MTOT, NWIN, PROBE_GEMM == 8 ? 512 : 256}; ProbeOrder S; S.init(2176, 136, F.G, (int)blockIdx.x, 1);
          pg8::gemm_phase<EpiNull, ProbeOrder, true, true>(F.lds, g, S, E); }
#elif PROBE_GEMM == 10 || PROBE_GEMM == 11
        { pg8::Gemm g{(const pg8::bf16_t*)(ws + WS_XG), (const pg8::bf16_t*)(ws + WS_WGU), NE * EROWS0, NE * 4096, PROBE_GEMM == 10 ? 256 : 1024}; ProbeOrder S; S.init(4352, 272, F.G, (int)blockIdx.x, 1);
          pg8::gemm_phase<EpiNull, ProbeOrder, true, true, true>(F.lds, g, S, E); }
#elif PROBE_GEMM == 3 || PROBE_GEMM == 4
        { pg8::Gemm g{(const pg8::bf16_t*)(ws + WS_HID), (const pg8::bf16_t*)(ws + WS_WD), NE * EROWS0, NE * 1024, FF / 2}; ProbeOrder S; S.init(1088, 272, F.G, (int)blockIdx.x, PROBE_GEMM == 3 ? 0 : 1);
          pg8::gemm_phase<EpiNull, ProbeOrder, true, true, true>(F.lds, g, S, E); }
#elif PROBE_GEMM == 5 || PROBE_GEMM == 6
        { pg8::Gemm g{(const pg8::bf16_t*)(ws + WS_XG), (const pg8::bf16_t*)(ws + WS_WGU), NE * EROWS0, NE * 4096, D / 2}; ProbeOrder S; S.init(4352, 272, F.G, (int)blockIdx.x, PROBE_GEMM == 5 ? 0 : 1);
          pg8::gemm_phase<EpiNull, ProbeOrder, true, true, true>(F.lds, g, S, E); }
#endif
    }
#endif
#undef IN
#undef SEAM
}

extern "C" void kernel_launch(void* const* d_in, const int* in_sizes, int n_in, void* d_out, int out_size, void* d_ws, size_t ws_size, hipStream_t stream) {
    static int grid = 0;
    if (grid == 0) {
        if (n_in != 30 || in_sizes[0] != MLAT * D || out_size != MLAT * D || ws_size < WS_END) { fprintf(stderr, "kernel_launch: unexpected shapes (n_in %d, in0 %d, out %d, ws %zu); nothing launched\n", n_in, n_in > 0 ? in_sizes[0] : -1, out_size, ws_size); grid = -1; return; }
        int dev = 0, cus = 0, per_cu = 0;
        if (hipGetDevice(&dev) != hipSuccess || hipDeviceGetAttribute(&cus, hipDeviceAttributeMultiprocessorCount, dev) != hipSuccess) { grid = -1; return; }
        if (hipFuncSetAttribute((const void*)fwd_kernel, hipFuncAttributeMaxDynamicSharedMemorySize, LDS_BYTES) != hipSuccess) { fprintf(stderr, "kernel_launch: hipFuncSetAttribute failed\n"); grid = -1; return; }
        if (hipOccupancyMaxActiveBlocksPerMultiprocessor(&per_cu, (const void*)fwd_kernel, NWAVES * 64, LDS_BYTES) != hipSuccess || per_cu < 1) { fprintf(stderr, "kernel_launch: occupancy query says %d blocks per CU\n", per_cu); }
        (void)hipGetLastError();
        grid = cus;
        if (grid % 8 != 0) { fprintf(stderr, "kernel_launch: CU count %d is not a multiple of 8\n", grid); grid = -1; return; }
    }
    if (grid < 0) return;
    if (hipMemsetAsync((char*)d_ws + WS_CTL, 0, CTL_ZERO_BYTES, stream) != hipSuccess) return;
    Args a{};
    for (int i = 0; i < 30; ++i) a.in[i] = (const float*)d_in[i];
    a.out = (float*)d_out; a.ws = (unsigned char*)d_ws;
#if MK_ONE_LAUNCH
    a.ph_lo = 0; a.ph_hi = NPH;
    hipLaunchKernelGGL(fwd_kernel, dim3(grid), dim3(NWAVES * 64), LDS_BYTES, stream, a);
#else
#ifdef PROBE_GEMM
    const int nph_launch = NPH + 1;
#else
    const int nph_launch = NPH;
#endif
    for (int p = 0; p < nph_launch; ++p) for (int rep = 0; rep < (((PROBE_REP >> p) & 1u) ? 2 : 1); ++rep) { a.ph_lo = p; a.ph_hi = p + 1; hipLaunchKernelGGL(fwd_kernel, dim3(grid), dim3(NWAVES * 64), LDS_BYTES, stream, a); }
#endif
}
```

```cpp
#include <hip/hip_runtime.h>
#include <cstdio>
#include <cstdint>
#define MK_ONE_LAUNCH 1
namespace pg8 {
#define PG8_LAS __attribute__((address_space(3)))
typedef unsigned short bf16_t;
typedef short bf16x8 __attribute__((ext_vector_type(8)));
typedef float f32x4 __attribute__((ext_vector_type(4)));
typedef unsigned u32x4 __attribute__((ext_vector_type(4)));
constexpr int BM = 256, BK = 64, HALF = 128, HTB = HALF * BK * 2  , STAGE_BYTES = 8 * HTB, NXCD = 8, WGM = 8;

__host__ __device__ __forceinline__ int lds_byte(int r, int c) { const int st = (r >> 4) * 2 + (c >> 5), rr = r & 15, cc = c & 31, ob = rr * 64 + cc * 2; return st * 1024 + (ob ^ (((ob >> 9) & 1) << 5)); }
__host__ __device__ __forceinline__ void stage_rc(int b, int& R, int& C) { const int st = b / 1024, sb = b % 1024, swz = sb ^ (((sb >> 9) & 1) << 5); R = (st >> 1) * 16 + swz / 64; C = (st & 1) * 32 + (swz % 64) / 2; }
__host__ __device__ __forceinline__ int perm32(int rho) { const int n = rho >> 4, i = rho & 15; return 8 * (i >> 2) + 4 * n + (i & 3); }

struct Unit { int pm, pn; };
struct Gemm { const bf16_t* A; const bf16_t* Bt; int M, N, K; };

struct StaticOrder {
    int nM, nN, nwg, G, c;
    __host__ __device__ void init(int M, int N, int G_, int c_) { nM = M / BM; nN = N / BM; nwg = nM * nN; G = G_; c = c_; }
    __host__ __device__ bool next(int i, Unit& u) const {
        const long L = (long)i * G + c; if (L >= nwg) return false;
        int wgid = (int)L; { const int q = nwg / NXCD, r = nwg % NXCD, xcd = wgid % NXCD, off = wgid / NXCD; wgid = (xcd < r ? xcd * (q + 1) : r * (q + 1) + (xcd - r) * q) + off; }
        const int nig = WGM * nN, gid = wgid / nig, fm = gid * WGM, gsz = (nM - fm) < WGM ? (nM - fm) : WGM;
        u.pm = fm + ((wgid % nig) % gsz); u.pn = (wgid % nig) / gsz; return true;
    }
    __device__ __forceinline__ void a_ready(const Unit&) const {}
    __device__ __forceinline__ void done(const Unit&) const {}
    __device__ __forceinline__ const char* aptr(const Gemm& g, const Unit& u, size_t tstep) const { return (const char*)g.A + (size_t)u.pm * tstep; }
    __device__ __forceinline__ const char* bptr(const Gemm& g, const Unit& u, size_t tstep) const { return (const char*)g.Bt + (size_t)u.pn * tstep; }
};

__device__ __forceinline__ unsigned cvt_pk_bf16(float lo, float hi) { unsigned r; asm volatile("v_cvt_pk_bf16_f32 %0, %1, %2" : "=v"(r) : "v"(lo), "v"(hi)); return r; }
typedef int v8i32 __attribute__((ext_vector_type(8)));
__device__ __forceinline__ v8i32 ld8(const PG8_LAS unsigned char* p) { typedef int v4i __attribute__((ext_vector_type(4))); const v4i x = *(const PG8_LAS v4i*)p, y = *(const PG8_LAS v4i*)(p + 1024); return (v8i32){x[0], x[1], x[2], x[3], y[0], y[1], y[2], y[3]}; }
__device__ __forceinline__ void mfma8(f32x4& acc, const v8i32& a, const v8i32& b, int sc) { asm volatile("v_mfma_scale_f32_16x16x128_f8f6f4 %0, %1, %2, %0, %3, %3 op_sel_hi:[0,0,0]" : "+v"(acc) : "v"(a), "v"(b), "v"(sc)); }
template <class Epi, class Sched, bool ALIGN_EPI = false, bool SP2 = false, bool FP8 = false>
__device__ __forceinline__ void gemm_phase(PG8_LAS unsigned char* lds, const Gemm g, const Sched& S, const Epi& E) {
    const int tid = threadIdx.x, wid = __builtin_amdgcn_readfirstlane(tid >> 6), lane = tid & 63, wr = wid >> 2, wc = wid & 3, fr = lane & 15, fq = lane >> 4;
    const int K = g.K, nt = K / BK;
    unsigned voffA[2], voffB[2];
#pragma unroll
    for (int i = 0; i < 2; ++i) { int R, C; stage_rc(tid * 16 + i * 8192, R, C); const int Rb = Epi::PERM ? ((R & ~31) + perm32(R & 31)) : R;
        voffA[i] = (unsigned)(R * K + C) * 2u; voffB[i] = (unsigned)(Rb * K + C) * 2u; }
    const size_t kstep = (size_t)(BK * 2);
    const size_t hstep = (size_t)HALF * K * 2;
    const size_t tstep = 2 * hstep;
    const unsigned ldsw = (unsigned)wid * 1024u;
    const int aoff = lds_byte(wr * 64 + fr, fq * 8), boff = lds_byte(wc * 32 + fr, fq * 8);
#define PG8_SA(b, h) (((b) * 2 + (h)) * HTB)
#define PG8_SB(b, h) ((4 + (b) * 2 + (h)) * HTB)
#define PG8_STAGE(bufoff, gbase, voff) do { _Pragma("unroll") for (int _i = 0; _i < 2; ++_i) \
        __builtin_amdgcn_global_load_lds((const unsigned*)((const char*)(gbase) + (voff)[_i]), (PG8_LAS unsigned*)(lds + (bufoff) + ldsw + _i * 8192), 16, 0, 0); } while (0)
#define PG8_LDA(dst, b, h) do { if constexpr (FP8) { _Pragma("unroll") for (int m = 0; m < 4; ++m) dst##8[m] = ld8(lds + PG8_SA(b, h) + aoff + m * 2048); } else { \
        _Pragma("unroll") for (int m = 0; m < 4; ++m) _Pragma("unroll") for (int k = 0; k < 2; ++k) dst[m][k] = *(const PG8_LAS bf16x8*)(lds + PG8_SA(b, h) + aoff + m * 2048 + k * 1024); } } while (0)
#define PG8_LDB(dst, b, h) do { if constexpr (FP8) { _Pragma("unroll") for (int n = 0; n < 2; ++n) dst##8[n] = ld8(lds + PG8_SB(b, h) + boff + n * 2048); } else { \
        _Pragma("unroll") for (int n = 0; n < 2; ++n) _Pragma("unroll") for (int k = 0; k < 2; ++k) dst[n][k] = *(const PG8_LAS bf16x8*)(lds + PG8_SB(b, h) + boff + n * 2048 + k * 1024); } } while (0)
#define PG8_MMA(ai, bj, At, Bt) do { if constexpr (FP8) __builtin_amdgcn_sched_barrier(0); __builtin_amdgcn_s_setprio(1); if constexpr (FP8) { _Pragma("unroll") for (int m = 0; m < 4; ++m) _Pragma("unroll") for (int n = 0; n < 2; ++n) \
        mfma8(acc[ai][bj][m][n], Bt##8[n], At##8[m], sc8); } else { \
        _Pragma("unroll") for (int m = 0; m < 4; ++m) _Pragma("unroll") for (int n = 0; n < 2; ++n) _Pragma("unroll") for (int k = 0; k < 2; ++k) \
        acc[ai][bj][m][n] = __builtin_amdgcn_mfma_f32_16x16x32_bf16(Bt[n][k], At[m][k], acc[ai][bj][m][n], 0, 0, 0); } __builtin_amdgcn_s_setprio(0); if constexpr (FP8) __builtin_amdgcn_sched_barrier(0); } while (0)
#define PG8_WAIT_V(n) asm volatile("s_waitcnt vmcnt(" #n ")" ::: "memory")
#define PG8_WAIT_L(n) asm volatile("s_waitcnt lgkmcnt(" #n ")" ::: "memory")
#define PG8_BAR __builtin_amdgcn_s_barrier()
#define PG8_SCHED __builtin_amdgcn_sched_barrier(0)
    Unit cur, nxt; int ui = 0;
    if (!S.next(0, cur)) return;
    f32x4 acc[2][2][4][2];
#pragma unroll
    for (int a = 0; a < 2; ++a)
#pragma unroll
        for (int b = 0; b < 2; ++b)
#pragma unroll
            for (int m = 0; m < 4; ++m)
#pragma unroll
                for (int n = 0; n < 2; ++n) acc[a][b][m][n] = (f32x4){0.f, 0.f, 0.f, 0.f};
    bf16x8 At[4][2], B0[2][2], B1[2][2]; v8i32 At8[4], B08[2], B18[2]; int sc8 = 0x7f7f7f7f; asm volatile("" : "+v"(sc8));
    const char* cA = S.aptr(g, cur, tstep); const char* cB = S.bptr(g, cur, tstep);
    S.a_ready(cur);
    if constexpr (SP2) {
        PG8_STAGE(PG8_SB(0, 0), cB, voffB); PG8_STAGE(PG8_SB(0, 1), cB + hstep, voffB); PG8_STAGE(PG8_SA(0, 0), cA, voffA); PG8_STAGE(PG8_SA(0, 1), cA + hstep, voffA);
        if (wr == 1) PG8_BAR;
        PG8_WAIT_V(2); PG8_BAR;
        PG8_STAGE(PG8_SB(1, 0), cB + kstep, voffB); PG8_STAGE(PG8_SA(1, 0), cA + kstep, voffA); PG8_STAGE(PG8_SB(1, 1), cB + hstep + kstep, voffB);
        PG8_WAIT_V(6); PG8_BAR;
    } else {
        PG8_STAGE(PG8_SB(0, 0), cB, voffB); PG8_STAGE(PG8_SA(0, 0), cA, voffA); PG8_STAGE(PG8_SB(0, 1), cB + hstep, voffB); PG8_STAGE(PG8_SA(0, 1), cA + hstep, voffA);
        if (wr == 1) PG8_BAR;
        PG8_WAIT_V(4); PG8_BAR;
        PG8_STAGE(PG8_SB(1, 0), cB + kstep, voffB); PG8_STAGE(PG8_SA(1, 0), cA + kstep, voffA); PG8_STAGE(PG8_SB(1, 1), cB + hstep + kstep, voffB);
        PG8_WAIT_V(6); PG8_BAR;
    }
    for (;;) {
        const bool has_next = S.next(ui + 1, nxt);
        const char* nA = has_next ? S.aptr(g, nxt, tstep) : cA; const char* nB = has_next ? S.bptr(g, nxt, tstep) : cB;
#pragma unroll 1
        for (int t = 0; t < nt; t += 2) {
            const bool last = (t == nt - 2);
            const char* a1 = cA + (size_t)(t + 1) * kstep;
            const char* a2 = last ? nA : cA + (size_t)(t + 2) * kstep; const char* b2 = last ? nB : cB + (size_t)(t + 2) * kstep;
            const char* a3 = a2 + kstep; const char* b3 = b2 + kstep;
            if (last && has_next) S.a_ready(nxt);
            if constexpr (SP2) {
            PG8_LDB(B0, 0, 0); PG8_LDB(B1, 0, 1); PG8_SCHED; PG8_LDA(At, 0, 0); PG8_STAGE(PG8_SA(1, 1), a1 + hstep, voffA);
            PG8_WAIT_V(8); PG8_WAIT_L(0); PG8_BAR; PG8_MMA(0, 0, At, B0); PG8_MMA(0, 1, At, B1); PG8_BAR; PG8_SCHED;
            PG8_LDA(At, 0, 1); PG8_STAGE(PG8_SB(0, 0), b2, voffB); PG8_STAGE(PG8_SB(0, 1), b2 + hstep, voffB); PG8_STAGE(PG8_SA(0, 0), a2, voffA);
            PG8_WAIT_V(8); PG8_WAIT_L(0); PG8_BAR; PG8_MMA(1, 0, At, B0); PG8_MMA(1, 1, At, B1); PG8_BAR; PG8_SCHED;
            PG8_LDB(B0, 1, 0); PG8_LDB(B1, 1, 1); PG8_SCHED; PG8_LDA(At, 1, 0); PG8_STAGE(PG8_SA(0, 1), a2 + hstep, voffA);
            PG8_WAIT_V(8); PG8_WAIT_L(0); PG8_BAR; PG8_MMA(0, 0, At, B0); PG8_MMA(0, 1, At, B1); PG8_BAR; PG8_SCHED;
            PG8_LDA(At, 1, 1); PG8_STAGE(PG8_SB(1, 0), b3, voffB); PG8_STAGE(PG8_SB(1, 1), b3 + hstep, voffB); PG8_STAGE(PG8_SA(1, 0), a3, voffA);
            PG8_WAIT_V(8); PG8_WAIT_L(0); PG8_BAR; PG8_MMA(1, 0, At, B0); PG8_MMA(1, 1, At, B1); PG8_BAR; PG8_SCHED;
            } else {
            PG8_LDB(B0, 0, 0); PG8_SCHED; PG8_LDA(At, 0, 0); PG8_STAGE(PG8_SA(1, 1), a1 + hstep, voffA);
            PG8_WAIT_L(8); PG8_BAR; PG8_WAIT_L(0); PG8_MMA(0, 0, At, B0); PG8_BAR; PG8_SCHED;
            PG8_LDB(B1, 0, 1); PG8_STAGE(PG8_SB(0, 0), b2, voffB);
            PG8_BAR; PG8_WAIT_L(0); PG8_MMA(0, 1, At, B1); PG8_BAR;
            PG8_LDA(At, 0, 1); PG8_STAGE(PG8_SA(0, 0), a2, voffA);
            PG8_BAR; PG8_WAIT_L(0); PG8_MMA(1, 0, At, B0); PG8_BAR; PG8_SCHED;
            PG8_STAGE(PG8_SB(0, 1), b2 + hstep, voffB);
            PG8_WAIT_V(6); PG8_BAR; PG8_MMA(1, 1, At, B1); PG8_BAR;
            PG8_LDB(B0, 1, 0); PG8_SCHED; PG8_LDA(At, 1, 0); PG8_STAGE(PG8_SA(0, 1), a2 + hstep, voffA);
            PG8_WAIT_L(8); PG8_BAR; PG8_WAIT_L(0); PG8_MMA(0, 0, At, B0); PG8_BAR; PG8_SCHED;
            PG8_LDB(B1, 1, 1); PG8_STAGE(PG8_SB(1, 0), b3, voffB);
            PG8_BAR; PG8_WAIT_L(0); PG8_MMA(0, 1, At, B1); PG8_BAR;
            PG8_LDA(At, 1, 1); PG8_STAGE(PG8_SA(1, 0), a3, voffA);
            PG8_BAR; PG8_WAIT_L(0); PG8_MMA(1, 0, At, B0); PG8_BAR; PG8_SCHED;
            PG8_STAGE(PG8_SB(1, 1), b3 + hstep, voffB);
            PG8_WAIT_V(6); PG8_BAR; PG8_MMA(1, 1, At, B1); PG8_BAR;
            }
        }
        if constexpr (FP8) asm volatile("s_nop 15\n\ts_nop 15" ::: "memory");
        if constexpr (ALIGN_EPI) { if (wr == 0) PG8_BAR; }
        if constexpr (!Epi::AFTER_DRAIN) { E(acc, cur, wr, wc, fr, fq); S.done(cur); }
        if (!has_next) break;
#pragma unroll
        for (int a = 0; a < 2; ++a)
#pragma unroll
            for (int b = 0; b < 2; ++b)
#pragma unroll
                for (int m = 0; m < 4; ++m)
#pragma unroll
                    for (int n = 0; n < 2; ++n) acc[a][b][m][n] = (f32x4){0.f, 0.f, 0.f, 0.f};
        cur = nxt; cA = nA; cB = nB; ++ui;
        if constexpr (ALIGN_EPI) { if (wr == 1) PG8_BAR; }
    }
    PG8_WAIT_V(0);
    if constexpr (!ALIGN_EPI) { if (wr == 0) PG8_BAR; }
    PG8_BAR;
    if constexpr (Epi::AFTER_DRAIN) { E.fused(acc, cur, wr, wc, fr, fq, lds, wid, lane); S.done(cur); }
#undef PG8_SA
#undef PG8_SB
#undef PG8_STAGE
#undef PG8_LDA
#undef PG8_LDB
#undef PG8_MMA
#undef PG8_WAIT_V
#undef PG8_WAIT_L
#undef PG8_BAR
#undef PG8_SCHED
}
}

constexpr int D = 1024, NB = 8, SEQ = 4096, CTXL = 256;
constexpr int MLAT = NB * SEQ, MCTX = NB * CTXL, MTOT = MLAT + MCTX;
constexpr int NE = 16, FF = 2048, CAPL = 512, CAPC = 32;
constexpr int EROWS0 = NB * (CAPL + CAPC);
constexpr int EROWS1 = NB * CAPL;
constexpr int NQKV = 1536, NWIN = 4096, LDWIN = 4128;
constexpr float EPS = 1e-6f;
constexpr int NWAVES = 8, NTHR = 512;
constexpr int NPH = 21;

constexpr size_t MiB = 1u << 20;
constexpr size_t WS_CTL = 0, CTL_ZERO_BYTES = 1 * MiB;
constexpr size_t WS_MOD = 1 * MiB;
constexpr size_t WS_ROPE = 1 * MiB + 512 * 1024;
constexpr size_t WS_WQKV = 2 * MiB, WS_WO0 = 5 * MiB, WS_WIN = 7 * MiB, WS_WO1 = 15 * MiB;
constexpr size_t WS_WGU = 17 * MiB, WS_WD = 81 * MiB, WS_WGU1 = 113 * MiB, WS_WD1 = 177 * MiB;
constexpr size_t WS_XRES = 209 * MiB;
constexpr size_t WS_H = 345 * MiB;
constexpr size_t WS_H8 = WS_H;
constexpr size_t WS_AFF = 413 * MiB;
constexpr size_t WS_GW = 416 * MiB;
constexpr size_t WS_SLOT = 417 * MiB;
constexpr size_t WS_G = 420 * MiB, WS_BETA = 423 * MiB;
constexpr size_t WS_R = 427 * MiB;
constexpr size_t WS_Q = WS_R, WS_K = WS_R + 68 * MiB, WS_V = WS_R + 85 * MiB, WS_ATT = WS_R + 102 * MiB;
constexpr size_t WS_XG = WS_R, WS_HID = WS_R + 136 * MiB;
constexpr size_t WS_PQKV = WS_R, WS_Z = WS_R + 204 * MiB, WS_QN = WS_R + 272 * MiB, WS_KN = WS_R + 340 * MiB, WS_VV = WS_R + 408 * MiB;
constexpr size_t WS_TB = WS_R, WS_TG = WS_R + 68 * MiB, WS_QKD = WS_R + 136 * MiB, WS_GC = WS_AFF;
constexpr size_t WS_RO = WS_R;
constexpr size_t WS_END = WS_R + 476 * MiB;
constexpr int CW_BAR = 4096;

constexpr int RING_BYTES = 131072;
constexpr int LDSCTL_OFF = RING_BYTES, MISC_OFF = LDSCTL_OFF + 320;
constexpr int LDS_BYTES = 147456;

#define GAS __attribute__((address_space(1)))
#define LAS __attribute__((address_space(3)))
typedef unsigned short bf16;
typedef unsigned v4u __attribute__((ext_vector_type(4)));
typedef unsigned v2u __attribute__((ext_vector_type(2)));
typedef float f32x4 __attribute__((ext_vector_type(4)));
typedef short bf16x8 __attribute__((ext_vector_type(8)));
typedef GAS unsigned gu32;
typedef GAS unsigned long long gu64;
#define RLX_AGENT __ATOMIC_RELAXED, __HIP_MEMORY_SCOPE_AGENT
#define LDS_WAIT() asm volatile("s_waitcnt lgkmcnt(0)" ::: "memory")
#define VM_WAIT() asm volatile("s_waitcnt vmcnt(0)" ::: "memory")

#define XB_TMO      128
#define XB_XCNT(j)  (256  + 64 * (j))
#define XB_XSUB(j)  (1280 + 64 * (j))
#define XB_XGEN(j)  (2304 + 64 * (j))
#define XB_TOP      3328
#define XB_TOPGEN   3392
#define XCD_BAR_WORDS 3456
#define XB_SPIN_CAP (1u << 18)

__device__ __forceinline__ unsigned xb_ld(unsigned* p)              { return __hip_atomic_load(p, __ATOMIC_RELAXED, __HIP_MEMORY_SCOPE_AGENT); }
__device__ __forceinline__ unsigned xb_add(unsigned* p, unsigned v) { return __hip_atomic_fetch_add(p, v, __ATOMIC_RELAXED, __HIP_MEMORY_SCOPE_AGENT); }
__device__ __forceinline__ unsigned xb_xcc_id() { return (unsigned)__builtin_amdgcn_s_getreg((3 << 11) | 20) & 0xFu; }
#define XB_SPIN(cond, bar) do { unsigned _sp = 0; while (cond) { __builtin_amdgcn_s_sleep(1); \
    if ((++_sp & 255u) == 0u) { if (xb_ld(&(bar)[XB_TMO])) break; if (_sp > XB_SPIN_CAP) { atomicAdd(&(bar)[XB_TMO], 1u); break; } } } } while (0)

struct XcdBarrier {
    unsigned* bar; unsigned x;
    volatile LAS unsigned* st;
};

__device__ __forceinline__ XcdBarrier xcd_barrier_post(unsigned* bar, volatile LAS unsigned* st) {
    XcdBarrier b; b.bar = bar; b.x = xb_xcc_id(); b.st = st;
    if (threadIdx.x == 0) (void)xb_add(&bar[XB_XCNT(b.x)], 1u);
    return b;
}
__device__ __forceinline__ void xcd_barrier_complete(unsigned* bar, unsigned x, unsigned& nloc, unsigned& nx) {
    const unsigned G = gridDim.x * gridDim.y * gridDim.z;
    unsigned sum, cnt, mine, sp = 0u;
    for (;;) {
        sum = 0u; cnt = 0u; mine = 0u;
#pragma unroll
        for (unsigned j = 0; j < 16; ++j) { const unsigned c = xb_ld(&bar[XB_XCNT(j)]); sum += c; cnt += (c > 0u) ? 1u : 0u; mine = (j == x) ? c : mine; }
        if (sum == G) break;
        __builtin_amdgcn_s_sleep(1);
        if ((++sp & 255u) == 0u) { if (xb_ld(&bar[XB_TMO])) break; if (sp > XB_SPIN_CAP) { atomicAdd(&bar[XB_TMO], 1u); break; } }
    }
    nloc = mine > 0u ? mine : 1u; nx = cnt > 0u ? cnt : 1u;
}

__device__ __forceinline__ void xcd_barrier(const XcdBarrier& b) {
    asm volatile("s_waitcnt vmcnt(0)" ::: "memory");
    __syncthreads();
    if (threadIdx.x == 0) {
        unsigned* bar = b.bar;
        __builtin_amdgcn_s_waitcnt(0);
        unsigned nloc = b.st[0], nx = b.st[1];
        if (nloc == 0u) { xcd_barrier_complete(bar, b.x, nloc, nx); b.st[0] = nloc; b.st[1] = nx; }
        const unsigned old = xb_add(&bar[XB_XSUB(b.x)], 1u);
        const unsigned gen = old / nloc;
        if (old + 1u == (gen + 1u) * nloc) {
            __builtin_amdgcn_fence(__ATOMIC_RELEASE, "agent");
            asm volatile("s_waitcnt vmcnt(0)" ::: "memory");
            const unsigned og = xb_add(&bar[XB_TOP], 1u);
            const unsigned tg = og / nx;
            if (og + 1u == (tg + 1u) * nx) xb_add(&bar[XB_TOPGEN], 1u);
            else XB_SPIN(xb_ld(&bar[XB_TOPGEN]) == tg, bar);
            __builtin_amdgcn_fence(__ATOMIC_ACQUIRE, "agent");
            xb_add(&bar[XB_XGEN(b.x)], 1u);
            asm volatile("s_waitcnt vmcnt(0)" ::: "memory");
        } else {
            XB_SPIN(xb_ld(&bar[XB_XGEN(b.x)]) == gen, bar);
            __builtin_amdgcn_fence(__ATOMIC_ACQUIRE, "agent");
            asm volatile("s_waitcnt vmcnt(0)" ::: "memory");
        }
    }
    __syncthreads();
}

struct Args { const float* in[30]; float* out; unsigned char* ws; int ph_lo, ph_hi; };
struct Frame { LAS unsigned char* lds; volatile LAS unsigned* MISC; int tid, lane, wave, vcu, G; };

__device__ __forceinline__ float wave_sum(float v) {
#pragma unroll
    for (int o = 1; o < 64; o <<= 1) v += __shfl_xor(v, o);
    return v;
}
template <int N> __device__ __forceinline__ float fold_sum(float (&p)[N], int lane) {
    int o = 32;
#pragma unroll
    for (int n = N; n > 1; n >>= 1) { const unsigned um = (lane & o) ? 0xffffffffu : 0u;
#pragma unroll
        for (int k = 0; k < n / 2; ++k) { const unsigned a = __float_as_uint(p[k]), b = __float_as_uint(p[k + n / 2]);
            const float send = __uint_as_float((a & um) | (b & ~um)), keep = __uint_as_float((b & um) | (a & ~um)); p[k] = keep + __shfl_xor(send, o); }
        o >>= 1; }
    float v = p[0];
#pragma unroll
    for (int oo = 32; oo >= 1; oo >>= 1) if (oo <= o) v += __shfl_xor(v, oo);
    return v;
}
__device__ __forceinline__ float proj16(const f32x4 (&v)[4], const LAS float* w16, int lane) {
    float pj[16];
#pragma unroll
    for (int e = 0; e < 16; ++e) { float s = 0.f;
#pragma unroll
        for (int j = 0; j < 4; ++j) { const f32x4 w = ((const LAS f32x4*)(w16 + e * 1024))[lane + 64 * j]; s += (v[j].x * w.x + v[j].y * w.y) + (v[j].z * w.z + v[j].w * w.w); }
        pj[e] = s; }
    return fold_sum<16>(pj, lane);
}
template <int R> __device__ __forceinline__ void proj16xR(const f32x4 (&v)[R][4], const LAS float* w16, int lane, float (&out)[R]) {
    float p[R][16];
#pragma unroll
    for (int e = 0; e < 16; ++e) { float s[R];
#pragma unroll
        for (int t = 0; t < R; ++t) s[t] = 0.f;
#pragma unroll
        for (int j = 0; j < 4; ++j) { const f32x4 w = ((const LAS f32x4*)(w16 + e * 1024))[lane + 64 * j];
#pragma unroll
            for (int t = 0; t < R; ++t) s[t] += (v[t][j].x * w.x + v[t][j].y * w.y) + (v[t][j].z * w.z + v[t][j].w * w.w); }
#pragma unroll
        for (int t = 0; t < R; ++t) p[t][e] = s[t]; }
#pragma unroll
    for (int t = 0; t < R; ++t) out[t] = fold_sum<16>(p[t], lane);
}
__device__ __forceinline__ void proj16x2(const f32x4 (&v0)[4], const f32x4 (&v1)[4], const LAS float* w16, int lane, float& r0, float& r1) {
    float p0[16], p1[16];
#pragma unroll
    for (int e = 0; e < 16; ++e) { float s0 = 0.f, s1 = 0.f;
#pragma unroll
        for (int j = 0; j < 4; ++j) { const f32x4 w = ((const LAS f32x4*)(w16 + e * 1024))[lane + 64 * j];
            s0 += (v0[j].x * w.x + v0[j].y * w.y) + (v0[j].z * w.z + v0[j].w * w.w); s1 += (v1[j].x * w.x + v1[j].y * w.y) + (v1[j].z * w.z + v1[j].w * w.w); }
        p0[e] = s0; p1[e] = s1; }
    r0 = fold_sum<16>(p0, lane); r1 = fold_sum<16>(p1, lane);
}
__device__ __forceinline__ float bflo(unsigned w) { return __uint_as_float(w << 16); }
__device__ __forceinline__ float bfhi(unsigned w) { return __uint_as_float(w & 0xffff0000u); }
__device__ __forceinline__ unsigned pkbf(float lo, float hi) { return pg8::cvt_pk_bf16(lo, hi); }
__device__ __forceinline__ float silu_f(float x) { return x * __builtin_amdgcn_rcpf(1.f + __expf(-x)); }
__device__ __forceinline__ unsigned pk4f8(float a, float b, float c, float d) { int v = __builtin_amdgcn_cvt_pk_fp8_f32(a, b, 0, false); v = __builtin_amdgcn_cvt_pk_fp8_f32(c, d, v, true); return (unsigned)v; }
constexpr float W8S = 64.f, W8I = 1.f / 64.f;
__device__ __forceinline__ int modrow(int m) { return m < MLAT ? (m >> 12) : 8; }

__device__ __forceinline__ void tr_item(const float* W, size_t ldw, int k0, size_t srccol0, bool permq, bf16* WT, size_t K, size_t dstrow0, LAS float* scr, int lane) {
    const int nl = lane & 31;
    size_t col = srccol0 + nl;
    if (permq) { const int nd = (int)col; const int s = nd & 63, j = (s & 31) >> 1; col = (size_t)((nd - s) + (s & 32) + ((s & 1) ? 16 + j : j)); }
    float t[32];
#pragma unroll
    for (int i = 0; i < 32; ++i) t[i] = W[(size_t)(k0 + 2 * i + (lane >> 5)) * ldw + col];
#pragma unroll
    for (int i = 0; i < 32; ++i) scr[(2 * i + (lane >> 5)) * 33 + nl] = t[i];
    LDS_WAIT(); asm volatile("" ::: "memory");
    const int c = lane & 7;
#pragma unroll
    for (int j = 0; j < 4; ++j) { const int n = (lane >> 3) + 8 * j; const LAS float* s = scr + (8 * c) * 33 + n;
        v4u o; o.x = pkbf(s[0 * 33], s[1 * 33]); o.y = pkbf(s[2 * 33], s[3 * 33]); o.z = pkbf(s[4 * 33], s[5 * 33]); o.w = pkbf(s[6 * 33], s[7 * 33]);
        *(v4u*)(WT + (dstrow0 + n) * K + k0 + 8 * c) = o; }
    LDS_WAIT(); asm volatile("" ::: "memory");
}
__device__ __forceinline__ void tr_item8(const float* W, size_t ldw, int k0, size_t srccol0, unsigned char* WT, size_t K, size_t dstrow0, LAS float* scr, int lane) {
    const int nl = lane & 31; const size_t col = srccol0 + nl;
    float t[32];
#pragma unroll
    for (int i = 0; i < 32; ++i) t[i] = W[(size_t)(k0 + 2 * i + (lane >> 5)) * ldw + col];
#pragma unroll
    for (int i = 0; i < 32; ++i) scr[(2 * i + (lane >> 5)) * 33 + nl] = t[i] * W8S;
    LDS_WAIT(); asm volatile("" ::: "memory");
    const int c = lane & 7;
#pragma unroll
    for (int j = 0; j < 4; ++j) { const int n = (lane >> 3) + 8 * j; const LAS float* s = scr + (8 * c) * 33 + n;
        v2u o; o.x = pk4f8(s[0 * 33], s[1 * 33], s[2 * 33], s[3 * 33]); o.y = pk4f8(s[4 * 33], s[5 * 33], s[6 * 33], s[7 * 33]);
        *(v2u*)(WT + (dstrow0 + n) * K + k0 + 8 * c) = o; }
    LDS_WAIT(); asm volatile("" ::: "memory");
}
constexpr int IT_GU = 16 * 2048, IT_D = 16 * 1024, IT_MOE = IT_GU + IT_D;
__device__ __forceinline__ void tr_moe_items(const Frame& F, const float* wg, const float* wu, const float* wd, unsigned char* wgu, unsigned char* wdn, int lo, int hi, int widx, int nw) {
    LAS float* scr = (LAS float*)(F.lds + F.wave * 16384);
    for (int r = lo + widx; r < hi; r += nw) {
        if (r < IT_GU) { const int e = r >> 11, q = r & 2047, kb = q >> 7, nb = q & 127, n0 = nb * 32, pn = n0 >> 8, w = n0 & 255;
            const float* W = ((w < 128) ? wg : wu) + (size_t)e * 1024 * 2048;
            tr_item8(W, 2048, kb * 64, (size_t)(pn * 128 + (w & 127)), wgu, 1024, (size_t)e * 4096 + n0, scr, F.lane); }
        else { const int rr = r - IT_GU; const int e = rr >> 10, q = rr & 1023, kb = q >> 5, nb = q & 31, n0 = nb * 32;
            tr_item8(wd + (size_t)e * 2048 * 1024, 1024, kb * 64, (size_t)n0, wdn, 2048, (size_t)e * 1024 + n0, scr, F.lane); }
    }
}
constexpr int L0_QKV = 208 * 8 * 9, L0_WO = 224 * 8 * 9, L0_TOPK = 128 * 8 * 5, L0_PRO = IT_MOE - L0_QKV - L0_WO - L0_TOPK;
constexpr int L1_ATT = 128 * 8 * 4, L1_G2 = 192 * 8 * 10, L1_WIN = 128 * 8 * 8, L1_TOPK = 128 * 8 * 5, L1_PREP = 192 * 8 * 5, L1_CMB = IT_MOE - L1_ATT - L1_G2 - L1_WIN - L1_TOPK - L1_PREP;
__device__ __forceinline__ void phase_prologue(const Frame& F, const Args& A) {
    unsigned char* ws = A.ws;
    const int gw = F.vcu * NWAVES + F.wave, NGW = F.G * NWAVES;
    {
        LAS float* sl = (LAS float*)F.lds;
        LAS float* part = sl + 9 * 1024;
        float* MOD = (float*)(ws + WS_MOD);
        if (F.vcu < 192) {
            for (int idx = F.tid; idx < 9 * 1024; idx += NTHR) { const int r = idx >> 10, k = idx & 1023; const float v = r < 8 ? A.in[1][r * 1024 + k] : A.in[3][k]; sl[idx] = silu_f(v); }
        }
        __syncthreads();
        for (int u = F.vcu; u < 192; u += F.G) {
            const int layer = u / 96, cg = u % 96, col = cg * 64 + F.lane;
            const float* W = layer ? A.in[15] : A.in[4]; const float* bias = layer ? A.in[16] : A.in[5];
            float acc[9];
#pragma unroll
            for (int r = 0; r < 9; ++r) acc[r] = 0.f;
            const int k0 = F.wave * 128;
#pragma unroll 8
            for (int k = k0; k < k0 + 128; ++k) { const float w = W[(size_t)k * 6144 + col];
#pragma unroll
                for (int r = 0; r < 9; ++r) acc[r] += sl[r * 1024 + k] * w; }
#pragma unroll
            for (int r = 0; r < 9; ++r) part[(F.wave * 9 + r) * 64 + F.lane] = acc[r];
            __syncthreads();
            for (int idx = F.tid; idx < 576; idx += NTHR) { const int r = idx >> 6, l = idx & 63; float s = 0.f;
#pragma unroll
                for (int w = 0; w < 8; ++w) s += part[(w * 9 + r) * 64 + l];
                MOD[(size_t)(layer * 9 + r) * 6144 + cg * 64 + l] = s + bias[cg * 64 + l]; }
            __syncthreads();
        }
        if (F.vcu == F.G - 1) {
            float* rc = (float*)(ws + WS_ROPE); float* rs = rc + 1024;
            for (int idx = F.tid; idx < 1024; idx += NTHR) { const int pos = idx >> 4, j = idx & 15;
                const float inv = exp2f(-(float)j * (13.287712379549449f / 16.f));
                const float ang = (float)pos * inv; rc[idx] = cosf(ang); rs[idx] = sinf(ang); }
        }
        __syncthreads();
    }
    {
        LAS float* scr = (LAS float*)(F.lds + F.wave * 16384);
        constexpr int I_QKV = 16 * 48, I_WO = 16 * 32, I_WIN = 16 * 128;
        constexpr int NSMALL = I_QKV + 2 * I_WO + I_WIN;
        for (int it = gw; it < NSMALL; it += NGW) {
            int r = it;
            if (r < I_QKV) { const int kb = r / 48, nb = r % 48; tr_item(A.in[7], NQKV, kb * 64, (size_t)nb * 32, nb * 32 < 1280, (bf16*)(ws + WS_WQKV), 1024, (size_t)nb * 32, scr, F.lane); continue; } r -= I_QKV;
            if (r < I_WO) { const int kb = r >> 5, nb = r & 31; tr_item(A.in[9], 1024, kb * 64, (size_t)nb * 32, false, (bf16*)(ws + WS_WO0), 1024, (size_t)nb * 32, scr, F.lane); continue; } r -= I_WO;
            if (r < I_WIN) { const int kb = r >> 7, nb = r & 127; tr_item(A.in[18], LDWIN, kb * 64, (size_t)nb * 32, false, (bf16*)(ws + WS_WIN), 1024, (size_t)nb * 32, scr, F.lane); continue; } r -= I_WIN;
            { const int kb = r >> 5, nb = r & 31; tr_item(A.in[23], 1024, kb * 64, (size_t)nb * 32, false, (bf16*)(ws + WS_WO1), 1024, (size_t)nb * 32, scr, F.lane); }
        }
        constexpr int L0_NOADA = 64 * 8 * 6;
        if (F.G == 256) { if (F.vcu >= 192) tr_moe_items(F, A.in[12], A.in[13], A.in[14], ws + WS_WGU, ws + WS_WD, 0, L0_NOADA, (F.vcu - 192) * NWAVES + F.wave, 64 * NWAVES);
            tr_moe_items(F, A.in[12], A.in[13], A.in[14], ws + WS_WGU, ws + WS_WD, L0_NOADA, L0_PRO, gw, NGW); }
        else tr_moe_items(F, A.in[12], A.in[13], A.in[14], ws + WS_WGU, ws + WS_WD, 0, L0_PRO, gw, NGW);
    }
}

struct RowCoef { f32x4 a[4], b[4]; };
__device__ __forceinline__ void load_coef(RowCoef& C, const float* g, const float* sh, const float* sc, int lane) {
#pragma unroll
    for (int j = 0; j < 4; ++j) { const f32x4 gv = ((const f32x4*)g)[lane + 64 * j], sv = ((const f32x4*)sc)[lane + 64 * j]; C.a[j] = gv * (sv + 1.0f); C.b[j] = ((const f32x4*)sh)[lane + 64 * j]; }
}
__device__ __forceinline__ float row_rstd(const f32x4 (&v)[4]) {
    float s = 0.f;
#pragma unroll
    for (int j = 0; j < 4; ++j) s += (v[j].x * v[j].x + v[j].y * v[j].y) + (v[j].z * v[j].z + v[j].w * v[j].w);
    return 1.0f / sqrtf(wave_sum(s) * (1.0f / 1024.0f) + EPS);
}
__device__ __forceinline__ void store_row_bf16(bf16* row, const f32x4 (&v)[4], int lane) {
#pragma unroll
    for (int j = 0; j < 4; ++j) { v2u w; w.x = pkbf(v[j].x, v[j].y); w.y = pkbf(v[j].z, v[j].w); ((v2u*)row)[lane + 64 * j] = w; }
}

__device__ __forceinline__ void load_row_bf16(f32x4 (&v)[4], const bf16* row, int lane) {
#pragma unroll
    for (int j = 0; j < 4; ++j) { const v2u w = ((const v2u*)row)[lane + 64 * j]; v[j] = (f32x4){bflo(w.x), bfhi(w.x), bflo(w.y), bfhi(w.y)}; }
}
__device__ __forceinline__ void phase_modnorm0(const Frame& F, const Args& A) {
    const int gw = F.vcu * NWAVES + F.wave, NGW = F.G * NWAVES;
    const float* MOD = (const float*)(A.ws + WS_MOD); bf16* H = (bf16*)(A.ws + WS_H);
    const int rpw = (MTOT + NGW - 1) / NGW;
    int curb = -1; RowCoef C;
    const int mbeg = gw * rpw, cnt = (MTOT - mbeg) < rpw ? (MTOT - mbeg) : rpw;
    f32x4 nx[4];
    if (cnt > 0) { const float* xr = mbeg < MLAT ? A.in[0] + (size_t)mbeg * D : A.in[2] + (size_t)(mbeg - MLAT) * D;
#pragma unroll
        for (int j = 0; j < 4; ++j) nx[j] = ((const f32x4*)xr)[F.lane + 64 * j]; }
    for (int r = 0; r < cnt; ++r) { const int m = mbeg + r;
        const int mb = modrow(m);
        if (mb != curb) { load_coef(C, A.in[6], MOD + (size_t)mb * 6144, MOD + (size_t)mb * 6144 + 1024, F.lane); curb = mb; }
        f32x4 v[4];
#pragma unroll
        for (int j = 0; j < 4; ++j) v[j] = nx[j];
        if (r + 1 < cnt) { const int m1 = m + 1; const float* xr = m1 < MLAT ? A.in[0] + (size_t)m1 * D : A.in[2] + (size_t)(m1 - MLAT) * D;
#pragma unroll
            for (int j = 0; j < 4; ++j) nx[j] = ((const f32x4*)xr)[F.lane + 64 * j]; }
        const float rstd = row_rstd(v);
#pragma unroll
        for (int j = 0; j < 4; ++j) v[j] = v[j] * rstd * C.a[j] + C.b[j];
        store_row_bf16(H + (size_t)m * D, v, F.lane);
    }
}

template <int NML, int NNL> struct GroupOrder {
    static constexpr int PER = NML * NNL, BW = 4 * NNL;
    int nx, e0, lid;
    __device__ void init(int G_, int bx) { nx = G_ / 8; e0 = bx % 8; lid = bx / 8; }
    __device__ bool next(int i, pg8::Unit& u) const { const int q = i * nx + lid; if (q >= 2 * PER) return false;
        const int e = e0 + 8 * (q / PER), r = q % PER, band = r / BW, rr = r % BW, brow = (NML - 4 * band) < 4 ? (NML - 4 * band) : 4;
        u.pm = e * NML + 4 * band + rr % brow; u.pn = e * NNL + rr / brow; return true; }
    __device__ __forceinline__ void a_ready(const pg8::Unit&) const {}
    __device__ __forceinline__ void done(const pg8::Unit&) const {}
    __device__ __forceinline__ const char* aptr(const pg8::Gemm& g, const pg8::Unit& u, size_t tstep) const { return (const char*)g.A + (size_t)u.pm * tstep; }
    __device__ __forceinline__ const char* bptr(const pg8::Gemm& g, const pg8::Unit& u, size_t tstep) const { return (const char*)g.Bt + (size_t)u.pn * tstep; }
};
struct QKVOrder {
    int nx, x0, lid;
    __device__ void init(int G_, int bx) { nx = G_ / 8; x0 = bx % 8; lid = bx / 8; }
    __device__ bool next(int i, pg8::Unit& u) const { const int q = i * nx + lid; if (q >= 102) return false; const int tm = 17 * x0 + q / 6, c = q % 6;
        if (c < 5) { u.pm = tm; u.pn = c; } else { u.pm = 1000 + tm; u.pn = 5; } return true; }
    __device__ __forceinline__ void a_ready(const pg8::Unit&) const {}
    __device__ __forceinline__ void done(const pg8::Unit&) const {}
    __device__ __forceinline__ const char* aptr(const pg8::Gemm& g, const pg8::Unit& u, size_t tstep) const { return u.pm >= 1000 ? (const char*)g.Bt + 5 * tstep : (const char*)g.A + (size_t)u.pm * tstep; }
    __device__ __forceinline__ const char* bptr(const pg8::Gemm& g, const pg8::Unit& u, size_t tstep) const { return u.pm >= 1000 ? (const char*)g.A + (size_t)(u.pm - 1000) * tstep : (const char*)g.Bt + (size_t)u.pn * tstep; }
};
struct EpiQKV {
    static constexpr bool PERM = true, AFTER_DRAIN = false;
    bf16 *Q, *K, *V; const float* rc; const float* rs; float QS;
    __device__ __forceinline__ void operator()(const f32x4 (&acc)[2][2][4][2], const pg8::Unit& u, int wr, int wc, int fr, int fq) const {
        if (u.pm >= 1000) {
            const int tok0 = (u.pm - 1000) * 256;
#pragma unroll
            for (int ai = 0; ai < 2; ++ai)
#pragma unroll
                for (int m = 0; m < 4; ++m) { const int dr = ai * 128 + wr * 64 + m * 16 + fr;
#pragma unroll
                    for (int bj = 0; bj < 2; ++bj) { const f32x4 v0 = acc[ai][bj][m][0], v1 = acc[ai][bj][m][1];
                        v4u w; w.x = pkbf(v0[0], v0[1]); w.y = pkbf(v0[2], v0[3]); w.z = pkbf(v1[0], v1[1]); w.w = pkbf(v1[2], v1[3]);
                        *(v4u*)(V + (size_t)dr * MTOT + tok0 + bj * 128 + wc * 32 + 8 * fq) = w; } }
            return; }
        const int pn = u.pn; bf16* base; int ld, coff;
        if (pn < 4) { base = Q; ld = 1024; coff = pn * 256; } else { base = K; ld = 256; coff = 0; }
        const bool rope = (u.pm < MLAT / 256);
        const float sc = pn < 4 ? QS : 1.0f;
        const int iscol = wc & 1;
#pragma unroll
        for (int ai = 0; ai < 2; ++ai)
#pragma unroll
            for (int m = 0; m < 4; ++m) {
                const int r = u.pm * 256 + ai * 128 + wr * 64 + m * 16 + fr;
                f32x4 cv = (f32x4){1.f, 1.f, 1.f, 1.f}, sv = (f32x4){0.f, 0.f, 0.f, 0.f};
                if (rope) { const int n = r & 4095; const int pos = iscol ? (n & 63) : (n >> 6); cv = *(const f32x4*)(rc + pos * 16 + 4 * fq); sv = *(const f32x4*)(rs + pos * 16 + 4 * fq); }
#pragma unroll
                for (int bj = 0; bj < 2; ++bj) {
                    const f32x4 v0 = acc[ai][bj][m][0], v1 = acc[ai][bj][m][1];
                    const float o0 = (v0[0] * cv[0] - v0[1] * sv[0]) * sc, o1 = (v0[1] * cv[0] + v0[0] * sv[0]) * sc;
                    const float o2 = (v0[2] * cv[1] - v0[3] * sv[1]) * sc, o3 = (v0[3] * cv[1] + v0[2] * sv[1]) * sc;
                    const float o4 = (v1[0] * cv[2] - v1[1] * sv[2]) * sc, o5 = (v1[1] * cv[2] + v1[0] * sv[2]) * sc;
                    const float o6 = (v1[2] * cv[3] - v1[3] * sv[3]) * sc, o7 = (v1[3] * cv[3] + v1[2] * sv[3]) * sc;
                    v4u w; w.x = pkbf(o0, o1); w.y = pkbf(o2, o3); w.z = pkbf(o4, o5); w.w = pkbf(o6, o7);
                    *(v4u*)(base + (size_t)r * ld + coff + bj * 128 + wc * 32 + 8 * fq) = w;
                }
            }
    }
};
template <bool XIN_BF16> struct EpiResid {
    static constexpr bool PERM = true, AFTER_DRAIN = false;
    const void* xlat; const void* xctx; bf16* out; const float* gate;
    __device__ __forceinline__ void operator()(const f32x4 (&acc)[2][2][4][2], const pg8::Unit& u, int wr, int wc, int fr, int fq) const {
        const int mb = u.pm < MLAT / 256 ? (u.pm >> 4) : 8;
        const int col0 = u.pn * 256 + wc * 32 + 8 * fq;
        const float* gp = gate + (size_t)mb * 6144 + col0;
        f32x4 gv[2][2];
#pragma unroll
        for (int bj = 0; bj < 2; ++bj)
#pragma unroll
            for (int n = 0; n < 2; ++n) gv[bj][n] = *(const f32x4*)(gp + bj * 128 + n * 4);
#pragma unroll
        for (int ai = 0; ai < 2; ++ai)
#pragma unroll
            for (int m = 0; m < 4; ++m) {
                const int r = u.pm * 256 + ai * 128 + wr * 64 + m * 16 + fr;
                bf16* o = out + (size_t)r * D + col0;
#pragma unroll
                for (int bj = 0; bj < 2; ++bj) { f32x4 x0, x1;
                    if (XIN_BF16) { const v4u w = *(const v4u*)((const bf16*)xlat + (size_t)r * D + col0 + bj * 128);
                        x0 = (f32x4){bflo(w.x), bfhi(w.x), bflo(w.y), bfhi(w.y)}; x1 = (f32x4){bflo(w.z), bfhi(w.z), bflo(w.w), bfhi(w.w)}; }
                    else { const float* xin = (r < MLAT ? (const float*)xlat + (size_t)r * D : (const float*)xctx + (size_t)(r - MLAT) * D) + col0 + bj * 128; x0 = *(const f32x4*)xin; x1 = *(const f32x4*)(xin + 4); }
                    x0 += gv[bj][0] * acc[ai][bj][m][0]; x1 += gv[bj][1] * acc[ai][bj][m][1];
                    v4u w; w.x = pkbf(x0[0], x0[1]); w.y = pkbf(x0[2], x0[3]); w.z = pkbf(x1[0], x1[1]); w.w = pkbf(x1[2], x1[3]);
                    *(v4u*)(o + bj * 128) = w; }
            }
    }
};
struct EpiSwiGLU {
    static constexpr bool PERM = true, AFTER_DRAIN = false;
    unsigned char* HID;
    __device__ __forceinline__ void operator()(const f32x4 (&acc)[2][2][4][2], const pg8::Unit& u, int wr, int wc, int fr, int fq) const {
        asm volatile("" : "+v"(fr), "+v"(fq));
        const int col = (u.pn & 15) * 128 + wc * 32 + 8 * fq;
#pragma unroll
        for (int ai = 0; ai < 2; ++ai)
#pragma unroll
            for (int m = 0; m < 4; ++m) {
                const int r = u.pm * 256 + ai * 128 + wr * 64 + m * 16 + fr;
                const f32x4 g0 = acc[ai][0][m][0] * W8I, g1 = acc[ai][0][m][1] * W8I, u0 = acc[ai][1][m][0] * W8I, u1 = acc[ai][1][m][1] * W8I;
                v2u w; w.x = pk4f8(silu_f(g0[0]) * u0[0], silu_f(g0[1]) * u0[1], silu_f(g0[2]) * u0[2], silu_f(g0[3]) * u0[3]);
                w.y = pk4f8(silu_f(g1[0]) * u1[0], silu_f(g1[1]) * u1[1], silu_f(g1[2]) * u1[2], silu_f(g1[3]) * u1[3]);
                *(v2u*)(HID + (size_t)r * FF + col) = w;
            }
    }
};
struct EpiY {
    static constexpr bool PERM = true, AFTER_DRAIN = false;
    bf16* Y;
    __device__ __forceinline__ void operator()(const f32x4 (&acc)[2][2][4][2], const pg8::Unit& u, int wr, int wc, int fr, int fq) const {
        asm volatile("" : "+v"(fr), "+v"(fq));
        const int col = (u.pn & 3) * 256 + wc * 32 + 8 * fq;
#pragma unroll
        for (int ai = 0; ai < 2; ++ai)
#pragma unroll
            for (int m = 0; m < 4; ++m) {
                const int r = u.pm * 256 + ai * 128 + wr * 64 + m * 16 + fr;
                const float gwt = W8I;
#pragma unroll
                for (int bj = 0; bj < 2; ++bj) { const f32x4 v0 = acc[ai][bj][m][0] * gwt, v1 = acc[ai][bj][m][1] * gwt;
                    v4u w; w.x = pkbf(v0[0], v0[1]); w.y = pkbf(v0[2], v0[3]); w.z = pkbf(v1[0], v1[1]); w.w = pkbf(v1[2], v1[3]);
                    *(v4u*)(Y + (size_t)r * D + col + bj * 128) = w; }
            }
    }
};
struct EpiP {
    static constexpr bool PERM = true, AFTER_DRAIN = false;
    bf16 *P, *Z;
    __device__ __forceinline__ void operator()(const f32x4 (&acc)[2][2][4][2], const pg8::Unit& u, int wr, int wc, int fr, int fq) const {
        bf16* base; int ld, coff;
        if (u.pn < 12) { base = P; ld = 3072; coff = u.pn * 256; } else { base = Z; ld = 1024; coff = (u.pn - 12) * 256; }
#pragma unroll
        for (int ai = 0; ai < 2; ++ai)
#pragma unroll
            for (int m = 0; m < 4; ++m) {
                const int r = u.pm * 256 + ai * 128 + wr * 64 + m * 16 + fr;
#pragma unroll
                for (int bj = 0; bj < 2; ++bj) { const f32x4 v0 = acc[ai][bj][m][0], v1 = acc[ai][bj][m][1];
                    v4u w; w.x = pkbf(v0[0], v0[1]); w.y = pkbf(v0[2], v0[3]); w.z = pkbf(v1[0], v1[1]); w.w = pkbf(v1[2], v1[3]);
                    *(v4u*)(base + (size_t)r * ld + coff + bj * 128 + wc * 32 + 8 * fq) = w; }
            }
    }
};

typedef float f32x16 __attribute__((ext_vector_type(16)));
typedef float f32x2_t __attribute__((ext_vector_type(2)));
typedef __bf16 bf16x2_t __attribute__((ext_vector_type(2)));
__device__ __forceinline__ unsigned cvtpk(float lo, float hi) { f32x2_t v = {lo, hi}; bf16x2_t b = __builtin_convertvector(v, bf16x2_t); return __builtin_bit_cast(unsigned, b); }
#define MFMA32(a, b, c) __builtin_amdgcn_mfma_f32_32x32x16_bf16((a), (b), (c), 0, 0, 0)
constexpr float LOG2E = 1.4426950408889634f;
constexpr float QSCALE = 0.125f * LOG2E;
constexpr int ATT_KROW = 144, ATT_VROW = 136, ATT_KB = 64 * ATT_KROW, ATT_VB = 64 * ATT_VROW;
struct AttU { int b, kvh, qb, hq, n, jlo, nl, T; bool lat; size_t mrow, ctxbase, latbase; };
__device__ __forceinline__ void att_decode(AttU& U, int u, int g, int half, int r) {
    constexpr int NU_LAT = NB * 4 * 64;
    U.lat = u < NU_LAT;
    if (U.lat) { U.b = u >> 8; U.kvh = (u >> 6) & 3; U.qb = u & 63; } else { const int uu = u - NU_LAT; U.b = uu >> 4; U.kvh = (uu >> 2) & 3; U.qb = uu & 3; }
    U.hq = U.kvh * 4 + g; U.n = U.qb * 64 + half * 32 + r;
    U.mrow = U.lat ? (size_t)U.b * SEQ + U.n : (size_t)MLAT + U.b * CTXL + U.n;
    U.jlo = U.lat ? (U.qb - 2 < 0 ? 0 : U.qb - 2) : 0; const int jhi = U.lat ? (U.qb + 2 > 63 ? 63 : U.qb + 2) : -1; U.nl = jhi - U.jlo + 1; U.T = U.nl + 4;
    U.ctxbase = (size_t)MLAT + U.b * CTXL; U.latbase = (size_t)U.b * SEQ;
}
__device__ __forceinline__ void phase_attn_v2(const Frame& F, const Args& A) {
    const bf16* Q = (const bf16*)(A.ws + WS_Q); const bf16* K = (const bf16*)(A.ws + WS_K); const bf16* VT = (const bf16*)(A.ws + WS_V); bf16* O = (bf16*)(A.ws + WS_ATT);
    LAS unsigned char* Kb = F.lds; LAS unsigned char* Vb = F.lds + 2 * ATT_KB;
    const int g = F.wave >> 1, half = F.wave & 1, r = F.lane & 31, hh = F.lane >> 5;
    const int kr = F.tid >> 3, kc = F.tid & 7;
    constexpr int NU = NB * 4 * 64 + NB * 4 * 4;
    int u = F.vcu; bool have = u < NU;
    AttU U{}, Un{}; v4u kreg = (v4u){0u, 0u, 0u, 0u}, vreg = kreg; bf16x8 qfn[4];
#pragma unroll
    for (int ks = 0; ks < 4; ++ks) qfn[ks] = (bf16x8){0, 0, 0, 0, 0, 0, 0, 0};
#define ATT_PREFETCH(UU) do { const size_t rb_ = ((UU).nl > 0) ? (UU).latbase + (size_t)(UU).jlo * 64 : (UU).ctxbase; \
        kreg = *(const v4u*)(K + (rb_ + kr) * 256 + (UU).kvh * 64 + kc * 8); vreg = *(const v4u*)(VT + (size_t)((UU).kvh * 64 + kr) * MTOT + rb_ + kc * 8); \
        _Pragma("unroll") for (int ks_ = 0; ks_ < 4; ++ks_) qfn[ks_] = *(const bf16x8*)(Q + (UU).mrow * 1024 + (UU).hq * 64 + 16 * ks_ + 8 * hh); } while (0)
    if (have) { att_decode(U, u, g, half, r); ATT_PREFETCH(U); }
    while (have) {
        const int b = U.b, kvh = U.kvh, qb = U.qb, hq = U.hq, n = U.n, jlo = U.jlo, nl = U.nl, T = U.T; const size_t mrow = U.mrow, ctxbase = U.ctxbase, latbase = U.latbase; (void)b;
        bf16x8 qf[4];
#pragma unroll
        for (int ks = 0; ks < 4; ++ks) qf[ks] = qfn[ks];
        const float sink2 = A.in[8][hq] * LOG2E;
        float mrun = sink2, lsum = 0.f;
        f32x16 oacc[2];
#pragma unroll
        for (int i = 0; i < 16; ++i) { oacc[0][i] = 0.f; oacc[1][i] = 0.f; }
        *(LAS v4u*)(Kb + kr * ATT_KROW + kc * 16) = kreg;
        *(LAS v2u*)(Vb + kr * ATT_VROW + kc * 16) = (v2u){vreg.x, vreg.y}; *(LAS v2u*)(Vb + kr * ATT_VROW + kc * 16 + 8) = (v2u){vreg.z, vreg.w};
        __syncthreads();
        const int un = u + F.G; const bool hn = un < NU;
        if (hn) att_decode(Un, un, g, half, r);
        for (int t = 0; t < T; ++t) {
            if (t + 1 < T) { const int t1 = t + 1; const size_t rb = (t1 < nl) ? latbase + (size_t)(jlo + t1) * 64 : ctxbase + (size_t)(t1 - nl) * 64;
                kreg = *(const v4u*)(K + (rb + kr) * 256 + kvh * 64 + kc * 8); vreg = *(const v4u*)(VT + (size_t)(kvh * 64 + kr) * MTOT + rb + kc * 8); }
            else if (hn) ATT_PREFETCH(Un);
            const LAS unsigned char* kb = Kb + (t & 1) * ATT_KB; const LAS unsigned char* vb = Vb + (t & 1) * ATT_VB;
            f32x16 st[2];
#pragma unroll
            for (int sub = 0; sub < 2; ++sub) {
#pragma unroll
                for (int i = 0; i < 16; ++i) st[sub][i] = 0.f;
#pragma unroll
                for (int ks = 0; ks < 4; ++ks) { const bf16x8 kf = *(const LAS bf16x8*)(kb + (32 * sub + r) * ATT_KROW + (16 * ks + 8 * hh) * 2); st[sub] = MFMA32(kf, qf[ks], st[sub]); }
            }
            if (t < nl) { const int jt = jlo + t;
                if (jt == qb - 2 || jt == qb + 2) {
#pragma unroll
                    for (int sub = 0; sub < 2; ++sub)
#pragma unroll
                        for (int i = 0; i < 16; ++i) { const int key = jt * 64 + 32 * sub + (i & 3) + 8 * (i >> 2) + 4 * hh; const int d = key - n; if (d > 128 || d < -128) st[sub][i] = -INFINITY; }
                } }
            float mx = st[0][0];
#pragma unroll
            for (int i = 1; i < 16; ++i) mx = fmaxf(mx, st[0][i]);
#pragma unroll
            for (int i = 0; i < 16; ++i) mx = fmaxf(mx, st[1][i]);
            mx = fmaxf(mx, __shfl_xor(mx, 32));
            const float mnew = fmaxf(mrun, mx);
            if (__builtin_amdgcn_ballot_w64(mnew != mrun) != 0ull) {
                const float alpha = __builtin_amdgcn_exp2f(mrun - mnew); mrun = mnew; lsum *= alpha;
#pragma unroll
                for (int i = 0; i < 16; ++i) { oacc[0][i] *= alpha; oacc[1][i] *= alpha; } }
            float ps = 0.f;
#pragma unroll
            for (int sub = 0; sub < 2; ++sub)
#pragma unroll
                for (int i = 0; i < 16; ++i) { const float p = __builtin_amdgcn_exp2f(st[sub][i] - mnew); st[sub][i] = p; ps += p; }
            lsum += ps;
#pragma unroll
            for (int sub = 0; sub < 2; ++sub)
#pragma unroll
                for (int s = 0; s < 2; ++s) {
                    v4u pw; pw.x = cvtpk(st[sub][8 * s], st[sub][8 * s + 1]); pw.y = cvtpk(st[sub][8 * s + 2], st[sub][8 * s + 3]); pw.z = cvtpk(st[sub][8 * s + 4], st[sub][8 * s + 5]); pw.w = cvtpk(st[sub][8 * s + 6], st[sub][8 * s + 7]);
                    const bf16x8 pf = __builtin_bit_cast(bf16x8, pw);
#pragma unroll
                    for (int dt = 0; dt < 2; ++dt) { const LAS unsigned char* vp = vb + (32 * dt + r) * ATT_VROW + (32 * sub + 16 * s + 4 * hh) * 2;
                        const v2u lo = *(const LAS v2u*)vp, hi = *(const LAS v2u*)(vp + 16);
                        const bf16x8 vf = __builtin_bit_cast(bf16x8, (v4u){lo.x, lo.y, hi.x, hi.y});
                        oacc[dt] = MFMA32(vf, pf, oacc[dt]); }
                }
            if (t + 1 < T) { LAS unsigned char* kw = Kb + ((t + 1) & 1) * ATT_KB; LAS unsigned char* vw = Vb + ((t + 1) & 1) * ATT_VB;
                *(LAS v4u*)(kw + kr * ATT_KROW + kc * 16) = kreg;
                *(LAS v2u*)(vw + kr * ATT_VROW + kc * 16) = (v2u){vreg.x, vreg.y}; *(LAS v2u*)(vw + kr * ATT_VROW + kc * 16 + 8) = (v2u){vreg.z, vreg.w}; }
            __syncthreads();
        }
        lsum += __shfl_xor(lsum, 32);
        const float inv = 1.0f / (lsum + __builtin_amdgcn_exp2f(sink2 - mrun));
        bf16* orow = O + mrow * 1024 + hq * 64;
#pragma unroll
        for (int dt = 0; dt < 2; ++dt)
#pragma unroll
            for (int rq = 0; rq < 4; ++rq) { v2u w; w.x = cvtpk(oacc[dt][4 * rq] * inv, oacc[dt][4 * rq + 1] * inv); w.y = cvtpk(oacc[dt][4 * rq + 2] * inv, oacc[dt][4 * rq + 3] * inv);
                *(v2u*)(orow + 32 * dt + 8 * rq + 4 * hh) = w; }
        U = Un; u = un; have = hn;
    }
#undef ATT_PREFETCH
    if (F.G == 256 && F.vcu >= 128) tr_moe_items(F, A.in[26], A.in[27], A.in[28], A.ws + WS_WGU1, A.ws + WS_WD1, 0, L1_ATT, (F.vcu - 128) * NWAVES + F.wave, 128 * NWAVES);
    else if (F.G != 256) tr_moe_items(F, A.in[26], A.in[27], A.in[28], A.ws + WS_WGU1, A.ws + WS_WD1, 0, L1_ATT, F.vcu * NWAVES + F.wave, F.G * NWAVES);
}

template <int R> __device__ __forceinline__ void nr_rows(const Frame& F, const bf16* xres, int m0, const float* g, const float* mod, const LAS float* WrT, unsigned char* H8, float* AFF, float* AFFC, RowCoef& C, int& curb) {
    f32x4 vv[R][4];
#pragma unroll
    for (int t = 0; t < R; ++t) load_row_bf16(vv[t], xres + (size_t)(m0 + t) * D, F.lane);
#pragma unroll
    for (int t = 0; t < R; ++t) { const int m = m0 + t; const int mb = modrow(m);
        if (mb != curb) { load_coef(C, g, mod + (size_t)mb * 6144 + 3 * 1024, mod + (size_t)mb * 6144 + 4 * 1024, F.lane); curb = mb; }
        const float rstd = row_rstd(vv[t]);
#pragma unroll
        for (int j = 0; j < 4; ++j) vv[t][j] = vv[t][j] * rstd * C.a[j] + C.b[j];
#pragma unroll
        for (int j = 0; j < 4; ++j) ((unsigned*)(H8 + (size_t)m * D))[F.lane + 64 * j] = pk4f8(vv[t][j].x, vv[t][j].y, vv[t][j].z, vv[t][j].w); }
    const LAS float* wrt = WrT; asm volatile("" : "+v"(wrt));
    float lgt[R];
    proj16xR<R>(vv, wrt, F.lane, lgt);
#pragma unroll
    for (int t = 0; t < R; ++t) { const float logit = lgt[t];
        float mx = logit;
#pragma unroll
        for (int o = 4; o < 64; o <<= 1) mx = fmaxf(mx, __shfl_xor(mx, o));
        const float ex = expf(logit - mx); float den = ex;
#pragma unroll
        for (int o = 4; o < 64; o <<= 1) den += __shfl_xor(den, o);
        const float mine = ex / den; const int ee = F.lane >> 2; const int m = m0 + t;
        if ((F.lane & 3) == 0) { if (m < MLAT) AFF[((size_t)(m >> 12) * NE + ee) * SEQ + (m & 4095)] = mine; else { const int mm = m - MLAT; AFFC[((size_t)(mm >> 8) * NE + ee) * CTXL + (mm & 255)] = mine; } } }
}
__device__ __forceinline__ void phase_norm_router(const Frame& F, const Args& A, const bf16* xres, int nrows, const float* g, const float* mod, const float* router) {
    LAS float* WrT = (LAS float*)F.lds;
    for (int idx = F.tid; idx < 16384; idx += NTHR) WrT[(idx & 15) * 1024 + (idx >> 4)] = router[idx];
    __syncthreads();
    const int gw = F.vcu * NWAVES + F.wave, NGW = F.G * NWAVES;
    unsigned char* H8 = A.ws + WS_H8; float* AFF = (float*)(A.ws + WS_AFF); float* AFFC = AFF + (size_t)NB * NE * SEQ;
    const int rpw = (nrows + NGW - 1) / NGW;
    int curb = -1; RowCoef C;
    const int mbeg = gw * rpw, cnt = (nrows - mbeg) < rpw ? (nrows - mbeg) : rpw;
    int r = 0;
    for (; r + 4 <= cnt; r += 4) nr_rows<4>(F, xres, mbeg + r, g, mod, WrT, H8, AFF, AFFC, C, curb);
    for (; r < cnt; ++r) nr_rows<1>(F, xres, mbeg + r, g, mod, WrT, H8, AFF, AFFC, C, curb);
    __syncthreads();
}

__device__ __forceinline__ void phase_topk(const Frame& F, const Args& A, bool with_ctx, int erows, const float* cwg, const float* cwu, const float* cwd, unsigned char* cwgu, unsigned char* cwdn, int clo, int chi) {
    LAS unsigned* hist = (LAS unsigned*)F.lds;
    LAS unsigned* ctl = hist + 256;
    LAS unsigned* wsum = hist + 272;
    LAS int* sel = (LAS int*)(hist + 512);
    const float* AFF = (const float*)(A.ws + WS_AFF); const float* AFFC = AFF + (size_t)NB * NE * SEQ;
    float* GW = (float*)(A.ws + WS_GW); int* SLOT = (int*)(A.ws + WS_SLOT);
    const unsigned char* H8 = A.ws + WS_H8; unsigned char* XG = A.ws + WS_XG;
    const int nprob = with_ctx ? 256 : 128;
    for (int p = F.vcu; p < nprob; p += F.G) {
        int b, e, N, cap, rowbase, tokbase; const float* src;
        if (p < 128) { b = p >> 4; e = p & 15; N = SEQ; cap = CAPL; src = AFF + (size_t)(b * NE + e) * SEQ; rowbase = e * erows + b * CAPL; tokbase = b * SEQ; }
        else { const int pp = p - 128; b = pp >> 4; e = pp & 15; N = CTXL; cap = CAPC; src = AFFC + (size_t)(b * NE + e) * CTXL; rowbase = e * erows + NB * CAPL + b * CAPC; tokbase = MLAT + b * CTXL; }
        const bool own = 8 * F.tid < N;
        unsigned v[8];
        { f32x4 x0 = (f32x4){0.f, 0.f, 0.f, 0.f}, x1 = x0; if (own) { x0 = ((const f32x4*)src)[2 * F.tid]; x1 = ((const f32x4*)src)[2 * F.tid + 1]; }
          v[0] = __float_as_uint(x0.x); v[1] = __float_as_uint(x0.y); v[2] = __float_as_uint(x0.z); v[3] = __float_as_uint(x0.w); v[4] = __float_as_uint(x1.x); v[5] = __float_as_uint(x1.y); v[6] = __float_as_uint(x1.z); v[7] = __float_as_uint(x1.w); }
        unsigned prefix = 0u, need = (unsigned)cap;
#pragma unroll
        for (int pass = 0; pass < 4; ++pass) { const int shift = 24 - 8 * pass;
            if (F.tid < 256) hist[F.tid] = 0u;
            __syncthreads();
            if (own) {
#pragma unroll
                for (int k = 0; k < 8; ++k) { const bool match = (pass == 0) ? true : ((v[k] >> ((shift + 8) & 31)) == (prefix >> ((shift + 8) & 31))); if (match) atomicAdd((unsigned*)&hist[(v[k] >> shift) & 255u], 1u); } }
            __syncthreads();
            if (F.wave == 0) { const unsigned c0 = hist[4 * F.lane], c1 = hist[4 * F.lane + 1], c2 = hist[4 * F.lane + 2], c3 = hist[4 * F.lane + 3]; const unsigned tot = (c0 + c1) + (c2 + c3);
                unsigned sv = tot;
#pragma unroll
                for (int o = 1; o < 64; o <<= 1) { const unsigned t = __shfl_down(sv, o); if (F.lane + o < 64) sv += t; }
                const unsigned g3 = sv - tot, g2 = g3 + c3, g1 = g2 + c2, g0 = g1 + c1;
                if (g3 < need && need <= g3 + c3) { ctl[0] = 4 * F.lane + 3; ctl[1] = need - g3; }
                else if (g2 < need && need <= g2 + c2) { ctl[0] = 4 * F.lane + 2; ctl[1] = need - g2; }
                else if (g1 < need && need <= g1 + c1) { ctl[0] = 4 * F.lane + 1; ctl[1] = need - g1; }
                else if (g0 < need && need <= g0 + c0) { ctl[0] = 4 * F.lane; ctl[1] = need - g0; } }
            __syncthreads();
            prefix |= ctl[0] << shift; need = ctl[1]; }
        const unsigned T = prefix;
        unsigned packed = 0u;
        if (own) {
#pragma unroll
            for (int k = 0; k < 8; ++k) packed += (v[k] > T ? 1u : 0u) + (v[k] == T ? 0x10000u : 0u); }
        unsigned incl = packed;
#pragma unroll
        for (int o = 1; o < 64; o <<= 1) { const unsigned t = __shfl_up(incl, o); if (F.lane >= o) incl += t; }
        if (F.lane == 63) wsum[F.wave] = incl;
        __syncthreads();
        unsigned base = 0u;
#pragma unroll
        for (int w = 0; w < 8; ++w) if (w < F.wave) base += wsum[w];
        unsigned rg = ((incl - packed) + base) & 0xffffu, re = ((incl - packed) + base) >> 16; const unsigned totalgt = (unsigned)cap - need;
        if (own) {
#pragma unroll
            for (int k = 0; k < 8; ++k) { const int tok = tokbase + 8 * F.tid + k; int slot = -1;
                if (v[k] > T) { slot = (int)rg; ++rg; } else if (v[k] == T) { if (re < need) slot = (int)(totalgt + re); ++re; }
                if (slot >= 0) { GW[rowbase + slot] = __uint_as_float(v[k]); SLOT[(size_t)tok * 16 + e] = rowbase + slot; sel[slot] = tok; } else SLOT[(size_t)tok * 16 + e] = -1; } }
        __syncthreads();
        for (int i0 = F.wave; i0 < cap; i0 += 8 * NWAVES) {
            v4u x[8];
#pragma unroll
            for (int q = 0; q < 8; ++q) { const int i = i0 + q * NWAVES; const int tok = sel[i < cap ? i : i0]; x[q] = ((const v4u*)(H8 + (size_t)tok * D))[F.lane]; }
#pragma unroll
            for (int q = 0; q < 8; ++q) { const int i = i0 + q * NWAVES; if (i < cap) ((v4u*)(XG + (size_t)(rowbase + i) * D))[F.lane] = x[q]; } }
        __syncthreads();
    }
    if (F.G == 256) { if (F.vcu >= 128) tr_moe_items(F, cwg, cwu, cwd, cwgu, cwdn, clo, chi, (F.vcu - 128) * NWAVES + F.wave, 128 * NWAVES); }
    else tr_moe_items(F, cwg, cwu, cwd, cwgu, cwdn, clo, chi, F.vcu * NWAVES + F.wave, F.G * NWAVES);
}

struct CombineIn { int sv; v2u xr[4]; };
__device__ __forceinline__ void combine_issue(CombineIn& ci, const bf16* xres_row, const int* slot_row, int lane) {
    ci.sv = slot_row[lane & 15];
#pragma unroll
    for (int j = 0; j < 4; ++j) ci.xr[j] = ((const v2u*)xres_row)[lane + 64 * j];
}
__device__ __forceinline__ void combine_finish(f32x4 (&v)[4], const CombineIn& ci, const bf16* Y, const float* GW, const float* gt2, int lane) {
    f32x4 acc[4];
#pragma unroll
    for (int j = 0; j < 4; ++j) acc[j] = (f32x4){0.f, 0.f, 0.f, 0.f};
    const int sv = ci.sv;
    unsigned mask = (unsigned)(__builtin_amdgcn_ballot_w64(sv >= 0) & 0xffffull);
    while (mask) {
        v2u w[4][4]; float gte[4];
#pragma unroll
        for (int q = 0; q < 4; ++q) {
            gte[q] = 0.f;
#pragma unroll
            for (int j = 0; j < 4; ++j) w[q][j] = (v2u){0u, 0u};
            if (mask) { const int e = __builtin_ctz(mask); mask &= mask - 1u; const int s = __builtin_amdgcn_readlane(sv, e);
                gte[q] = GW[s]; const v2u* yr = (const v2u*)(Y + (size_t)s * D);
#pragma unroll
                for (int j = 0; j < 4; ++j) w[q][j] = yr[lane + 64 * j]; } }
#pragma unroll
        for (int q = 0; q < 4; ++q)
#pragma unroll
            for (int j = 0; j < 4; ++j) acc[j] += (f32x4){bflo(w[q][j].x), bfhi(w[q][j].x), bflo(w[q][j].y), bfhi(w[q][j].y)} * gte[q];
    }
#pragma unroll
    for (int j = 0; j < 4; ++j) v[j] = (f32x4){bflo(ci.xr[j].x), bfhi(ci.xr[j].x), bflo(ci.xr[j].y), bfhi(ci.xr[j].y)} + ((const f32x4*)gt2)[lane + 64 * j] * acc[j];
}

template <int R> __device__ __forceinline__ void cmb_rows(const Frame& F, const Args& A, int m0, const LAS float* WabT, RowCoef& C, int& curb, float alog, float dtb) {
    const float* MOD0 = (const float*)(A.ws + WS_MOD); const float* MOD1 = MOD0 + 9 * 6144;
    bf16* XRES = (bf16*)(A.ws + WS_XRES); bf16* H = (bf16*)(A.ws + WS_H); const bf16* Y = (const bf16*)(A.ws + WS_XG); const int* SLOT = (const int*)(A.ws + WS_SLOT);
    float* Gb = (float*)(A.ws + WS_G); float* Bb = (float*)(A.ws + WS_BETA);
    f32x4 vv[R][4]; CombineIn ci[R];
#pragma unroll
    for (int t = 0; t < R; ++t) combine_issue(ci[t], XRES + (size_t)(m0 + t) * D, SLOT + (size_t)(m0 + t) * 16, F.lane);
#pragma unroll
    for (int t = 0; t < R; ++t) { const int m = m0 + t; const int mb = modrow(m);
        if (mb != curb) { load_coef(C, A.in[17], MOD1 + (size_t)mb * 6144, MOD1 + (size_t)mb * 6144 + 1024, F.lane); curb = mb; }
        combine_finish(vv[t], ci[t], Y, (const float*)(A.ws + WS_GW), MOD0 + (size_t)mb * 6144 + 5 * 1024, F.lane);
        store_row_bf16(XRES + (size_t)m * D, vv[t], F.lane);
        const float rstd = row_rstd(vv[t]);
#pragma unroll
        for (int j = 0; j < 4; ++j) vv[t][j] = vv[t][j] * rstd * C.a[j] + C.b[j];
        store_row_bf16(H + (size_t)m * D, vv[t], F.lane); }
    const LAS float* wab = WabT; asm volatile("" : "+v"(wab));
    float av[R], bv[R];
    proj16xR<R>(vv, wab, F.lane, av); proj16xR<R>(vv, wab + 16 * 1024, F.lane, bv);
    if ((F.lane & 3) == 0) { const int jj = F.lane >> 2;
#pragma unroll
        for (int t = 0; t < R; ++t) { const int m = m0 + t; const float xx = av[t] + dtb; const float sp = fmaxf(xx, 0.f) + log1pf(expf(-fabsf(xx))); Gb[(size_t)m * 16 + jj] = -expf(alog) * sp; Bb[(size_t)m * 16 + jj] = 1.0f / (1.0f + expf(-bv[t])); } }
}
__device__ __forceinline__ void phase_combine0(const Frame& F, const Args& A) {
    const int gw = F.vcu * NWAVES + F.wave, NGW = F.G * NWAVES;
    tr_moe_items(F, A.in[26], A.in[27], A.in[28], A.ws + WS_WGU1, A.ws + WS_WD1, L1_ATT + L1_G2 + L1_WIN, L1_ATT + L1_G2 + L1_WIN + L1_CMB, gw, NGW);
    __syncthreads();
    LAS float* WabT = (LAS float*)F.lds;
    for (int idx = F.tid; idx < 32768; idx += NTHR) { const int k = idx >> 5, j = idx & 31; WabT[j * 1024 + k] = A.in[18][(size_t)k * LDWIN + 4096 + j]; }
    __syncthreads();
    const int rpw = (MTOT + NGW - 1) / NGW;
    int curb = -1; RowCoef C;
    const float alog = A.in[20][(F.lane >> 2) & 15], dtb = A.in[21][(F.lane >> 2) & 15];
    const int mbeg = gw * rpw, cnt = (MTOT - mbeg) < rpw ? (MTOT - mbeg) : rpw;
    int r = 0;
    for (; r + 4 <= cnt; r += 4) cmb_rows<4>(F, A, mbeg + r, WabT, C, curb, alog, dtb);
    for (; r < cnt; ++r) cmb_rows<1>(F, A, mbeg + r, WabT, C, curb, alog, dtb);
    __syncthreads();
}

__device__ __forceinline__ void phase_conv(const Frame& F, const Args& A) {
    const int gw = F.vcu * NWAVES + F.wave, NGW = F.G * NWAVES;
    const bf16* P = (const bf16*)(A.ws + WS_PQKV); const float* cw = A.in[19];
    bf16* out0 = (bf16*)(A.ws + WS_QN);
    const int nchunk = NGW / 2, rpc = (MTOT + nchunk - 1) / nchunk;
    const int half = gw & 1, chunk = gw >> 1;
    const int mbeg = chunk * rpc, cnt = (MTOT - mbeg) < rpc ? (MTOT - mbeg) : rpc;
    if (cnt <= 0) return;
    float w[3][3][8];
#pragma unroll
    for (int ii = 0; ii < 3; ++ii) { const int c = 512 * (3 * half + ii) + 8 * F.lane;
#pragma unroll
        for (int j = 0; j < 3; ++j) { const f32x4 a = *(const f32x4*)(cw + j * 3072 + c), bq = *(const f32x4*)(cw + j * 3072 + c + 4);
            w[ii][j][0] = a.x; w[ii][j][1] = a.y; w[ii][j][2] = a.z; w[ii][j][3] = a.w; w[ii][j][4] = bq.x; w[ii][j][5] = bq.y; w[ii][j][6] = bq.z; w[ii][j][7] = bq.w; } }
    v4u xp[3], xc[3], xn[3], xnn[3];
    const int cbase = 512 * 3 * half + 8 * F.lane;
#pragma unroll
    for (int ii = 0; ii < 3; ++ii) { xp[ii] = (v4u){0u, 0u, 0u, 0u}; xc[ii] = *(const v4u*)(P + (size_t)mbeg * 3072 + cbase + 512 * ii); xn[ii] = (v4u){0u, 0u, 0u, 0u}; xnn[ii] = (v4u){0u, 0u, 0u, 0u}; }
    if (mbeg > 0) {
#pragma unroll
        for (int ii = 0; ii < 3; ++ii) xp[ii] = *(const v4u*)(P + (size_t)(mbeg - 1) * 3072 + cbase + 512 * ii); }
    if (mbeg + 1 < MTOT) {
#pragma unroll
        for (int ii = 0; ii < 3; ++ii) xn[ii] = *(const v4u*)(P + (size_t)(mbeg + 1) * 3072 + cbase + 512 * ii); }
    for (int r = 0; r < cnt; ++r) { const int m = mbeg + r;
        bool hp, hn; if (m < MLAT) { const int n = m & 4095; hp = n > 0; hn = n < SEQ - 1; } else { const int l = (m - MLAT) & 255; hp = l > 0; hn = l < CTXL - 1; }
        if (m + 2 < MTOT) {
#pragma unroll
            for (int ii = 0; ii < 3; ++ii) xnn[ii] = *(const v4u*)(P + (size_t)(m + 2) * 3072 + cbase + 512 * ii); }
#pragma unroll
        for (int ii = 0; ii < 3; ++ii) { const int i = 3 * half + ii;
            const v4u a = hp ? xp[ii] : (v4u){0u, 0u, 0u, 0u}, c = xc[ii], e = hn ? xn[ii] : (v4u){0u, 0u, 0u, 0u};
            float y[8];
            y[0] = bflo(a.x) * w[ii][0][0] + bflo(c.x) * w[ii][1][0] + bflo(e.x) * w[ii][2][0]; y[1] = bfhi(a.x) * w[ii][0][1] + bfhi(c.x) * w[ii][1][1] + bfhi(e.x) * w[ii][2][1];
            y[2] = bflo(a.y) * w[ii][0][2] + bflo(c.y) * w[ii][1][2] + bflo(e.y) * w[ii][2][2]; y[3] = bfhi(a.y) * w[ii][0][3] + bfhi(c.y) * w[ii][1][3] + bfhi(e.y) * w[ii][2][3];
            y[4] = bflo(a.z) * w[ii][0][4] + bflo(c.z) * w[ii][1][4] + bflo(e.z) * w[ii][2][4]; y[5] = bfhi(a.z) * w[ii][0][5] + bfhi(c.z) * w[ii][1][5] + bfhi(e.z) * w[ii][2][5];
            y[6] = bflo(a.w) * w[ii][0][6] + bflo(c.w) * w[ii][1][6] + bflo(e.w) * w[ii][2][6]; y[7] = bfhi(a.w) * w[ii][0][7] + bfhi(c.w) * w[ii][1][7] + bfhi(e.w) * w[ii][2][7];
            float ss = 0.f;
#pragma unroll
            for (int t = 0; t < 8; ++t) { y[t] = silu_f(y[t]); ss += y[t] * y[t]; }
            if (i < 4) { ss += __shfl_xor(ss, 1); ss += __shfl_xor(ss, 2); ss += __shfl_xor(ss, 4); ss += __shfl_xor(ss, 8);
                const float sc = (1.0f / sqrtf(ss + EPS)) * (i < 2 ? 0.08838834764831845f : 1.0f);
#pragma unroll
                for (int t = 0; t < 8; ++t) y[t] *= sc; }
            v4u o; o.x = pkbf(y[0], y[1]); o.y = pkbf(y[2], y[3]); o.z = pkbf(y[4], y[5]); o.w = pkbf(y[6], y[7]);
            *(v4u*)(out0 + (size_t)(i >> 1) * (68 * MiB / 2) + (size_t)m * D + ((512 * i + 8 * F.lane) & 1023)) = o;
            xp[ii] = xc[ii]; xc[ii] = xn[ii]; xn[ii] = xnn[ii];
        }
    }
}

constexpr int NCHK = 68, NTASK = NB * 8 * NCHK * 2;
constexpr int TAB_OFF = RING_BYTES + 1024;
typedef short s16x4 __attribute__((ext_vector_type(4)));
typedef short v4i16_t __attribute__((ext_vector_type(4)));
__device__ __forceinline__ size_t gdn_tok0(int b, int cidx) { return cidx < 4 ? (size_t)MLAT + b * CTXL + cidx * 64 : (size_t)b * SEQ + (size_t)(cidx - 4) * 64; }
__device__ __forceinline__ bf16x8 tr_pair(const LAS unsigned char* p, int rowstride4) {
    const s16x4 lo = __builtin_bit_cast(s16x4, __builtin_amdgcn_ds_read_tr16_b64_v4i16((LAS v4i16_t*)p));
    const s16x4 hi = __builtin_bit_cast(s16x4, __builtin_amdgcn_ds_read_tr16_b64_v4i16((LAS v4i16_t*)(p + rowstride4)));
    return (bf16x8){lo[0], lo[1], lo[2], lo[3], hi[0], hi[1], hi[2], hi[3]};
}
__device__ __forceinline__ void st_acc_T(LAS unsigned char* base, int stride, int col, int row0, const f32x16& a, int hh) {
#pragma unroll
    for (int rq = 0; rq < 4; ++rq) { v2u w; w.x = cvtpk(a[4 * rq], a[4 * rq + 1]); w.y = cvtpk(a[4 * rq + 2], a[4 * rq + 3]); *(LAS v2u*)(base + col * stride + (row0 + 8 * rq + 4 * hh) * 2) = w; }
}

__device__ __forceinline__ void phase_gdn_prep(const Frame& F, const Args& A) {
    const bf16* QN = (const bf16*)(A.ws + WS_QN); const bf16* KN = (const bf16*)(A.ws + WS_KN);
    const float* Gb = (const float*)(A.ws + WS_G); const float* Bb = (const float*)(A.ws + WS_BETA);
    bf16* TB = (bf16*)(A.ws + WS_TB); bf16* TG = (bf16*)(A.ws + WS_TG); bf16* QKD = (bf16*)(A.ws + WS_QKD); float* GC = (float*)(A.ws + WS_GC);
    LAS float* As = (LAS float*)(F.lds + F.wave * 16384);
    LAS float* tab = (LAS float*)(F.lds + TAB_OFF + F.wave * 512);
    const int gw = F.vcu * NWAVES + F.wave, NGW = F.G * NWAVES;
    for (int task = gw; task < NTASK; task += NGW) {
        int ln = F.lane; asm volatile("" : "+v"(ln));
        const int r = ln & 31, hh = ln >> 5;
        const int dir = task & 1, t2 = task >> 1, cidx = t2 % NCHK, bh = t2 / NCHK, h = bh & 7, b = bh >> 3;
        const size_t m0 = gdn_tok0(b, cidx);
        { const size_t mi = m0 + (dir ? 63 - ln : ln);
          float gc = Gb[mi * 16 + dir * 8 + h]; const float bt = Bb[mi * 16 + dir * 8 + h];
#pragma unroll
          for (int o = 1; o < 64; o <<= 1) { const float t = __shfl_up(gc, o); if (ln >= o) gc += t; }
          tab[ln] = gc; tab[64 + ln] = bt; GC[(size_t)task * 64 + ln] = gc; }
        bf16x8 kf[2][8], qf[2][8];
        LAS unsigned char* tl8 = (LAS unsigned char*)As;
        const int l4 = ln >> 4, l15 = ln & 15, rr = ln & 31, h2 = ln >> 5;
#pragma unroll
        for (int which = 0; which < 2; ++which) { const bf16* src = which ? KN : QN;
#pragma unroll
            for (int hb = 0; hb < 2; ++hb) { v4u st[8];
#pragma unroll
                for (int i = 0; i < 8; ++i) { const int row = 32 * hb + 4 * i + l4; const size_t m = m0 + (dir ? 63 - row : row); st[i] = *(const v4u*)(src + m * D + h * 128 + l15 * 8); }
#pragma unroll
                for (int i = 0; i < 8; ++i) { const int row = 32 * hb + 4 * i + l4; *(LAS v4u*)(tl8 + (row * 16 + (l15 ^ (row & 15))) * 16) = st[i]; }
                asm volatile("" ::: "memory"); }
            LDS_WAIT();
#pragma unroll
            for (int ti = 0; ti < 2; ++ti) { const int row = 32 * ti + rr;
#pragma unroll
                for (int s = 0; s < 8; ++s) { const bf16x8 f = *(const LAS bf16x8*)(tl8 + (row * 16 + ((2 * s + h2) ^ (row & 15))) * 16); if (which) kf[ti][s] = f; else qf[ti][s] = f; } }
            LDS_WAIT();
        }
#pragma unroll
        for (int tile = 0; tile < 3; ++tile) { const int ti = tile == 0 ? 0 : 1, tj = tile == 2 ? 1 : 0;
            f32x16 acc;
#pragma unroll
            for (int i = 0; i < 16; ++i) acc[i] = 0.f;
#pragma unroll
            for (int s = 0; s < 8; ++s) acc = MFMA32(kf[ti][s], kf[tj][s], acc);
            const int j = 32 * tj + r; const float gcj = tab[j];
#pragma unroll
            for (int i16 = 0; i16 < 16; ++i16) { const int i = 32 * ti + (i16 & 3) + 8 * (i16 >> 2) + 4 * hh;
                As[i * 64 + ((((j >> 2) ^ (i & 15)) << 2) | (j & 3))] = (i > j) ? tab[64 + i] * acc[i16] * __expf(tab[i] - gcj) : 0.f; } }
        bf16* qkd = QKD + (size_t)task * 4096;
#pragma unroll
        for (int ti = 0; ti < 2; ++ti) { const int row = 32 * ti + r;
            const float gci = tab[row];
#pragma unroll
            for (int tj = 0; tj < 2; ++tj) {
                if (tj > ti) { *(v4u*)(qkd + row * 64 + 32 + 16 * hh) = (v4u){0u, 0u, 0u, 0u}; *(v4u*)(qkd + row * 64 + 32 + 16 * hh + 8) = (v4u){0u, 0u, 0u, 0u}; continue; }
                f32x16 acc;
#pragma unroll
                for (int i = 0; i < 16; ++i) acc[i] = 0.f;
#pragma unroll
                for (int s = 0; s < 8; ++s) acc = MFMA32(kf[tj][s], qf[ti][s], acc);
#pragma unroll
                for (int rq = 0; rq < 4; ++rq) { const int j0 = 32 * tj + 8 * rq + 4 * hh; float v[4];
#pragma unroll
                    for (int e = 0; e < 4; ++e) { const int j = j0 + e; v[e] = (row >= j) ? acc[4 * rq + e] * __expf(gci - tab[j]) : 0.f; }
                    v2u w; w.x = cvtpk(v[0], v[1]); w.y = cvtpk(v[2], v[3]); *(v2u*)(qkd + row * 64 + j0) = w; }
            } }
        LDS_WAIT();
        LAS unsigned char* Tr = tl8;
        LAS unsigned char* Tcb = tl8 + 8192;
#define PREP_LDA8(DST, ROW, G0) do { const int row_ = (ROW); const f32x4 a_ = *(const LAS f32x4*)(As + row_ * 64 + ((((G0)) ^ (row_ & 15)) << 2)); const f32x4 b_ = *(const LAS f32x4*)(As + row_ * 64 + ((((G0) + 1) ^ (row_ & 15)) << 2)); \
            v4u w_; w_.x = cvtpk(a_.x, a_.y); w_.y = cvtpk(a_.z, a_.w); w_.z = cvtpk(b_.x, b_.y); w_.w = cvtpk(b_.z, b_.w); DST = __builtin_bit_cast(bf16x8, w_); } while (0)
        bf16x8 L64[2], L32[2];
#pragma unroll
        for (int ks = 0; ks < 2; ++ks) PREP_LDA8(L64[ks], 32 + r, 4 * ks + 2 * hh);
#pragma unroll
        for (int q = 0; q < 2; ++q) { PREP_LDA8(L32[q], 32 * q + r, 8 * q + 2 * hh); if (r < 16) L32[q] = (bf16x8){0, 0, 0, 0, 0, 0, 0, 0}; }
#undef PREP_LDA8
        const int dblk = ln >> 4, cl = ln & 15;
        float x[16];
#pragma unroll
        for (int i = 0; i < 16; ++i) { float acc = (cl == i) ? 1.f : 0.f;
#pragma unroll
            for (int jq = 0; jq < (i + 3) / 4; ++jq) { const f32x4 a4 = *(const LAS f32x4*)(As + (16 * dblk + i) * 64 + (((4 * dblk + jq) ^ i) << 2));
                if (4 * jq + 0 < i) acc -= a4.x * x[4 * jq + 0];
                if (4 * jq + 1 < i) acc -= a4.y * x[4 * jq + 1];
                if (4 * jq + 2 < i) acc -= a4.z * x[4 * jq + 2];
                if (4 * jq + 3 < i) acc -= a4.w * x[4 * jq + 3]; }
            x[i] = acc; }
        LDS_WAIT();
        { v4u w0, w1; w0.x = cvtpk(x[0], x[1]); w0.y = cvtpk(x[2], x[3]); w0.z = cvtpk(x[4], x[5]); w0.w = cvtpk(x[6], x[7]); w1.x = cvtpk(x[8], x[9]); w1.y = cvtpk(x[10], x[11]); w1.z = cvtpk(x[12], x[13]); w1.w = cvtpk(x[14], x[15]);
          *(LAS v4u*)(Tcb + ln * 128 + (((2 * dblk) ^ (ln & 7)) << 4)) = w0; *(LAS v4u*)(Tcb + ln * 128 + (((2 * dblk + 1) ^ (ln & 7)) << 4)) = w1;
#pragma unroll
          for (int i = 0; i < 16; ++i) { const int row = 16 * dblk + i; *(LAS unsigned short*)(Tr + row * 128 + (((ln >> 3) ^ (i & 7)) << 4) + (ln & 7) * 2) = (unsigned short)(cvtpk(x[i], 0.f) & 0xffffu); } }
        LDS_WAIT();
#pragma unroll
        for (int q = 0; q < 2; ++q) {
            v4u bz = (v4u){0u, 0u, 0u, 0u};
            if (r < 16) bz = *(const LAS v4u*)(Tcb + (32 * q + r) * 128 + (((4 * q + hh) ^ (r & 7)) << 4));
            f32x16 W;
#pragma unroll
            for (int i = 0; i < 16; ++i) W[i] = 0.f;
            W = MFMA32(L32[q], __builtin_bit_cast(bf16x8, bz), W);
            v4u pw; pw.x = cvtpk(W[8], W[9]); pw.y = cvtpk(W[10], W[11]); pw.z = cvtpk(W[12], W[13]); pw.w = cvtpk(W[14], W[15]);
            v2u lo = (v2u){0u, 0u}, hi = lo;
            if (r >= 16) { const LAS unsigned char* rowp = Tr + (32 * q + r) * 128; lo = *(const LAS v2u*)(rowp + (((4 * q + 2) ^ (r & 7)) << 4) + 8 * hh); hi = *(const LAS v2u*)(rowp + (((4 * q + 3) ^ (r & 7)) << 4) + 8 * hh); }
            f32x16 Y;
#pragma unroll
            for (int i = 0; i < 16; ++i) Y[i] = 0.f;
            Y = MFMA32(__builtin_bit_cast(bf16x8, ((v4u){lo.x, lo.y, hi.x, hi.y})), __builtin_bit_cast(bf16x8, pw), Y);
            if (r < 16) {
#pragma unroll
                for (int rq = 2; rq < 4; ++rq) { v2u w; w.x = cvtpk(-Y[4 * rq], -Y[4 * rq + 1]); w.y = cvtpk(-Y[4 * rq + 2], -Y[4 * rq + 3]); *(LAS v2u*)(Tcb + (32 * q + r) * 128 + (((4 * q + rq) ^ (r & 7)) << 4) + 8 * hh) = w; }
#pragma unroll
                for (int i = 8; i < 16; ++i) { const int row = 32 * q + (i & 3) + 8 * (i >> 2) + 4 * hh; *(LAS unsigned short*)(Tr + row * 128 + (((4 * q + (r >> 3)) ^ (row & 7)) << 4) + (r & 7) * 2) = (unsigned short)(cvtpk(-Y[i], 0.f) & 0xffffu); }
            }
        }
        LDS_WAIT();
        { f32x16 W;
#pragma unroll
          for (int i = 0; i < 16; ++i) W[i] = 0.f;
#pragma unroll
          for (int ks = 0; ks < 2; ++ks) { v4u bz = (v4u){0u, 0u, 0u, 0u}; if (ks >= (r >> 4)) bz = *(const LAS v4u*)(Tcb + r * 128 + (((2 * ks + hh) ^ (r & 7)) << 4)); W = MFMA32(L64[ks], __builtin_bit_cast(bf16x8, bz), W); }
          f32x16 Y;
#pragma unroll
          for (int i = 0; i < 16; ++i) Y[i] = 0.f;
#pragma unroll
          for (int sq = 0; sq < 2; ++sq) { v4u pw; pw.x = cvtpk(W[8 * sq], W[8 * sq + 1]); pw.y = cvtpk(W[8 * sq + 2], W[8 * sq + 3]); pw.z = cvtpk(W[8 * sq + 4], W[8 * sq + 5]); pw.w = cvtpk(W[8 * sq + 6], W[8 * sq + 7]);
              v2u lo = (v2u){0u, 0u}, hi = lo;
              if (sq <= (r >> 4)) { const LAS unsigned char* rowp = Tr + (32 + r) * 128; lo = *(const LAS v2u*)(rowp + (((4 + 2 * sq) ^ (r & 7)) << 4) + 8 * hh); hi = *(const LAS v2u*)(rowp + (((5 + 2 * sq) ^ (r & 7)) << 4) + 8 * hh); }
              Y = MFMA32(__builtin_bit_cast(bf16x8, ((v4u){lo.x, lo.y, hi.x, hi.y})), __builtin_bit_cast(bf16x8, pw), Y); }
#pragma unroll
          for (int i = 0; i < 16; ++i) { const int row = 32 + (i & 3) + 8 * (i >> 2) + 4 * hh; *(LAS unsigned short*)(Tr + row * 128 + (((r >> 3) ^ (row & 7)) << 4) + (r & 7) * 2) = (unsigned short)(cvtpk(-Y[i], 0.f) & 0xffffu); } }
        LDS_WAIT();
        { const int cch = ln & 7, rb = ln >> 3;
          float sbv[8], sgv[8];
#pragma unroll
          for (int e = 0; e < 8; ++e) { const float bt = tab[64 + 8 * cch + e]; sbv[e] = bt; sgv[e] = -bt * __expf(tab[8 * cch + e]); }
          bf16* tb = TB + (size_t)task * 4096 + 8 * cch; bf16* tg = TG + (size_t)task * 4096 + 8 * cch;
#pragma unroll
          for (int it = 0; it < 8; ++it) { const int row = rb + 8 * it;
              v4u t = (v4u){0u, 0u, 0u, 0u};
              if ((cch >> 1) <= (it >> 1)) t = *(const LAS v4u*)(Tr + row * 128 + ((cch ^ rb) << 4));
              const float f0 = bflo(t.x), f1 = bfhi(t.x), f2 = bflo(t.y), f3 = bfhi(t.y), f4 = bflo(t.z), f5 = bfhi(t.z), f6 = bflo(t.w), f7 = bfhi(t.w);
              v4u o; o.x = cvtpk(f0 * sbv[0], f1 * sbv[1]); o.y = cvtpk(f2 * sbv[2], f3 * sbv[3]); o.z = cvtpk(f4 * sbv[4], f5 * sbv[5]); o.w = cvtpk(f6 * sbv[6], f7 * sbv[7]);
              *(v4u*)(tb + row * 64) = o;
              o.x = cvtpk(f0 * sgv[0], f1 * sgv[1]); o.y = cvtpk(f2 * sgv[2], f3 * sgv[3]); o.z = cvtpk(f4 * sgv[4], f5 * sgv[5]); o.w = cvtpk(f6 * sgv[6], f7 * sgv[7]);
              *(v4u*)(tg + row * 64) = o; } }
        LDS_WAIT();
    }
    if (F.G == 256 && F.vcu >= 64) tr_moe_items(F, A.in[26], A.in[27], A.in[28], A.ws + WS_WGU1, A.ws + WS_WD1, L1_ATT + L1_G2 + L1_WIN + L1_CMB, L1_ATT + L1_G2 + L1_WIN + L1_CMB + L1_PREP, (F.vcu - 64) * NWAVES + F.wave, 192 * NWAVES);
    else if (F.G != 256) tr_moe_items(F, A.in[26], A.in[27], A.in[28], A.ws + WS_WGU1, A.ws + WS_WD1, L1_ATT + L1_G2 + L1_WIN + L1_CMB, L1_ATT + L1_G2 + L1_WIN + L1_CMB + L1_PREP, F.vcu * NWAVES + F.wave, F.G * NWAVES);
}

constexpr int G_QS = 0, G_KS = 17408, G_VS = 37888, G_TBS = 50176, G_TGS = 59392, G_QKS = 68608, G_WS = 77824, G_SS = 95232, G_VNS = 112640, G_VSS = 121856;
constexpr int G_SQ = 272, G_SK = 320, G_SV = 192, G_ST = 144;
__device__ __forceinline__ void phase_gdn_scan(const Frame& F, const Args& A) {
    const bf16* QN = (const bf16*)(A.ws + WS_QN); const bf16* KN = (const bf16*)(A.ws + WS_KN); const bf16* VV = (const bf16*)(A.ws + WS_VV);
    const bf16* TB = (const bf16*)(A.ws + WS_TB); const bf16* TG = (const bf16*)(A.ws + WS_TG); const bf16* QKD = (const bf16*)(A.ws + WS_QKD); const float* GC = (const float*)(A.ws + WS_GC);
    bf16* OF = (bf16*)A.out; bf16* OB = OF + (size_t)MLAT * D;
    LAS unsigned char* L = F.lds; LAS float* tab = (LAS float*)(F.lds + TAB_OFF);
    const int w = F.wave, r = F.lane & 31, hh = F.lane >> 5, g16 = F.lane >> 4, q4 = (F.lane & 15) >> 2, p4 = F.lane & 3;
    const int dkt = w >> 1, tt1 = w & 1, dvtS = w & 1;
    const int ttv = (w & 3) >> 1, dvtv = w & 1;
    const int dvto = (w & 3) >> 1, tto = w & 1;
    const int trrow = 8 * (g16 >> 1) + q4, trcol = 16 * (g16 & 1) + 4 * p4;
    for (int unit = F.vcu; unit < 256; unit += F.G) {
        const int half = unit & 1, dir = (unit >> 1) & 1, h = (unit >> 2) & 7, b = unit >> 5;
        bf16* O = dir ? OB : OF;
        f32x16 accS;
#pragma unroll
        for (int i = 0; i < 16; ++i) accS[i] = 0.f;
        v4u pre[8]; float gcv = 0.f, gcl = 0.f;
#define GDN_LOAD_A(S_) do { const int cidx_ = dir ? ((S_) < 4 ? 3 - (S_) : 71 - (S_)) : (S_); const size_t m0_ = gdn_tok0(b, cidx_); const size_t task_ = ((size_t)((b * 8 + h) * NCHK + cidx_)) * 2 + dir; \
        _Pragma("unroll") for (int e_ = 0; e_ < 2; ++e_) { const int ci_ = F.tid + 512 * e_, row_ = ci_ >> 4, c16_ = ci_ & 15; const size_t m_ = m0_ + (dir ? 63 - row_ : row_); \
            pre[2 + e_] = *(const v4u*)(KN + m_ * D + h * 128 + c16_ * 8); } \
        { const int row_ = F.tid >> 3, c16_ = F.tid & 7; const size_t m_ = m0_ + (dir ? 63 - row_ : row_); pre[4] = *(const v4u*)(VV + m_ * D + h * 128 + half * 64 + c16_ * 8); \
          pre[5] = *(const v4u*)(TB + task_ * 4096 + F.tid * 8); pre[6] = *(const v4u*)(TG + task_ * 4096 + F.tid * 8); } } while (0)
#define GDN_LOAD_B(S_) do { const int cidx_ = dir ? ((S_) < 4 ? 3 - (S_) : 71 - (S_)) : (S_); const size_t m0_ = gdn_tok0(b, cidx_); const size_t task_ = ((size_t)((b * 8 + h) * NCHK + cidx_)) * 2 + dir; \
        _Pragma("unroll") for (int e_ = 0; e_ < 2; ++e_) { const int ci_ = F.tid + 512 * e_, row_ = ci_ >> 4, c16_ = ci_ & 15; const size_t m_ = m0_ + (dir ? 63 - row_ : row_); \
            pre[e_] = *(const v4u*)(QN + m_ * D + h * 128 + c16_ * 8); } \
        pre[7] = *(const v4u*)(QKD + task_ * 4096 + F.tid * 8); \
        gcv = GC[task_ * 64 + (F.tid & 63)]; gcl = GC[task_ * 64 + 63]; } while (0)
#define GDN_LOAD(S_) do { GDN_LOAD_A(S_); GDN_LOAD_B(S_); } while (0)
#define GDN_STAGE() do { \
        _Pragma("unroll") for (int e_ = 0; e_ < 2; ++e_) { const int ci_ = F.tid + 512 * e_, row_ = ci_ >> 4, c16_ = ci_ & 15; \
            *(LAS v4u*)(L + G_QS + row_ * G_SQ + c16_ * 16) = pre[e_]; *(LAS v4u*)(L + G_KS + row_ * G_SK + c16_ * 16) = pre[2 + e_]; } \
        { const int row_ = F.tid >> 3, c16_ = F.tid & 7; *(LAS v4u*)(L + G_VS + row_ * G_SV + c16_ * 16) = pre[4]; \
          *(LAS v4u*)(L + G_TBS + row_ * G_ST + c16_ * 16) = pre[5]; *(LAS v4u*)(L + G_TGS + row_ * G_ST + c16_ * 16) = pre[6]; *(LAS v4u*)(L + G_QKS + row_ * G_ST + c16_ * 16) = pre[7]; } \
        if (F.tid < 64) { tab[F.tid] = __expf(gcv); tab[64 + F.tid] = __expf(gcl - gcv); if (F.tid == 0) tab[128] = __expf(gcl); } } while (0)
#define GDN_STAGE_A() do { \
        _Pragma("unroll") for (int e_ = 0; e_ < 2; ++e_) { const int ci_ = F.tid + 512 * e_, row_ = ci_ >> 4, c16_ = ci_ & 15; *(LAS v4u*)(L + G_KS + row_ * G_SK + c16_ * 16) = pre[2 + e_]; } \
        { const int row_ = F.tid >> 3, c16_ = F.tid & 7; *(LAS v4u*)(L + G_VS + row_ * G_SV + c16_ * 16) = pre[4]; \
          *(LAS v4u*)(L + G_TBS + row_ * G_ST + c16_ * 16) = pre[5]; *(LAS v4u*)(L + G_TGS + row_ * G_ST + c16_ * 16) = pre[6]; } } while (0)
#define GDN_STAGE_B() do { \
        _Pragma("unroll") for (int e_ = 0; e_ < 2; ++e_) { const int ci_ = F.tid + 512 * e_, row_ = ci_ >> 4, c16_ = ci_ & 15; *(LAS v4u*)(L + G_QS + row_ * G_SQ + c16_ * 16) = pre[e_]; } \
        { const int row_ = F.tid >> 3, c16_ = F.tid & 7; *(LAS v4u*)(L + G_QKS + row_ * G_ST + c16_ * 16) = pre[7]; } \
        if (F.tid < 64) { tab[F.tid] = __expf(gcv); tab[64 + F.tid] = __expf(gcl - gcv); if (F.tid == 0) tab[128] = __expf(gcl); } } while (0)
        GDN_LOAD(0); GDN_STAGE();
        GDN_LOAD(1);
        __syncthreads();
        for (int s = 0; s < NCHK; ++s) {
            const int cidx = dir ? (s < 4 ? 3 - s : 71 - s) : s; const size_t m0 = gdn_tok0(b, cidx);
            bf16x8 kT[4];
#pragma unroll
            for (int ks = 0; ks < 4; ++ks) kT[ks] = tr_pair(L + G_KS + (16 * ks + trrow) * G_SK + (32 * dkt + trcol) * 2, 4 * G_SK);
            { f32x16 accw;
#pragma unroll
              for (int i = 0; i < 16; ++i) accw[i] = 0.f;
#pragma unroll
              for (int ks = 0; ks < 4; ++ks) { const bf16x8 bq = *(const LAS bf16x8*)(L + G_TGS + (32 * tt1 + r) * G_ST + (16 * ks + 8 * hh) * 2); accw = MFMA32(kT[ks], bq, accw); }
              st_acc_T(L + G_WS, G_SQ, 32 * tt1 + r, 32 * dkt, accw, hh); }
            f32x16 accv;
#pragma unroll
            for (int i = 0; i < 16; ++i) accv[i] = 0.f;
            if (w < 4) {
#pragma unroll
                for (int ks = 0; ks < 4; ++ks) { const bf16x8 a = *(const LAS bf16x8*)(L + G_TBS + (32 * ttv + r) * G_ST + (16 * ks + 8 * hh) * 2);
                    const bf16x8 bv = tr_pair(L + G_VS + (16 * ks + trrow) * G_SV + (32 * dvtv + trcol) * 2, 4 * G_SV); accv = MFMA32(a, bv, accv); }
            }
            st_acc_T(L + G_SS, G_SQ, 32 * dvtS + r, 32 * dkt, accS, hh);
            __syncthreads();
            if (s + 1 < NCHK) GDN_STAGE_A();
            if (s + 2 < NCHK) GDN_LOAD_A(s + 2);
            f32x16 acco;
#pragma unroll
            for (int i = 0; i < 16; ++i) acco[i] = 0.f;
            if (w < 4) {
#pragma unroll
                for (int ks = 0; ks < 8; ++ks) { const bf16x8 a = *(const LAS bf16x8*)(L + G_WS + (32 * ttv + r) * G_SQ + (16 * ks + 8 * hh) * 2);
                    const bf16x8 bs = *(const LAS bf16x8*)(L + G_SS + (32 * dvtv + r) * G_SQ + (16 * ks + 8 * hh) * 2); accv = MFMA32(a, bs, accv); }
                st_acc_T(L + G_VNS, G_ST, 32 * dvtv + r, 32 * ttv, accv, hh);
                f32x16 sc;
#pragma unroll
                for (int rq = 0; rq < 4; ++rq) { const f32x4 e4 = *(const LAS f32x4*)(tab + 64 + 32 * ttv + 8 * rq + 4 * hh);
                    sc[4 * rq] = accv[4 * rq] * e4.x; sc[4 * rq + 1] = accv[4 * rq + 1] * e4.y; sc[4 * rq + 2] = accv[4 * rq + 2] * e4.z; sc[4 * rq + 3] = accv[4 * rq + 3] * e4.w; }
                st_acc_T(L + G_VSS, G_ST, 32 * dvtv + r, 32 * ttv, sc, hh);
            } else {
#pragma unroll
                for (int ks = 0; ks < 8; ++ks) { const bf16x8 a = *(const LAS bf16x8*)(L + G_SS + (32 * dvto + r) * G_SQ + (16 * ks + 8 * hh) * 2);
                    const bf16x8 bq = *(const LAS bf16x8*)(L + G_QS + (32 * tto + r) * G_SQ + (16 * ks + 8 * hh) * 2); acco = MFMA32(a, bq, acco); }
                const float egi = tab[32 * tto + r];
#pragma unroll
                for (int i = 0; i < 16; ++i) acco[i] *= egi;
            }
            __syncthreads();
            if (w >= 4) {
#pragma unroll
                for (int ks = 0; ks < 4; ++ks) { const bf16x8 a = *(const LAS bf16x8*)(L + G_VNS + (32 * dvto + r) * G_ST + (16 * ks + 8 * hh) * 2);
                    const bf16x8 bq = *(const LAS bf16x8*)(L + G_QKS + (32 * tto + r) * G_ST + (16 * ks + 8 * hh) * 2); acco = MFMA32(a, bq, acco); }
                if (cidx >= 4) { const int i = 32 * tto + r; const size_t m = m0 + (dir ? 63 - i : i);
                    bf16* op = O + m * D + h * 128 + half * 64 + 32 * dvto + 4 * hh;
#pragma unroll
                    for (int rq = 0; rq < 4; ++rq) { v2u ww; ww.x = cvtpk(acco[4 * rq], acco[4 * rq + 1]); ww.y = cvtpk(acco[4 * rq + 2], acco[4 * rq + 3]); *(v2u*)(op + 8 * rq) = ww; } }
            }
            { const float egl = tab[128];
#pragma unroll
              for (int i = 0; i < 16; ++i) accS[i] *= egl;
#pragma unroll
              for (int ks = 0; ks < 4; ++ks) { const bf16x8 bv = *(const LAS bf16x8*)(L + G_VSS + (32 * dvtS + r) * G_ST + (16 * ks + 8 * hh) * 2); accS = MFMA32(kT[ks], bv, accS); } }
            __syncthreads();
            if (s + 1 < NCHK) GDN_STAGE_B();
            if (s + 2 < NCHK) GDN_LOAD_B(s + 2);
        }
        __syncthreads();
#undef GDN_LOAD
#undef GDN_LOAD_A
#undef GDN_LOAD_B
#undef GDN_STAGE
#undef GDN_STAGE_A
#undef GDN_STAGE_B
    }
}

__device__ __forceinline__ void phase_readout(const Frame& F, const Args& A) {
    const int gw = F.vcu * NWAVES + F.wave, NGW = F.G * NWAVES;
    const bf16* OF = (const bf16*)A.out; const bf16* OB = OF + (size_t)MLAT * D; const bf16* Z = (const bf16*)(A.ws + WS_Z); bf16* RO = (bf16*)(A.ws + WS_RO);
    const f32x4 on = ((const f32x4*)A.in[22])[F.lane & 31];
    const int rpw = (MLAT + NGW - 1) / NGW;
    const int mbeg = gw * rpw, cnt = (MLAT - mbeg) < rpw ? (MLAT - mbeg) : rpw;
    for (int r = 0; r < cnt; r += 2) {
        v2u wf[2][4], wb[2][4], zw[2][4];
#pragma unroll
        for (int t = 0; t < 2; ++t) { const int m = mbeg + ((r + t < cnt) ? r + t : r);
#pragma unroll
            for (int j = 0; j < 4; ++j) { wf[t][j] = ((const v2u*)(OF + (size_t)m * D))[F.lane + 64 * j]; wb[t][j] = ((const v2u*)(OB + (size_t)m * D))[F.lane + 64 * j]; zw[t][j] = ((const v2u*)(Z + (size_t)m * D))[F.lane + 64 * j]; } }
#pragma unroll
        for (int t = 0; t < 2; ++t) { const int m = mbeg + r + t;
            f32x4 v[4];
#pragma unroll
            for (int j = 0; j < 4; ++j) {
                v[j] = (f32x4){bflo(wf[t][j].x) + bflo(wb[t][j].x), bfhi(wf[t][j].x) + bfhi(wb[t][j].x), bflo(wf[t][j].y) + bflo(wb[t][j].y), bfhi(wf[t][j].y) + bfhi(wb[t][j].y)};
                float ss = (v[j].x * v[j].x + v[j].y * v[j].y) + (v[j].z * v[j].z + v[j].w * v[j].w);
                ss += __shfl_xor(ss, 1); ss += __shfl_xor(ss, 2); ss += __shfl_xor(ss, 4); ss += __shfl_xor(ss, 8); ss += __shfl_xor(ss, 16);
                const float rs = 1.0f / sqrtf(ss * (1.0f / 128.0f) + EPS);
                v[j].x = v[j].x * rs * on.x * silu_f(bflo(zw[t][j].x)); v[j].y = v[j].y * rs * on.y * silu_f(bfhi(zw[t][j].x)); v[j].z = v[j].z * rs * on.z * silu_f(bflo(zw[t][j].y)); v[j].w = v[j].w * rs * on.w * silu_f(bfhi(zw[t][j].y)); }
            if (r + t < cnt) store_row_bf16(RO + (size_t)m * D, v, F.lane); }
    }
}


struct EpiNull { static constexpr bool PERM = false, AFTER_DRAIN = false; float* sink;
    __device__ __forceinline__ void operator()(const f32x4 (&acc)[2][2][4][2], const pg8::Unit&, int, int, int, int) const { float s = 0.f;
#pragma unroll
        for (int a = 0; a < 2; ++a)
#pragma unroll
            for (int b = 0; b < 2; ++b)
#pragma unroll
                for (int mm = 0; mm < 4; ++mm)
#pragma unroll
                    for (int n = 0; n < 2; ++n) s += acc[a][b][mm][n][0] + acc[a][b][mm][n][3];
        if (s == 12345.678f) sink[threadIdx.x] = s; }
};
struct ProbeOrder { int nunits, nM, G, c, mode;
    __device__ void init(int nunits_, int nM_, int G_, int c_, int mode_) { nunits = nunits_; nM = nM_; G = G_; c = c_; mode = mode_; }
    __device__ bool next(int i, pg8::Unit& u) const { const int L = i * G + c; if (L >= nunits) return false; if (mode == 0) { u.pm = L % nM; u.pn = L / nM; } else if (mode == 1) { u.pm = 0; u.pn = 0; } else { u.pm = L % nM; u.pn = 0; } return true; }
    __device__ __forceinline__ void a_ready(const pg8::Unit&) const {}
    __device__ __forceinline__ void done(const pg8::Unit&) const {}
    __device__ __forceinline__ const char* aptr(const pg8::Gemm& g, const pg8::Unit& u, size_t tstep) const { return (const char*)g.A + (size_t)u.pm * tstep; }
    __device__ __forceinline__ const char* bptr(const pg8::Gemm& g, const pg8::Unit& u, size_t tstep) const { return (const char*)g.Bt + (size_t)u.pn * tstep; }
};
__device__ __forceinline__ void phase_final(const Frame& F, const Args& A) {
    const int gw = F.vcu * NWAVES + F.wave, NGW = F.G * NWAVES;
    const float* MOD1 = (const float*)(A.ws + WS_MOD) + 9 * 6144;
    const bf16* XRES = (const bf16*)(A.ws + WS_XRES); const bf16* Y = (const bf16*)(A.ws + WS_XG); const int* SLOT = (const int*)(A.ws + WS_SLOT);
    f32x4 fg[4];
#pragma unroll
    for (int j = 0; j < 4; ++j) fg[j] = ((const f32x4*)A.in[29])[F.lane + 64 * j];
    const int rpw = (MLAT + NGW - 1) / NGW;
    const int mbeg = gw * rpw, cnt = (MLAT - mbeg) < rpw ? (MLAT - mbeg) : rpw;
    for (int r = 0; r < cnt; r += 2) {
        f32x4 vv[2][4]; CombineIn ci[2];
#pragma unroll
        for (int t = 0; t < 2; ++t) { const int m = mbeg + ((r + t < cnt) ? r + t : r); combine_issue(ci[t], XRES + (size_t)m * D, SLOT + (size_t)m * 16, F.lane); }
#pragma unroll
        for (int t = 0; t < 2; ++t) { const int m = mbeg + ((r + t < cnt) ? r + t : r);
            combine_finish(vv[t], ci[t], Y, (const float*)(A.ws + WS_GW), MOD1 + (size_t)(m >> 12) * 6144 + 5 * 1024, F.lane); }
#pragma unroll
        for (int t = 0; t < 2; ++t) { const int m = mbeg + r + t; const float rstd = row_rstd(vv[t]);
            if (r + t < cnt) {
#pragma unroll
                for (int j = 0; j < 4; ++j) ((f32x4*)(A.out + (size_t)m * D))[F.lane + 64 * j] = vv[t][j] * rstd * fg[j]; } }
    }
}

#ifndef MK_ONE_LAUNCH
#define MK_ONE_LAUNCH 1
#endif
__global__ void __launch_bounds__(NWAVES * 64, 2) fwd_kernel(Args args) {
    extern __shared__ __attribute__((aligned(16))) unsigned char lds[];
    Frame F;
    F.lds = (LAS unsigned char*)lds;
    F.MISC = (volatile LAS unsigned*)(F.lds + MISC_OFF);
    F.tid = threadIdx.x; F.lane = F.tid & 63; F.wave = __builtin_amdgcn_readfirstlane(F.tid >> 6);
    F.G = gridDim.x; { const int bx = blockIdx.x; F.vcu = (F.G % 8 == 0) ? (bx % 8) * (F.G / 8) + bx / 8 : bx; }
    unsigned char* ws = args.ws;
    gu32* ctl = (gu32*)(ws + WS_CTL);
    for (int u = F.tid; u < (LDS_BYTES - LDSCTL_OFF) / 4; u += NWAVES * 64) ((LAS unsigned*)(F.lds + LDSCTL_OFF))[u] = 0u;
    __syncthreads();
    XcdBarrier bar; bar.bar = (unsigned*)(ctl + CW_BAR); bar.x = 0; bar.st = nullptr;
    const int lo = args.ph_lo, hi = args.ph_hi;
    if (hi - lo > 1) bar = xcd_barrier_post((unsigned*)(ctl + CW_BAR), F.MISC + 8);
#ifndef PROBE_REP
#define PROBE_REP 0u
#endif
#define IN(k) (lo <= (k) && (k) < hi)
#define SEAM(k) do { if (IN(k) && IN((k) + 1)) xcd_barrier(bar); } while (0)

    const float* MOD0 = (const float*)(ws + WS_MOD); const float* MOD1 = MOD0 + 9 * 6144;
    bf16* XRES = (bf16*)(ws + WS_XRES);

    if (IN(0)) { phase_prologue(F, args); } SEAM(0);
    if (IN(1)) { phase_modnorm0(F, args); } SEAM(1);
    if (IN(2)) {
        pg8::Gemm g{(const pg8::bf16_t*)(ws + WS_H), (const pg8::bf16_t*)(ws + WS_WQKV), MTOT, NQKV, D}; QKVOrder S; S.init(F.G, (int)blockIdx.x);
        EpiQKV E{(bf16*)(ws + WS_Q), (bf16*)(ws + WS_K), (bf16*)(ws + WS_V), (const float*)(ws + WS_ROPE), (const float*)(ws + WS_ROPE) + 1024, QSCALE};
        pg8::gemm_phase<EpiQKV, QKVOrder, true, true>(F.lds, g, S, E);
        if (F.G == 256) { const int lid = (int)blockIdx.x / 8, x = (int)blockIdx.x % 8;
            if (lid >= 6) tr_moe_items(F, args.in[12], args.in[13], args.in[14], ws + WS_WGU, ws + WS_WD, L0_PRO, L0_PRO + L0_QKV, (x * 26 + lid - 6) * NWAVES + F.wave, 208 * NWAVES); }
        else tr_moe_items(F, args.in[12], args.in[13], args.in[14], ws + WS_WGU, ws + WS_WD, L0_PRO, L0_PRO + L0_QKV, F.vcu * NWAVES + F.wave, F.G * NWAVES);
    } SEAM(2);
    if (IN(3)) { phase_attn_v2(F, args); } SEAM(3);
    if (IN(4)) {
        pg8::Gemm g{(const pg8::bf16_t*)(ws + WS_ATT), (const pg8::bf16_t*)(ws + WS_WO0), MTOT, D, D}; pg8::StaticOrder S; S.init(MTOT, D, F.G, (int)blockIdx.x);
        EpiResid<false> E{args.in[0], args.in[2], XRES, MOD0 + 2 * 1024};
        pg8::gemm_phase<EpiResid<false>, pg8::StaticOrder, true, true>(F.lds, g, S, E);
        if (F.G == 256) { if (blockIdx.x >= 32) tr_moe_items(F, args.in[12], args.in[13], args.in[14], ws + WS_WGU, ws + WS_WD, L0_PRO + L0_QKV, L0_PRO + L0_QKV + L0_WO, ((int)blockIdx.x - 32) * NWAVES + F.wave, 224 * NWAVES); }
        else tr_moe_items(F, args.in[12], args.in[13], args.in[14], ws + WS_WGU, ws + WS_WD, L0_PRO + L0_QKV, L0_PRO + L0_QKV + L0_WO, F.vcu * NWAVES + F.wave, F.G * NWAVES);
    } SEAM(4);
    if (IN(5)) { phase_norm_router(F, args, XRES, MTOT, args.in[10], MOD0, args.in[11]); } SEAM(5);
    if (IN(6)) { phase_topk(F, args, true, EROWS0, args.in[12], args.in[13], args.in[14], ws + WS_WGU, ws + WS_WD, IT_MOE - L0_TOPK, IT_MOE); } SEAM(6);
    if (IN(7)) {
        pg8::Gemm g{(const pg8::bf16_t*)(ws + WS_XG), (const pg8::bf16_t*)(ws + WS_WGU), NE * EROWS0, NE * 4096, D / 2}; GroupOrder<EROWS0 / 256, 16> S; S.init(F.G, (int)blockIdx.x);
        EpiSwiGLU E{ws + WS_HID};
        pg8::gemm_phase<EpiSwiGLU, decltype(S), true, true, true>(F.lds, g, S, E);
    } SEAM(7);
    if (IN(8)) {
        pg8::Gemm g{(const pg8::bf16_t*)(ws + WS_HID), (const pg8::bf16_t*)(ws + WS_WD), NE * EROWS0, NE * 1024, FF / 2}; GroupOrder<EROWS0 / 256, 4> S; S.init(F.G, (int)blockIdx.x);
        EpiY E{(bf16*)(ws + WS_XG)};
        pg8::gemm_phase<EpiY, decltype(S), true, true, true>(F.lds, g, S, E);
        if (F.G == 256) { const int lid = (int)blockIdx.x / 8, x = (int)blockIdx.x % 8;
            if (lid >= 8) tr_moe_items(F, args.in[26], args.in[27], args.in[28], ws + WS_WGU1, ws + WS_WD1, L1_ATT, L1_ATT + L1_G2, (x * 24 + lid - 8) * NWAVES + F.wave, 192 * NWAVES); }
        else tr_moe_items(F, args.in[26], args.in[27], args.in[28], ws + WS_WGU1, ws + WS_WD1, L1_ATT, L1_ATT + L1_G2, F.vcu * NWAVES + F.wave, F.G * NWAVES);
    } SEAM(8);
    if (IN(9)) { phase_combine0(F, args); } SEAM(9);
    if (IN(10)) {
        pg8::Gemm g{(const pg8::bf16_t*)(ws + WS_H), (const pg8::bf16_t*)(ws + WS_WIN), MTOT, NWIN, D}; pg8::StaticOrder S; S.init(MTOT, NWIN, F.G, (int)blockIdx.x);
        EpiP E{(bf16*)(ws + WS_PQKV), (bf16*)(ws + WS_Z)};
        pg8::gemm_phase<EpiP, pg8::StaticOrder, true, true>(F.lds, g, S, E);
        if (F.G == 256) { if (blockIdx.x >= 128) tr_moe_items(F, args.in[26], args.in[27], args.in[28], ws + WS_WGU1, ws + WS_WD1, L1_ATT + L1_G2, L1_ATT + L1_G2 + L1_WIN, ((int)blockIdx.x - 128) * NWAVES + F.wave, 128 * NWAVES); }
        else tr_moe_items(F, args.in[26], args.in[27], args.in[28], ws + WS_WGU1, ws + WS_WD1, L1_ATT + L1_G2, L1_ATT + L1_G2 + L1_WIN, F.vcu * NWAVES + F.wave, F.G * NWAVES);
    } SEAM(10);
    if (IN(11)) { phase_conv(F, args); } SEAM(11);
    if (IN(12)) { phase_gdn_prep(F, args); } SEAM(12);
    if (IN(13)) { phase_gdn_scan(F, args); } SEAM(13);
    if (IN(14)) { phase_readout(F, args); } SEAM(14);
    if (IN(15)) {
        pg8::Gemm g{(const pg8::bf16_t*)(ws + WS_RO), (const pg8::bf16_t*)(ws + WS_WO1), MLAT, D, D}; pg8::StaticOrder S; S.init(MLAT, D, F.G, (int)blockIdx.x);
        EpiResid<true> E{XRES, XRES + (size_t)MLAT * D, XRES, MOD1 + 2 * 1024};
        pg8::gemm_phase<EpiResid<true>, pg8::StaticOrder, true, true>(F.lds, g, S, E);
    } SEAM(15);
    if (IN(16)) { phase_norm_router(F, args, XRES, MLAT, args.in[24], MOD1, args.in[25]); } SEAM(16);
    if (IN(17)) { phase_topk(F, args, false, EROWS1, args.in[26], args.in[27], args.in[28], ws + WS_WGU1, ws + WS_WD1, IT_MOE - L1_TOPK, IT_MOE); } SEAM(17);
    if (IN(18)) {
        pg8::Gemm g{(const pg8::bf16_t*)(ws + WS_XG), (const pg8::bf16_t*)(ws + WS_WGU1), NE * EROWS1, NE * 4096, D / 2}; GroupOrder<EROWS1 / 256, 16> S; S.init(F.G, (int)blockIdx.x);
        EpiSwiGLU E{ws + WS_HID};
        pg8::gemm_phase<EpiSwiGLU, decltype(S), true, true, true>(F.lds, g, S, E);
    } SEAM(18);
    if (IN(19)) {
        pg8::Gemm g{(const pg8::bf16_t*)(ws + WS_HID), (const pg8::bf16_t*)(ws + WS_WD1), NE * EROWS1, NE * 1024, FF / 2}; GroupOrder<EROWS1 / 256, 4> S; S.init(F.G, (int)blockIdx.x);
        EpiY E{(bf16*)(ws + WS_XG)};
        pg8::gemm_phase<EpiY, decltype(S), true, true, true>(F.lds, g, S, E);
    } SEAM(19);
    if (IN(20)) { phase_final(F, args); }
#ifdef PROBE_GEMM
    if (IN(21)) {
        EpiNull E{(float*)(ws + 960 * MiB)};
#if PROBE_GEMM == 1 || PROBE_GEMM == 2 || PROBE_GEMM == 7
        { pg8::Gemm g{(const pg8::bf16_t*)(ws + WS_H), (const pg8::bf16_t*)(ws + WS_WIN), MTOT, NWIN, D}; ProbeOrder S; S.init(2176, 136, F.G, (int)blockIdx.x, PROBE_GEMM == 1 ? 0 : (PROBE_GEMM == 2 ? 1 : 2));
          pg8::gemm_phase<EpiNull, ProbeOrder, true, true>(F.lds, g, S, E); }
#elif PROBE_GEMM == 8 || PROBE_GEMM == 9
        { pg8::Gemm g{(const pg8::bf16_t*)(ws + WS_H), (const pg8::bf16_t*)(ws + WS_WIN), MTOT, NWIN, PROBE_GEMM == 8 ? 512 : 256}; ProbeOrder S; S.init(2176, 136, F.G, (int)blockIdx.x, 1);
          pg8::gemm_phase<EpiNull, ProbeOrder, true, true>(F.lds, g, S, E); }
#elif PROBE_GEMM == 10 || PROBE_GEMM == 11
        { pg8::Gemm g{(const pg8::bf16_t*)(ws + WS_XG), (const pg8::bf16_t*)(ws + WS_WGU), NE * EROWS0, NE * 4096, PROBE_GEMM == 10 ? 256 : 1024}; ProbeOrder S; S.init(4352, 272, F.G, (int)blockIdx.x, 1);
          pg8::gemm_phase<EpiNull, ProbeOrder, true, true, true>(F.lds, g, S, E); }
#elif PROBE_GEMM == 3 || PROBE_GEMM == 4
        { pg8::Gemm g{(const pg8::bf16_t*)(ws + WS_HID), (const pg8::bf16_t*)(ws + WS_WD), NE * EROWS0, NE * 1024, FF / 2}; ProbeOrder S; S.init(1088, 272, F.G, (int)blockIdx.x, PROBE_GEMM == 3 ? 0 : 1);
          pg8::gemm_phase<EpiNull, ProbeOrder, true, true, true>(F.lds, g, S, E); }
#elif PROBE_GEMM == 5 || PROBE_GEMM == 6
        { pg8::Gemm g{(const pg8::bf16_t*)(ws + WS_XG), (const pg8::bf16_t*)(ws + WS_WGU), NE * EROWS0, NE * 4096, D / 2}; ProbeOrder S; S.init(4352, 272, F.G, (int)blockIdx.x, PROBE_GEMM == 5 ? 0 : 1);
          pg8::gemm_phase<EpiNull, ProbeOrder, true, true, true>(F.lds, g, S, E); }
#endif
    }
#endif
#undef IN
#undef SEAM
}

extern "C" void kernel_launch(void* const* d_in, const int* in_sizes, int n_in, void* d_out, int out_size, void* d_ws, size_t ws_size, hipStream_t stream) {
    static int grid = 0;
    if (grid == 0) {
        if (n_in != 30 || in_sizes[0] != MLAT * D || out_size != MLAT * D || ws_size < WS_END) { fprintf(stderr, "kernel_launch: unexpected shapes (n_in %d, in0 %d, out %d, ws %zu); nothing launched\n", n_in, n_in > 0 ? in_sizes[0] : -1, out_size, ws_size); grid = -1; return; }
        int dev = 0, cus = 0, per_cu = 0;
        if (hipGetDevice(&dev) != hipSuccess || hipDeviceGetAttribute(&cus, hipDeviceAttributeMultiprocessorCount, dev) != hipSuccess) { grid = -1; return; }
        if (hipFuncSetAttribute((const void*)fwd_kernel, hipFuncAttributeMaxDynamicSharedMemorySize, LDS_BYTES) != hipSuccess) { fprintf(stderr, "kernel_launch: hipFuncSetAttribute failed\n"); grid = -1; return; }
        if (hipOccupancyMaxActiveBlocksPerMultiprocessor(&per_cu, (const void*)fwd_kernel, NWAVES * 64, LDS_BYTES) != hipSuccess || per_cu < 1) { fprintf(stderr, "kernel_launch: occupancy query says %d blocks per CU\n", per_cu); }
        (void)hipGetLastError();
        grid = cus;
        if (grid % 8 != 0) { fprintf(stderr, "kernel_launch: CU count %d is not a multiple of 8\n", grid); grid = -1; return; }
    }
    if (grid < 0) return;
    if (hipMemsetAsync((char*)d_ws + WS_CTL, 0, CTL_ZERO_BYTES, stream) != hipSuccess) return;
    Args a{};
    for (int i = 0; i < 30; ++i) a.in[i] = (const float*)d_in[i];
    a.out = (float*)d_out; a.ws = (unsigned char*)d_ws;
#if MK_ONE_LAUNCH
    a.ph_lo = 0; a.ph_hi = NPH;
    hipLaunchKernelGGL(fwd_kernel, dim3(grid), dim3(NWAVES * 64), LDS_BYTES, stream, a);
#else
#ifdef PROBE_GEMM
    const int nph_launch = NPH + 1;
#else
    const int nph_launch = NPH;
#endif
    for (int p = 0; p < nph_launch; ++p) for (int rep = 0; rep < (((PROBE_REP >> p) & 1u) ? 2 : 1); ++rep) { a.ph_lo = p; a.ph_hi = p + 1; hipLaunchKernelGGL(fwd_kernel, dim3(grid), dim3(NWAVES * 64), LDS_BYTES, stream, a); }
#endif
}
```

```cpp
#include <hip/hip_runtime.h>
#include <cstdio>
#include <cstdint>
#define MK_ONE_LAUNCH 1
namespace pg8 {
#define PG8_LAS __attribute__((address_space(3)))
typedef unsigned short bf16_t;
typedef short bf16x8 __attribute__((ext_vector_type(8)));
typedef float f32x4 __attribute__((ext_vector_type(4)));
typedef unsigned u32x4 __attribute__((ext_vector_type(4)));
constexpr int BM = 256, BK = 64, HALF = 128, HTB = HALF * BK * 2  , STAGE_BYTES = 8 * HTB, NXCD = 8, WGM = 8;

__host__ __device__ __forceinline__ int lds_byte(int r, int c) { const int st = (r >> 4) * 2 + (c >> 5), rr = r & 15, cc = c & 31, ob = rr * 64 + cc * 2; return st * 1024 + (ob ^ (((ob >> 9) & 1) << 5)); }
__host__ __device__ __forceinline__ void stage_rc(int b, int& R, int& C) { const int st = b / 1024, sb = b % 1024, swz = sb ^ (((sb >> 9) & 1) << 5); R = (st >> 1) * 16 + swz / 64; C = (st & 1) * 32 + (swz % 64) / 2; }
__host__ __device__ __forceinline__ int perm32(int rho) { const int n = rho >> 4, i = rho & 15; return 8 * (i >> 2) + 4 * n + (i & 3); }

struct Unit { int pm, pn; };
struct Gemm { const bf16_t* A; const bf16_t* Bt; int M, N, K; };

struct StaticOrder {
    int nM, nN, nwg, G, c;
    __host__ __device__ void init(int M, int N, int G_, int c_) { nM = M / BM; nN = N / BM; nwg = nM * nN; G = G_; c = c_; }
    __host__ __device__ bool next(int i, Unit& u) const {
        const long L = (long)i * G + c; if (L >= nwg) return false;
        int wgid = (int)L; { const int q = nwg / NXCD, r = nwg % NXCD, xcd = wgid % NXCD, off = wgid / NXCD; wgid = (xcd < r ? xcd * (q + 1) : r * (q + 1) + (xcd - r) * q) + off; }
        const int nig = WGM * nN, gid = wgid / nig, fm = gid * WGM, gsz = (nM - fm) < WGM ? (nM - fm) : WGM;
        u.pm = fm + ((wgid % nig) % gsz); u.pn = (wgid % nig) / gsz; return true;
    }
    __device__ __forceinline__ void a_ready(const Unit&) const {}
    __device__ __forceinline__ void done(const Unit&) const {}
    __device__ __forceinline__ const char* aptr(const Gemm& g, const Unit& u, size_t tstep) const { return (const char*)g.A + (size_t)u.pm * tstep; }
    __device__ __forceinline__ const char* bptr(const Gemm& g, const Unit& u, size_t tstep) const { return (const char*)g.Bt + (size_t)u.pn * tstep; }
};

__device__ __forceinline__ unsigned cvt_pk_bf16(float lo, float hi) { unsigned r; asm volatile("v_cvt_pk_bf16_f32 %0, %1, %2" : "=v"(r) : "v"(lo), "v"(hi)); return r; }
typedef int v8i32 __attribute__((ext_vector_type(8)));
__device__ __forceinline__ v8i32 ld8(const PG8_LAS unsigned char* p) { typedef int v4i __attribute__((ext_vector_type(4))); const v4i x = *(const PG8_LAS v4i*)p, y = *(const PG8_LAS v4i*)(p + 1024); return (v8i32){x[0], x[1], x[2], x[3], y[0], y[1], y[2], y[3]}; }
__device__ __forceinline__ void mfma8(f32x4& acc, const v8i32& a, const v8i32& b, int sc) { asm volatile("v_mfma_scale_f32_16x16x128_f8f6f4 %0, %1, %2, %0, %3, %3 op_sel_hi:[0,0,0]" : "+v"(acc) : "v"(a), "v"(b), "v"(sc)); }
template <class Epi, class Sched, bool ALIGN_EPI = false, bool SP2 = false, bool FP8 = false>
__device__ __forceinline__ void gemm_phase(PG8_LAS unsigned char* lds, const Gemm g, const Sched& S, const Epi& E) {
    const int tid = threadIdx.x, wid = __builtin_amdgcn_readfirstlane(tid >> 6), lane = tid & 63, wr = wid >> 2, wc = wid & 3, fr = lane & 15, fq = lane >> 4;
    const int K = g.K, nt = K / BK;
    unsigned voffA[2], voffB[2];
#pragma unroll
    for (int i = 0; i < 2; ++i) { int R, C; stage_rc(tid * 16 + i * 8192, R, C); const int Rb = Epi::PERM ? ((R & ~31) + perm32(R & 31)) : R;
        voffA[i] = (unsigned)(R * K + C) * 2u; voffB[i] = (unsigned)(Rb * K + C) * 2u; }
    const size_t kstep = (size_t)(BK * 2);
    const size_t hstep = (size_t)HALF * K * 2;
    const size_t tstep = 2 * hstep;
    const unsigned ldsw = (unsigned)wid * 1024u;
    const int aoff = lds_byte(wr * 64 + fr, fq * 8), boff = lds_byte(wc * 32 + fr, fq * 8);
#define PG8_SA(b, h) (((b) * 2 + (h)) * HTB)
#define PG8_SB(b, h) ((4 + (b) * 2 + (h)) * HTB)
#define PG8_STAGE(bufoff, gbase, voff) do { _Pragma("unroll") for (int _i = 0; _i < 2; ++_i) \
        __builtin_amdgcn_global_load_lds((const unsigned*)((const char*)(gbase) + (voff)[_i]), (PG8_LAS unsigned*)(lds + (bufoff) + ldsw + _i * 8192), 16, 0, 0); } while (0)
#define PG8_LDA(dst, b, h) do { if constexpr (FP8) { _Pragma("unroll") for (int m = 0; m < 4; ++m) dst##8[m] = ld8(lds + PG8_SA(b, h) + aoff + m * 2048); } else { \
        _Pragma("unroll") for (int m = 0; m < 4; ++m) _Pragma("unroll") for (int k = 0; k < 2; ++k) dst[m][k] = *(const PG8_LAS bf16x8*)(lds + PG8_SA(b, h) + aoff + m * 2048 + k * 1024); } } while (0)
#define PG8_LDB(dst, b, h) do { if constexpr (FP8) { _Pragma("unroll") for (int n = 0; n < 2; ++n) dst##8[n] = ld8(lds + PG8_SB(b, h) + boff + n * 2048); } else { \
        _Pragma("unroll") for (int n = 0; n < 2; ++n) _Pragma("unroll") for (int k = 0; k < 2; ++k) dst[n][k] = *(const PG8_LAS bf16x8*)(lds + PG8_SB(b, h) + boff + n * 2048 + k * 1024); } } while (0)
#define PG8_MMA(ai, bj, At, Bt) do { if constexpr (FP8) __builtin_amdgcn_sched_barrier(0); __builtin_amdgcn_s_setprio(1); if constexpr (FP8) { _Pragma("unroll") for (int m = 0; m < 4; ++m) _Pragma("unroll") for (int n = 0; n < 2; ++n) \
        mfma8(acc[ai][bj][m][n], Bt##8[n], At##8[m], sc8); } else { \
        _Pragma("unroll") for (int m = 0; m < 4; ++m) _Pragma("unroll") for (int n = 0; n < 2; ++n) _Pragma("unroll") for (int k = 0; k < 2; ++k) \
        acc[ai][bj][m][n] = __builtin_amdgcn_mfma_f32_16x16x32_bf16(Bt[n][k], At[m][k], acc[ai][bj][m][n], 0, 0, 0); } __builtin_amdgcn_s_setprio(0); if constexpr (FP8) __builtin_amdgcn_sched_barrier(0); } while (0)
#define PG8_WAIT_V(n) asm volatile("s_waitcnt vmcnt(" #n ")" ::: "memory")
#define PG8_WAIT_L(n) asm volatile("s_waitcnt lgkmcnt(" #n ")" ::: "memory")
#define PG8_BAR __builtin_amdgcn_s_barrier()
#define PG8_SCHED __builtin_amdgcn_sched_barrier(0)
    Unit cur, nxt; int ui = 0;
    if (!S.next(0, cur)) return;
    f32x4 acc[2][2][4][2];
#pragma unroll
    for (int a = 0; a < 2; ++a)
#pragma unroll
        for (int b = 0; b < 2; ++b)
#pragma unroll
            for (int m = 0; m < 4; ++m)
#pragma unroll
                for (int n = 0; n < 2; ++n) acc[a][b][m][n] = (f32x4){0.f, 0.f, 0.f, 0.f};
    bf16x8 At[4][2], B0[2][2], B1[2][2]; v8i32 At8[4], B08[2], B18[2]; int sc8 = 0x7f7f7f7f; asm volatile("" : "+v"(sc8));
    const char* cA = S.aptr(g, cur, tstep); const char* cB = S.bptr(g, cur, tstep);
    S.a_ready(cur);
    if constexpr (SP2) {
        PG8_STAGE(PG8_SB(0, 0), cB, voffB); PG8_STAGE(PG8_SB(0, 1), cB + hstep, voffB); PG8_STAGE(PG8_SA(0, 0), cA, voffA); PG8_STAGE(PG8_SA(0, 1), cA + hstep, voffA);
        if (wr == 1) PG8_BAR;
        PG8_WAIT_V(2); PG8_BAR;
        PG8_STAGE(PG8_SB(1, 0), cB + kstep, voffB); PG8_STAGE(PG8_SA(1, 0), cA + kstep, voffA); PG8_STAGE(PG8_SB(1, 1), cB + hstep + kstep, voffB);
        PG8_WAIT_V(6); PG8_BAR;
    } else {
        PG8_STAGE(PG8_SB(0, 0), cB, voffB); PG8_STAGE(PG8_SA(0, 0), cA, voffA); PG8_STAGE(PG8_SB(0, 1), cB + hstep, voffB); PG8_STAGE(PG8_SA(0, 1), cA + hstep, voffA);
        if (wr == 1) PG8_BAR;
        PG8_WAIT_V(4); PG8_BAR;
        PG8_STAGE(PG8_SB(1, 0), cB + kstep, voffB); PG8_STAGE(PG8_SA(1, 0), cA + kstep, voffA); PG8_STAGE(PG8_SB(1, 1), cB + hstep + kstep, voffB);
        PG8_WAIT_V(6); PG8_BAR;
    }
    for (;;) {
        const bool has_next = S.next(ui + 1, nxt);
        const char* nA = has_next ? S.aptr(g, nxt, tstep) : cA; const char* nB = has_next ? S.bptr(g, nxt, tstep) : cB;
#pragma unroll 1
        for (int t = 0; t < nt; t += 2) {
            const bool last = (t == nt - 2);
            const char* a1 = cA + (size_t)(t + 1) * kstep;
            const char* a2 = last ? nA : cA + (size_t)(t + 2) * kstep; const char* b2 = last ? nB : cB + (size_t)(t + 2) * kstep;
            const char* a3 = a2 + kstep; const char* b3 = b2 + kstep;
            if (last && has_next) S.a_ready(nxt);
            if constexpr (SP2) {
            PG8_LDB(B0, 0, 0); PG8_LDB(B1, 0, 1); PG8_SCHED; PG8_LDA(At, 0, 0); PG8_STAGE(PG8_SA(1, 1), a1 + hstep, voffA);
            PG8_WAIT_V(8); PG8_WAIT_L(0); PG8_BAR; PG8_MMA(0, 0, At, B0); PG8_MMA(0, 1, At, B1); PG8_BAR; PG8_SCHED;
            PG8_LDA(At, 0, 1); PG8_STAGE(PG8_SB(0, 0), b2, voffB); PG8_STAGE(PG8_SB(0, 1), b2 + hstep, voffB); PG8_STAGE(PG8_SA(0, 0), a2, voffA);
            PG8_WAIT_V(8); PG8_WAIT_L(0); PG8_BAR; PG8_MMA(1, 0, At, B0); PG8_MMA(1, 1, At, B1); PG8_BAR; PG8_SCHED;
            PG8_LDB(B0, 1, 0); PG8_LDB(B1, 1, 1); PG8_SCHED; PG8_LDA(At, 1, 0); PG8_STAGE(PG8_SA(0, 1), a2 + hstep, voffA);
            PG8_WAIT_V(8); PG8_WAIT_L(0); PG8_BAR; PG8_MMA(0, 0, At, B0); PG8_MMA(0, 1, At, B1); PG8_BAR; PG8_SCHED;
            PG8_LDA(At, 1, 1); PG8_STAGE(PG8_SB(1, 0), b3, voffB); PG8_STAGE(PG8_SB(1, 1), b3 + hstep, voffB); PG8_STAGE(PG8_SA(1, 0), a3, voffA);
            PG8_WAIT_V(8); PG8_WAIT_L(0); PG8_BAR; PG8_MMA(1, 0, At, B0); PG8_MMA(1, 1, At, B1); PG8_BAR; PG8_SCHED;
            } else {
            PG8_LDB(B0, 0, 0); PG8_SCHED; PG8_LDA(At, 0, 0); PG8_STAGE(PG8_SA(1, 1), a1 + hstep, voffA);
            PG8_WAIT_L(8); PG8_BAR; PG8_WAIT_L(0); PG8_MMA(0, 0, At, B0); PG8_BAR; PG8_SCHED;
            PG8_LDB(B1, 0, 1); PG8_STAGE(PG8_SB(0, 0), b2, voffB);
            PG8_BAR; PG8_WAIT_L(0); PG8_MMA(0, 1, At, B1); PG8_BAR;
            PG8_LDA(At, 0, 1); PG8_STAGE(PG8_SA(0, 0), a2, voffA);
            PG8_BAR; PG8_WAIT_L(0); PG8_MMA(1, 0, At, B0); PG8_BAR; PG8_SCHED;
            PG8_STAGE(PG8_SB(0, 1), b2 + hstep, voffB);
            PG8_WAIT_V(6); PG8_BAR; PG8_MMA(1, 1, At, B1); PG8_BAR;
            PG8_LDB(B0, 1, 0); PG8_SCHED; PG8_LDA(At, 1, 0); PG8_STAGE(PG8_SA(0, 1), a2 + hstep, voffA);
            PG8_WAIT_L(8); PG8_BAR; PG8_WAIT_L(0); PG8_MMA(0, 0, At, B0); PG8_BAR; PG8_SCHED;
            PG8_LDB(B1, 1, 1); PG8_STAGE(PG8_SB(1, 0), b3, voffB);
            PG8_BAR; PG8_WAIT_L(0); PG8_MMA(0, 1, At, B1); PG8_BAR;
            PG8_LDA(At, 1, 1); PG8_STAGE(PG8_SA(1, 0), a3, voffA);
            PG8_BAR; PG8_WAIT_L(0); PG8_MMA(1, 0, At, B0); PG8_BAR; PG8_SCHED;
            PG8_STAGE(PG8_SB(1, 1), b3 + hstep, voffB);
            PG8_WAIT_V(6); PG8_BAR; PG8_MMA(1, 1, At, B1); PG8_BAR;
            }
        }
        if constexpr (FP8) asm volatile("s_nop 15\n\ts_nop 15" ::: "memory");
        if constexpr (ALIGN_EPI) { if (wr == 0) PG8_BAR; }
        if constexpr (!Epi::AFTER_DRAIN) { E(acc, cur, wr, wc, fr, fq); S.done(cur); }
        if (!has_next) break;
#pragma unroll
        for (int a = 0; a < 2; ++a)
#pragma unroll
            for (int b = 0; b < 2; ++b)
#pragma unroll
                for (int m = 0; m < 4; ++m)
#pragma unroll
                    for (int n = 0; n < 2; ++n) acc[a][b][m][n] = (f32x4){0.f, 0.f, 0.f, 0.f};
        cur = nxt; cA = nA; cB = nB; ++ui;
        if constexpr (ALIGN_EPI) { if (wr == 1) PG8_BAR; }
    }
    PG8_WAIT_V(0);
    if constexpr (!ALIGN_EPI) { if (wr == 0) PG8_BAR; }
    PG8_BAR;
    if constexpr (Epi::AFTER_DRAIN) { E.fused(acc, cur, wr, wc, fr, fq, lds, wid, lane); S.done(cur); }
#undef PG8_SA
#undef PG8_SB
#undef PG8_STAGE
#undef PG8_LDA
#undef PG8_LDB
#undef PG8_MMA
#undef PG8_WAIT_V
#undef PG8_WAIT_L
#undef PG8_BAR
#undef PG8_SCHED
}
}

constexpr int D = 1024, NB = 8, SEQ = 4096, CTXL = 256;
constexpr int MLAT = NB * SEQ, MCTX = NB * CTXL, MTOT = MLAT + MCTX;
constexpr int NE = 16, FF = 2048, CAPL = 512, CAPC = 32;
constexpr int EROWS0 = NB * (CAPL + CAPC);
constexpr int EROWS1 = NB * CAPL;
constexpr int NQKV = 1536, NWIN = 4096, LDWIN = 4128;
constexpr float EPS = 1e-6f;
constexpr int NWAVES = 8, NTHR = 512;
constexpr int NPH = 21;

constexpr size_t MiB = 1u << 20;
constexpr size_t WS_CTL = 0, CTL_ZERO_BYTES = 1 * MiB;
constexpr size_t WS_MOD = 1 * MiB;
constexpr size_t WS_ROPE = 1 * MiB + 512 * 1024;
constexpr size_t WS_WQKV = 2 * MiB, WS_WO0 = 5 * MiB, WS_WIN = 7 * MiB, WS_WO1 = 15 * MiB;
constexpr size_t WS_WGU = 17 * MiB, WS_WD = 81 * MiB, WS_WGU1 = 113 * MiB, WS_WD1 = 177 * MiB;
constexpr size_t WS_XRES = 209 * MiB;
constexpr size_t WS_H = 345 * MiB;
constexpr size_t WS_H8 = WS_H;
constexpr size_t WS_AFF = 413 * MiB;
constexpr size_t WS_GW = 416 * MiB;
constexpr size_t WS_SLOT = 417 * MiB;
constexpr size_t WS_G = 420 * MiB, WS_BETA = 423 * MiB;
constexpr size_t WS_R = 427 * MiB;
constexpr size_t WS_Q = WS_R, WS_K = WS_R + 68 * MiB, WS_V = WS_R + 85 * MiB, WS_ATT = WS_R + 102 * MiB;
constexpr size_t WS_XG = WS_R, WS_HID = WS_R + 136 * MiB;
constexpr size_t WS_PQKV = WS_R, WS_Z = WS_R + 204 * MiB, WS_QN = WS_R + 272 * MiB, WS_KN = WS_R + 340 * MiB, WS_VV = WS_R + 408 * MiB;
constexpr size_t WS_TB = WS_R, WS_TG = WS_R + 68 * MiB, WS_QKD = WS_R + 136 * MiB, WS_GC = WS_AFF;
constexpr size_t WS_RO = WS_R;
constexpr size_t WS_END = WS_R + 476 * MiB;
constexpr int CW_BAR = 4096;

constexpr int RING_BYTES = 131072;
constexpr int LDSCTL_OFF = RING_BYTES, MISC_OFF = LDSCTL_OFF + 320;
constexpr int LDS_BYTES = 147456;

#define GAS __attribute__((address_space(1)))
#define LAS __attribute__((address_space(3)))
typedef unsigned short bf16;
typedef unsigned v4u __attribute__((ext_vector_type(4)));
typedef unsigned v2u __attribute__((ext_vector_type(2)));
typedef float f32x4 __attribute__((ext_vector_type(4)));
typedef short bf16x8 __attribute__((ext_vector_type(8)));
typedef GAS unsigned gu32;
typedef GAS unsigned long long gu64;
#define RLX_AGENT __ATOMIC_RELAXED, __HIP_MEMORY_SCOPE_AGENT
#define LDS_WAIT() asm volatile("s_waitcnt lgkmcnt(0)" ::: "memory")
#define VM_WAIT() asm volatile("s_waitcnt vmcnt(0)" ::: "memory")

#define XB_TMO      128
#define XB_XCNT(j)  (256  + 64 * (j))
#define XB_XSUB(j)  (1280 + 64 * (j))
#define XB_XGEN(j)  (2304 + 64 * (j))
#define XB_TOP      3328
#define XB_TOPGEN   3392
#define XCD_BAR_WORDS 3456
#define XB_SPIN_CAP (1u << 18)

__device__ __forceinline__ unsigned xb_ld(unsigned* p)              { return __hip_atomic_load(p, __ATOMIC_RELAXED, __HIP_MEMORY_SCOPE_AGENT); }
__device__ __forceinline__ unsigned xb_add(unsigned* p, unsigned v) { return __hip_atomic_fetch_add(p, v, __ATOMIC_RELAXED, __HIP_MEMORY_SCOPE_AGENT); }
__device__ __forceinline__ unsigned xb_xcc_id() { return (unsigned)__builtin_amdgcn_s_getreg((3 << 11) | 20) & 0xFu; }
#define XB_SPIN(cond, bar) do { unsigned _sp = 0; while (cond) { __builtin_amdgcn_s_sleep(1); \
    if ((++_sp & 255u) == 0u) { if (xb_ld(&(bar)[XB_TMO])) break; if (_sp > XB_SPIN_CAP) { atomicAdd(&(bar)[XB_TMO], 1u); break; } } } } while (0)

struct XcdBarrier {
    unsigned* bar; unsigned x;
    volatile LAS unsigned* st;
};

__device__ __forceinline__ XcdBarrier xcd_barrier_post(unsigned* bar, volatile LAS unsigned* st) {
    XcdBarrier b; b.bar = bar; b.x = xb_xcc_id(); b.st = st;
    if (threadIdx.x == 0) (void)xb_add(&bar[XB_XCNT(b.x)], 1u);
    return b;
}
__device__ __forceinline__ void xcd_barrier_complete(unsigned* bar, unsigned x, unsigned& nloc, unsigned& nx) {
    const unsigned G = gridDim.x * gridDim.y * gridDim.z;
    unsigned sum, cnt, mine, sp = 0u;
    for (;;) {
        sum = 0u; cnt = 0u; mine = 0u;
#pragma unroll
        for (unsigned j = 0; j < 16; ++j) { const unsigned c = xb_ld(&bar[XB_XCNT(j)]); sum += c; cnt += (c > 0u) ? 1u : 0u; mine = (j == x) ? c : mine; }
        if (sum == G) break;
        __builtin_amdgcn_s_sleep(1);
        if ((++sp & 255u) == 0u) { if (xb_ld(&bar[XB_TMO])) break; if (sp > XB_SPIN_CAP) { atomicAdd(&bar[XB_TMO], 1u); break; } }
    }
    nloc = mine > 0u ? mine : 1u; nx = cnt > 0u ? cnt : 1u;
}

__device__ __forceinline__ void xcd_barrier(const XcdBarrier& b) {
    asm volatile("s_waitcnt vmcnt(0)" ::: "memory");
    __syncthreads();
    if (threadIdx.x == 0) {
        unsigned* bar = b.bar;
        __builtin_amdgcn_s_waitcnt(0);
        unsigned nloc = b.st[0], nx = b.st[1];
        if (nloc == 0u) { xcd_barrier_complete(bar, b.x, nloc, nx); b.st[0] = nloc; b.st[1] = nx; }
        const unsigned old = xb_add(&bar[XB_XSUB(b.x)], 1u);
        const unsigned gen = old / nloc;
        if (old + 1u == (gen + 1u) * nloc) {
            __builtin_amdgcn_fence(__ATOMIC_RELEASE, "agent");
            asm volatile("s_waitcnt vmcnt(0)" ::: "memory");
            const unsigned og = xb_add(&bar[XB_TOP], 1u);
            const unsigned tg = og / nx;
            if (og + 1u == (tg + 1u) * nx) xb_add(&bar[XB_TOPGEN], 1u);
            else XB_SPIN(xb_ld(&bar[XB_TOPGEN]) == tg, bar);
            __builtin_amdgcn_fence(__ATOMIC_ACQUIRE, "agent");
            xb_add(&bar[XB_XGEN(b.x)], 1u);
            asm volatile("s_waitcnt vmcnt(0)" ::: "memory");
        } else {
            XB_SPIN(xb_ld(&bar[XB_XGEN(b.x)]) == gen, bar);
            __builtin_amdgcn_fence(__ATOMIC_ACQUIRE, "agent");
            asm volatile("s_waitcnt vmcnt(0)" ::: "memory");
        }
    }
    __syncthreads();
}

struct Args { const float* in[30]; float* out; unsigned char* ws; int ph_lo, ph_hi; };
struct Frame { LAS unsigned char* lds; volatile LAS unsigned* MISC; int tid, lane, wave, vcu, G; };

__device__ __forceinline__ float wave_sum(float v) {
#pragma unroll
    for (int o = 1; o < 64; o <<= 1) v += __shfl_xor(v, o);
    return v;
}
template <int N> __device__ __forceinline__ float fold_sum(float (&p)[N], int lane) {
    int o = 32;
#pragma unroll
    for (int n = N; n > 1; n >>= 1) { const unsigned um = (lane & o) ? 0xffffffffu : 0u;
#pragma unroll
        for (int k = 0; k < n / 2; ++k) { const unsigned a = __float_as_uint(p[k]), b = __float_as_uint(p[k + n / 2]);
            const float send = __uint_as_float((a & um) | (b & ~um)), keep = __uint_as_float((b & um) | (a & ~um)); p[k] = keep + __shfl_xor(send, o); }
        o >>= 1; }
    float v = p[0];
#pragma unroll
    for (int oo = 32; oo >= 1; oo >>= 1) if (oo <= o) v += __shfl_xor(v, oo);
    return v;
}
__device__ __forceinline__ float proj16(const f32x4 (&v)[4], const LAS float* w16, int lane) {
    float pj[16];
#pragma unroll
    for (int e = 0; e < 16; ++e) { float s = 0.f;
#pragma unroll
        for (int j = 0; j < 4; ++j) { const f32x4 w = ((const LAS f32x4*)(w16 + e * 1024))[lane + 64 * j]; s += (v[j].x * w.x + v[j].y * w.y) + (v[j].z * w.z + v[j].w * w.w); }
        pj[e] = s; }
    return fold_sum<16>(pj, lane);
}
template <int R> __device__ __forceinline__ void proj16xR(const f32x4 (&v)[R][4], const LAS float* w16, int lane, float (&out)[R]) {
    float p[R][16];
#pragma unroll
    for (int e = 0; e < 16; ++e) { float s[R];
#pragma unroll
        for (int t = 0; t < R; ++t) s[t] = 0.f;
#pragma unroll
        for (int j = 0; j < 4; ++j) { const f32x4 w = ((const LAS f32x4*)(w16 + e * 1024))[lane + 64 * j];
#pragma unroll
            for (int t = 0; t < R; ++t) s[t] += (v[t][j].x * w.x + v[t][j].y * w.y) + (v[t][j].z * w.z + v[t][j].w * w.w); }
#pragma unroll
        for (int t = 0; t < R; ++t) p[t][e] = s[t]; }
#pragma unroll
    for (int t = 0; t < R; ++t) out[t] = fold_sum<16>(p[t], lane);
}
__device__ __forceinline__ void proj16x2(const f32x4 (&v0)[4], const f32x4 (&v1)[4], const LAS float* w16, int lane, float& r0, float& r1) {
    float p0[16], p1[16];
#pragma unroll
    for (int e = 0; e < 16; ++e) { float s0 = 0.f, s1 = 0.f;
#pragma unroll
        for (int j = 0; j < 4; ++j) { const f32x4 w = ((const LAS f32x4*)(w16 + e * 1024))[lane + 64 * j];
            s0 += (v0[j].x * w.x + v0[j].y * w.y) + (v0[j].z * w.z + v0[j].w * w.w); s1 += (v1[j].x * w.x + v1[j].y * w.y) + (v1[j].z * w.z + v1[j].w * w.w); }
        p0[e] = s0; p1[e] = s1; }
    r0 = fold_sum<16>(p0, lane); r1 = fold_sum<16>(p1, lane);
}
__device__ __forceinline__ float bflo(unsigned w) { return __uint_as_float(w << 16); }
__device__ __forceinline__ float bfhi(unsigned w) { return __uint_as_float(w & 0xffff0000u); }
__device__ __forceinline__ unsigned pkbf(float lo, float hi) { return pg8::cvt_pk_bf16(lo, hi); }
__device__ __forceinline__ float silu_f(float x) { return x * __builtin_amdgcn_rcpf(1.f + __expf(-x)); }
__device__ __forceinline__ unsigned pk4f8(float a, float b, float c, float d) { int v = __builtin_amdgcn_cvt_pk_fp8_f32(a, b, 0, false); v = __builtin_amdgcn_cvt_pk_fp8_f32(c, d, v, true); return (unsigned)v; }
constexpr float LOG2E = 1.4426950408889634f;
constexpr float W8S = 64.f, W8I = 1.f / 64.f;
__device__ __forceinline__ int modrow(int m) { return m < MLAT ? (m >> 12) : 8; }

__device__ __forceinline__ void tr_item(const float* W, size_t ldw, int k0, size_t srccol0, bool permq, bf16* WT, size_t K, size_t dstrow0, LAS float* scr, int lane) {
    const int nl = lane & 31;
    size_t col = srccol0 + nl;
    if (permq) { const int nd = (int)col; const int s = nd & 63, j = (s & 31) >> 1; col = (size_t)((nd - s) + (s & 32) + ((s & 1) ? 16 + j : j)); }
    float t[32];
#pragma unroll
    for (int i = 0; i < 32; ++i) t[i] = W[(size_t)(k0 + 2 * i + (lane >> 5)) * ldw + col];
#pragma unroll
    for (int i = 0; i < 32; ++i) scr[(2 * i + (lane >> 5)) * 33 + nl] = t[i];
    LDS_WAIT(); asm volatile("" ::: "memory");
    const int c = lane & 7;
#pragma unroll
    for (int j = 0; j < 4; ++j) { const int n = (lane >> 3) + 8 * j; const LAS float* s = scr + (8 * c) * 33 + n;
        v4u o; o.x = pkbf(s[0 * 33], s[1 * 33]); o.y = pkbf(s[2 * 33], s[3 * 33]); o.z = pkbf(s[4 * 33], s[5 * 33]); o.w = pkbf(s[6 * 33], s[7 * 33]);
        *(v4u*)(WT + (dstrow0 + n) * K + k0 + 8 * c) = o; }
    LDS_WAIT(); asm volatile("" ::: "memory");
}
__device__ __forceinline__ void tr_item8(const float* W, size_t ldw, int k0, size_t srccol0, unsigned char* WT, size_t K, size_t dstrow0, LAS float* scr, int lane) {
    const int nl = lane & 31; const size_t col = srccol0 + nl;
    float t[32];
#pragma unroll
    for (int i = 0; i < 32; ++i) t[i] = W[(size_t)(k0 + 2 * i + (lane >> 5)) * ldw + col];
#pragma unroll
    for (int i = 0; i < 32; ++i) scr[(2 * i + (lane >> 5)) * 33 + nl] = t[i] * W8S;
    LDS_WAIT(); asm volatile("" ::: "memory");
    const int c = lane & 7;
#pragma unroll
    for (int j = 0; j < 4; ++j) { const int n = (lane >> 3) + 8 * j; const LAS float* s = scr + (8 * c) * 33 + n;
        v2u o; o.x = pk4f8(s[0 * 33], s[1 * 33], s[2 * 33], s[3 * 33]); o.y = pk4f8(s[4 * 33], s[5 * 33], s[6 * 33], s[7 * 33]);
        *(v2u*)(WT + (dstrow0 + n) * K + k0 + 8 * c) = o; }
    LDS_WAIT(); asm volatile("" ::: "memory");
}
constexpr int IT_GU = 16 * 2048, IT_D = 16 * 1024, IT_MOE = IT_GU + IT_D;
__device__ __forceinline__ void tr_moe_items(const Frame& F, const float* wg, const float* wu, const float* wd, unsigned char* wgu, unsigned char* wdn, int lo, int hi, int widx, int nw) {
    LAS float* scr = (LAS float*)(F.lds + F.wave * 16384);
    for (int r = lo + widx; r < hi; r += nw) {
        if (r < IT_GU) { const int e = r >> 11, q = r & 2047, kb = q >> 7, nb = q & 127, n0 = nb * 32, pn = n0 >> 8, w = n0 & 255;
            const float* W = ((w < 128) ? wg : wu) + (size_t)e * 1024 * 2048;
            tr_item8(W, 2048, kb * 64, (size_t)(pn * 128 + (w & 127)), wgu, 1024, (size_t)e * 4096 + n0, scr, F.lane); }
        else { const int rr = r - IT_GU; const int e = rr >> 10, q = rr & 1023, kb = q >> 5, nb = q & 31, n0 = nb * 32;
            tr_item8(wd + (size_t)e * 2048 * 1024, 1024, kb * 64, (size_t)n0, wdn, 2048, (size_t)e * 1024 + n0, scr, F.lane); }
    }
}
constexpr int L0_QKV = 208 * 8 * 9, L0_WO = 224 * 8 * 9, L0_TOPK = 128 * 8 * 5, L0_PRO = IT_MOE - L0_QKV - L0_WO - L0_TOPK;
constexpr int L1_ATT = 128 * 8 * 4, L1_G2 = 192 * 8 * 10, L1_WIN = 128 * 8 * 8, L1_TOPK = 128 * 8 * 5, L1_PREP = 192 * 8 * 5, L1_CMB = IT_MOE - L1_ATT - L1_G2 - L1_WIN - L1_TOPK - L1_PREP;
__device__ __forceinline__ void phase_prologue(const Frame& F, const Args& A) {
    unsigned char* ws = A.ws;
    const int gw = F.vcu * NWAVES + F.wave, NGW = F.G * NWAVES;
    {
        LAS float* sl = (LAS float*)F.lds;
        LAS float* part = sl + 9 * 1024;
        float* MOD = (float*)(ws + WS_MOD);
        if (F.vcu < 192) {
            for (int idx = F.tid; idx < 9 * 1024; idx += NTHR) { const int r = idx >> 10, k = idx & 1023; const float v = r < 8 ? A.in[1][r * 1024 + k] : A.in[3][k]; sl[idx] = silu_f(v); }
        }
        __syncthreads();
        for (int u = F.vcu; u < 192; u += F.G) {
            const int layer = u / 96, cg = u % 96, col = cg * 64 + F.lane;
            const float* W = layer ? A.in[15] : A.in[4]; const float* bias = layer ? A.in[16] : A.in[5];
            float acc[9];
#pragma unroll
            for (int r = 0; r < 9; ++r) acc[r] = 0.f;
            const int k0 = F.wave * 128;
#pragma unroll 8
            for (int k = k0; k < k0 + 128; ++k) { const float w = W[(size_t)k * 6144 + col];
#pragma unroll
                for (int r = 0; r < 9; ++r) acc[r] += sl[r * 1024 + k] * w; }
#pragma unroll
            for (int r = 0; r < 9; ++r) part[(F.wave * 9 + r) * 64 + F.lane] = acc[r];
            __syncthreads();
            for (int idx = F.tid; idx < 576; idx += NTHR) { const int r = idx >> 6, l = idx & 63; float s = 0.f;
#pragma unroll
                for (int w = 0; w < 8; ++w) s += part[(w * 9 + r) * 64 + l];
                MOD[(size_t)(layer * 9 + r) * 6144 + cg * 64 + l] = s + bias[cg * 64 + l]; }
            __syncthreads();
        }
        if (F.vcu == F.G - 1) {
            float* rc = (float*)(ws + WS_ROPE); float* rs = rc + 1024;
            for (int idx = F.tid; idx < 1024; idx += NTHR) { const int pos = idx >> 4, j = idx & 15;
                const float inv = exp2f(-(float)j * (13.287712379549449f / 16.f));
                const float ang = (float)pos * inv; rc[idx] = cosf(ang); rs[idx] = sinf(ang); }
        }
        __syncthreads();
    }
    {
        LAS float* scr = (LAS float*)(F.lds + F.wave * 16384);
        constexpr int I_QKV = 16 * 48, I_WO = 16 * 32, I_WIN = 16 * 128;
        constexpr int NSMALL = I_QKV + 2 * I_WO + I_WIN;
        for (int it = gw; it < NSMALL; it += NGW) {
            int r = it;
            if (r < I_QKV) { const int kb = r / 48, nb = r % 48; tr_item(A.in[7], NQKV, kb * 64, (size_t)nb * 32, nb * 32 < 1280, (bf16*)(ws + WS_WQKV), 1024, (size_t)nb * 32, scr, F.lane); continue; } r -= I_QKV;
            if (r < I_WO) { const int kb = r >> 5, nb = r & 31; tr_item(A.in[9], 1024, kb * 64, (size_t)nb * 32, false, (bf16*)(ws + WS_WO0), 1024, (size_t)nb * 32, scr, F.lane); continue; } r -= I_WO;
            if (r < I_WIN) { const int kb = r >> 7, nb = r & 127; tr_item(A.in[18], LDWIN, kb * 64, (size_t)nb * 32, false, (bf16*)(ws + WS_WIN), 1024, (size_t)nb * 32, scr, F.lane); continue; } r -= I_WIN;
            { const int kb = r >> 5, nb = r & 31; tr_item(A.in[23], 1024, kb * 64, (size_t)nb * 32, false, (bf16*)(ws + WS_WO1), 1024, (size_t)nb * 32, scr, F.lane); }
        }
        constexpr int L0_NOADA = 64 * 8 * 6;
        if (F.G == 256) { if (F.vcu >= 192) tr_moe_items(F, A.in[12], A.in[13], A.in[14], ws + WS_WGU, ws + WS_WD, 0, L0_NOADA, (F.vcu - 192) * NWAVES + F.wave, 64 * NWAVES);
            tr_moe_items(F, A.in[12], A.in[13], A.in[14], ws + WS_WGU, ws + WS_WD, L0_NOADA, L0_PRO, gw, NGW); }
        else tr_moe_items(F, A.in[12], A.in[13], A.in[14], ws + WS_WGU, ws + WS_WD, 0, L0_PRO, gw, NGW);
    }
}

struct RowCoef { f32x4 a[4], b[4]; };
__device__ __forceinline__ void load_coef(RowCoef& C, const float* g, const float* sh, const float* sc, int lane) {
#pragma unroll
    for (int j = 0; j < 4; ++j) { const f32x4 gv = ((const f32x4*)g)[lane + 64 * j], sv = ((const f32x4*)sc)[lane + 64 * j]; C.a[j] = gv * (sv + 1.0f); C.b[j] = ((const f32x4*)sh)[lane + 64 * j]; }
}
__device__ __forceinline__ float row_rstd(const f32x4 (&v)[4]) {
    float s = 0.f;
#pragma unroll
    for (int j = 0; j < 4; ++j) s += (v[j].x * v[j].x + v[j].y * v[j].y) + (v[j].z * v[j].z + v[j].w * v[j].w);
    return 1.0f / sqrtf(wave_sum(s) * (1.0f / 1024.0f) + EPS);
}
__device__ __forceinline__ void store_row_bf16(bf16* row, const f32x4 (&v)[4], int lane) {
#pragma unroll
    for (int j = 0; j < 4; ++j) { v2u w; w.x = pkbf(v[j].x, v[j].y); w.y = pkbf(v[j].z, v[j].w); ((v2u*)row)[lane + 64 * j] = w; }
}

__device__ __forceinline__ void load_row_bf16(f32x4 (&v)[4], const bf16* row, int lane) {
#pragma unroll
    for (int j = 0; j < 4; ++j) { const v2u w = ((const v2u*)row)[lane + 64 * j]; v[j] = (f32x4){bflo(w.x), bfhi(w.x), bflo(w.y), bfhi(w.y)}; }
}
__device__ __forceinline__ void phase_modnorm0(const Frame& F, const Args& A) {
    const int gw = F.vcu * NWAVES + F.wave, NGW = F.G * NWAVES;
    const float* MOD = (const float*)(A.ws + WS_MOD); bf16* H = (bf16*)(A.ws + WS_H);
    const int rpw = (MTOT + NGW - 1) / NGW;
    int curb = -1; RowCoef C;
    const int mbeg = gw * rpw, cnt = (MTOT - mbeg) < rpw ? (MTOT - mbeg) : rpw;
    f32x4 nx[4];
    if (cnt > 0) { const float* xr = mbeg < MLAT ? A.in[0] + (size_t)mbeg * D : A.in[2] + (size_t)(mbeg - MLAT) * D;
#pragma unroll
        for (int j = 0; j < 4; ++j) nx[j] = ((const f32x4*)xr)[F.lane + 64 * j]; }
    for (int r = 0; r < cnt; ++r) { const int m = mbeg + r;
        const int mb = modrow(m);
        if (mb != curb) { load_coef(C, A.in[6], MOD + (size_t)mb * 6144, MOD + (size_t)mb * 6144 + 1024, F.lane); curb = mb; }
        f32x4 v[4];
#pragma unroll
        for (int j = 0; j < 4; ++j) v[j] = nx[j];
        if (r + 1 < cnt) { const int m1 = m + 1; const float* xr = m1 < MLAT ? A.in[0] + (size_t)m1 * D : A.in[2] + (size_t)(m1 - MLAT) * D;
#pragma unroll
            for (int j = 0; j < 4; ++j) nx[j] = ((const f32x4*)xr)[F.lane + 64 * j]; }
        const float rstd = row_rstd(v);
#pragma unroll
        for (int j = 0; j < 4; ++j) v[j] = v[j] * rstd * C.a[j] + C.b[j];
        store_row_bf16(H + (size_t)m * D, v, F.lane);
    }
}

template <int NML, int NNL> struct GroupOrder {
    static constexpr int PER = NML * NNL, BW = 4 * NNL;
    int nx, e0, lid;
    __device__ void init(int G_, int bx) { nx = G_ / 8; e0 = bx % 8; lid = bx / 8; }
    __device__ bool next(int i, pg8::Unit& u) const { const int q = i * nx + lid; if (q >= 2 * PER) return false;
        const int e = e0 + 8 * (q / PER), r = q % PER, band = r / BW, rr = r % BW, brow = (NML - 4 * band) < 4 ? (NML - 4 * band) : 4;
        u.pm = e * NML + 4 * band + rr % brow; u.pn = e * NNL + rr / brow; return true; }
    __device__ __forceinline__ void a_ready(const pg8::Unit&) const {}
    __device__ __forceinline__ void done(const pg8::Unit&) const {}
    __device__ __forceinline__ const char* aptr(const pg8::Gemm& g, const pg8::Unit& u, size_t tstep) const { return (const char*)g.A + (size_t)u.pm * tstep; }
    __device__ __forceinline__ const char* bptr(const pg8::Gemm& g, const pg8::Unit& u, size_t tstep) const { return (const char*)g.Bt + (size_t)u.pn * tstep; }
};
struct QKVOrder {
    int nx, x0, lid;
    __device__ void init(int G_, int bx) { nx = G_ / 8; x0 = bx % 8; lid = bx / 8; }
    __device__ bool next(int i, pg8::Unit& u) const { const int q = i * nx + lid; if (q >= 102) return false; const int tm = 17 * x0 + q / 6, c = q % 6;
        if (c < 5) { u.pm = tm; u.pn = c; } else { u.pm = 1000 + tm; u.pn = 5; } return true; }
    __device__ __forceinline__ void a_ready(const pg8::Unit&) const {}
    __device__ __forceinline__ void done(const pg8::Unit&) const {}
    __device__ __forceinline__ const char* aptr(const pg8::Gemm& g, const pg8::Unit& u, size_t tstep) const { return u.pm >= 1000 ? (const char*)g.Bt + 5 * tstep : (const char*)g.A + (size_t)u.pm * tstep; }
    __device__ __forceinline__ const char* bptr(const pg8::Gemm& g, const pg8::Unit& u, size_t tstep) const { return u.pm >= 1000 ? (const char*)g.A + (size_t)(u.pm - 1000) * tstep : (const char*)g.Bt + (size_t)u.pn * tstep; }
};
struct EpiQKV {
    static constexpr bool PERM = true, AFTER_DRAIN = false;
    bf16 *Q, *K, *V; const float* rc; const float* rs; float QS;
    __device__ __forceinline__ void operator()(const f32x4 (&acc)[2][2][4][2], const pg8::Unit& u, int wr, int wc, int fr, int fq) const {
        if (u.pm >= 1000) {
            const int tok0 = (u.pm - 1000) * 256;
#pragma unroll
            for (int ai = 0; ai < 2; ++ai)
#pragma unroll
                for (int m = 0; m < 4; ++m) { const int dr = ai * 128 + wr * 64 + m * 16 + fr;
#pragma unroll
                    for (int bj = 0; bj < 2; ++bj) { const f32x4 v0 = acc[ai][bj][m][0], v1 = acc[ai][bj][m][1];
                        v4u w; w.x = pkbf(v0[0], v0[1]); w.y = pkbf(v0[2], v0[3]); w.z = pkbf(v1[0], v1[1]); w.w = pkbf(v1[2], v1[3]);
                        *(v4u*)(V + (size_t)dr * MTOT + tok0 + bj * 128 + wc * 32 + 8 * fq) = w; } }
            return; }
        const int pn = u.pn; bf16* base; int ld, coff;
        if (pn < 4) { base = Q; ld = 1024; coff = pn * 256; } else { base = K; ld = 256; coff = 0; }
        const bool rope = (u.pm < MLAT / 256);
        const float sc = pn < 4 ? QS : 1.0f;
        const int iscol = wc & 1;
#pragma unroll
        for (int ai = 0; ai < 2; ++ai)
#pragma unroll
            for (int m = 0; m < 4; ++m) {
                const int r = u.pm * 256 + ai * 128 + wr * 64 + m * 16 + fr;
                f32x4 cv = (f32x4){1.f, 1.f, 1.f, 1.f}, sv = (f32x4){0.f, 0.f, 0.f, 0.f};
                if (rope) { const int n = r & 4095; const int pos = iscol ? (n & 63) : (n >> 6); cv = *(const f32x4*)(rc + pos * 16 + 4 * fq); sv = *(const f32x4*)(rs + pos * 16 + 4 * fq); }
#pragma unroll
                for (int bj = 0; bj < 2; ++bj) {
                    const f32x4 v0 = acc[ai][bj][m][0], v1 = acc[ai][bj][m][1];
                    const float o0 = (v0[0] * cv[0] - v0[1] * sv[0]) * sc, o1 = (v0[1] * cv[0] + v0[0] * sv[0]) * sc;
                    const float o2 = (v0[2] * cv[1] - v0[3] * sv[1]) * sc, o3 = (v0[3] * cv[1] + v0[2] * sv[1]) * sc;
                    const float o4 = (v1[0] * cv[2] - v1[1] * sv[2]) * sc, o5 = (v1[1] * cv[2] + v1[0] * sv[2]) * sc;
                    const float o6 = (v1[2] * cv[3] - v1[3] * sv[3]) * sc, o7 = (v1[3] * cv[3] + v1[2] * sv[3]) * sc;
                    v4u w; w.x = pkbf(o0, o1); w.y = pkbf(o2, o3); w.z = pkbf(o4, o5); w.w = pkbf(o6, o7);
                    *(v4u*)(base + (size_t)r * ld + coff + bj * 128 + wc * 32 + 8 * fq) = w;
                }
            }
    }
};
template <bool XIN_BF16> struct EpiResid {
    static constexpr bool PERM = true, AFTER_DRAIN = false;
    const void* xlat; const void* xctx; bf16* out; const float* gate;
    __device__ __forceinline__ void operator()(const f32x4 (&acc)[2][2][4][2], const pg8::Unit& u, int wr, int wc, int fr, int fq) const {
        const int mb = u.pm < MLAT / 256 ? (u.pm >> 4) : 8;
        const int col0 = u.pn * 256 + wc * 32 + 8 * fq;
        const float* gp = gate + (size_t)mb * 6144 + col0;
        f32x4 gv[2][2];
#pragma unroll
        for (int bj = 0; bj < 2; ++bj)
#pragma unroll
            for (int n = 0; n < 2; ++n) gv[bj][n] = *(const f32x4*)(gp + bj * 128 + n * 4);
#pragma unroll
        for (int ai = 0; ai < 2; ++ai)
#pragma unroll
            for (int m = 0; m < 4; ++m) {
                const int r = u.pm * 256 + ai * 128 + wr * 64 + m * 16 + fr;
                bf16* o = out + (size_t)r * D + col0;
#pragma unroll
                for (int bj = 0; bj < 2; ++bj) { f32x4 x0, x1;
                    if (XIN_BF16) { const v4u w = *(const v4u*)((const bf16*)xlat + (size_t)r * D + col0 + bj * 128);
                        x0 = (f32x4){bflo(w.x), bfhi(w.x), bflo(w.y), bfhi(w.y)}; x1 = (f32x4){bflo(w.z), bfhi(w.z), bflo(w.w), bfhi(w.w)}; }
                    else { const float* xin = (r < MLAT ? (const float*)xlat + (size_t)r * D : (const float*)xctx + (size_t)(r - MLAT) * D) + col0 + bj * 128; x0 = *(const f32x4*)xin; x1 = *(const f32x4*)(xin + 4); }
                    x0 += gv[bj][0] * acc[ai][bj][m][0]; x1 += gv[bj][1] * acc[ai][bj][m][1];
                    v4u w; w.x = pkbf(x0[0], x0[1]); w.y = pkbf(x0[2], x0[3]); w.z = pkbf(x1[0], x1[1]); w.w = pkbf(x1[2], x1[3]);
                    *(v4u*)(o + bj * 128) = w; }
            }
    }
};
struct EpiSwiGLU {
    static constexpr bool PERM = true, AFTER_DRAIN = false;
    unsigned char* HID;
    __device__ __forceinline__ void operator()(const f32x4 (&acc)[2][2][4][2], const pg8::Unit& u, int wr, int wc, int fr, int fq) const {
        asm volatile("" : "+v"(fr), "+v"(fq));
        const int col = (u.pn & 15) * 128 + wc * 32 + 8 * fq;
#pragma unroll
        for (int ai = 0; ai < 2; ++ai)
#pragma unroll
            for (int m = 0; m < 4; ++m) {
                const int r = u.pm * 256 + ai * 128 + wr * 64 + m * 16 + fr;
                v2u w;
#pragma unroll
                for (int n = 0; n < 2; ++n) { const f32x4 ga = acc[ai][0][m][n], ua = acc[ai][1][m][n];
                    const f32x4 t = ga * (-W8I * LOG2E);
                    f32x4 e; e[0] = __builtin_amdgcn_exp2f(t[0]); e[1] = __builtin_amdgcn_exp2f(t[1]); e[2] = __builtin_amdgcn_exp2f(t[2]); e[3] = __builtin_amdgcn_exp2f(t[3]);
                    const f32x4 d = e + 1.0f;
                    f32x4 rc; rc[0] = __builtin_amdgcn_rcpf(d[0]); rc[1] = __builtin_amdgcn_rcpf(d[1]); rc[2] = __builtin_amdgcn_rcpf(d[2]); rc[3] = __builtin_amdgcn_rcpf(d[3]);
                    const f32x4 h = (ga * ua) * (rc * (W8I * W8I));
                    const unsigned pk = pk4f8(h[0], h[1], h[2], h[3]); if (n == 0) w.x = pk; else w.y = pk; }
                *(v2u*)(HID + (size_t)r * FF + col) = w;
            }
    }
};
struct EpiY {
    static constexpr bool PERM = true, AFTER_DRAIN = false;
    bf16* Y;
    __device__ __forceinline__ void operator()(const f32x4 (&acc)[2][2][4][2], const pg8::Unit& u, int wr, int wc, int fr, int fq) const {
        asm volatile("" : "+v"(fr), "+v"(fq));
        const int col = (u.pn & 3) * 256 + wc * 32 + 8 * fq;
#pragma unroll
        for (int ai = 0; ai < 2; ++ai)
#pragma unroll
            for (int m = 0; m < 4; ++m) {
                const int r = u.pm * 256 + ai * 128 + wr * 64 + m * 16 + fr;
                const float gwt = W8I;
#pragma unroll
                for (int bj = 0; bj < 2; ++bj) { const f32x4 v0 = acc[ai][bj][m][0] * gwt, v1 = acc[ai][bj][m][1] * gwt;
                    v4u w; w.x = pkbf(v0[0], v0[1]); w.y = pkbf(v0[2], v0[3]); w.z = pkbf(v1[0], v1[1]); w.w = pkbf(v1[2], v1[3]);
                    *(v4u*)(Y + (size_t)r * D + col + bj * 128) = w; }
            }
    }
};
struct EpiP {
    static constexpr bool PERM = true, AFTER_DRAIN = false;
    bf16 *P, *Z;
    __device__ __forceinline__ void operator()(const f32x4 (&acc)[2][2][4][2], const pg8::Unit& u, int wr, int wc, int fr, int fq) const {
        bf16* base; int ld, coff;
        if (u.pn < 12) { base = P; ld = 3072; coff = u.pn * 256; } else { base = Z; ld = 1024; coff = (u.pn - 12) * 256; }
#pragma unroll
        for (int ai = 0; ai < 2; ++ai)
#pragma unroll
            for (int m = 0; m < 4; ++m) {
                const int r = u.pm * 256 + ai * 128 + wr * 64 + m * 16 + fr;
#pragma unroll
                for (int bj = 0; bj < 2; ++bj) { const f32x4 v0 = acc[ai][bj][m][0], v1 = acc[ai][bj][m][1];
                    v4u w; w.x = pkbf(v0[0], v0[1]); w.y = pkbf(v0[2], v0[3]); w.z = pkbf(v1[0], v1[1]); w.w = pkbf(v1[2], v1[3]);
                    *(v4u*)(base + (size_t)r * ld + coff + bj * 128 + wc * 32 + 8 * fq) = w; }
            }
    }
};

typedef float f32x16 __attribute__((ext_vector_type(16)));
typedef float f32x2_t __attribute__((ext_vector_type(2)));
typedef __bf16 bf16x2_t __attribute__((ext_vector_type(2)));
__device__ __forceinline__ unsigned cvtpk(float lo, float hi) { f32x2_t v = {lo, hi}; bf16x2_t b = __builtin_convertvector(v, bf16x2_t); return __builtin_bit_cast(unsigned, b); }
#define MFMA32(a, b, c) __builtin_amdgcn_mfma_f32_32x32x16_bf16((a), (b), (c), 0, 0, 0)
constexpr float QSCALE = 0.125f * LOG2E;
constexpr int ATT_KROW = 144, ATT_VROW = 136, ATT_KB = 64 * ATT_KROW, ATT_VB = 64 * ATT_VROW;
struct AttU { int b, kvh, qb, hq, n, jlo, nl, T; bool lat; size_t mrow, ctxbase, latbase; };
__device__ __forceinline__ void att_decode(AttU& U, int u, int g, int half, int r) {
    constexpr int NU_LAT = NB * 4 * 64;
    U.lat = u < NU_LAT;
    if (U.lat) { U.b = u >> 8; U.kvh = (u >> 6) & 3; U.qb = u & 63; } else { const int uu = u - NU_LAT; U.b = uu >> 4; U.kvh = (uu >> 2) & 3; U.qb = uu & 3; }
    U.hq = U.kvh * 4 + g; U.n = U.qb * 64 + half * 32 + r;
    U.mrow = U.lat ? (size_t)U.b * SEQ + U.n : (size_t)MLAT + U.b * CTXL + U.n;
    U.jlo = U.lat ? (U.qb - 2 < 0 ? 0 : U.qb - 2) : 0; const int jhi = U.lat ? (U.qb + 2 > 63 ? 63 : U.qb + 2) : -1; U.nl = jhi - U.jlo + 1; U.T = U.nl + 4;
    U.ctxbase = (size_t)MLAT + U.b * CTXL; U.latbase = (size_t)U.b * SEQ;
}
__device__ __forceinline__ void phase_attn_v2(const Frame& F, const Args& A) {
    const bf16* Q = (const bf16*)(A.ws + WS_Q); const bf16* K = (const bf16*)(A.ws + WS_K); const bf16* VT = (const bf16*)(A.ws + WS_V); bf16* O = (bf16*)(A.ws + WS_ATT);
    LAS unsigned char* Kb = F.lds; LAS unsigned char* Vb = F.lds + 2 * ATT_KB;
    const int g = F.wave >> 1, half = F.wave & 1, r = F.lane & 31, hh = F.lane >> 5;
    const int kr = F.tid >> 3, kc = F.tid & 7;
    constexpr int NU = NB * 4 * 64 + NB * 4 * 4;
    int u = F.vcu; bool have = u < NU;
    AttU U{}, Un{}; v4u kreg = (v4u){0u, 0u, 0u, 0u}, vreg = kreg; bf16x8 qfn[4];
#pragma unroll
    for (int ks = 0; ks < 4; ++ks) qfn[ks] = (bf16x8){0, 0, 0, 0, 0, 0, 0, 0};
#define ATT_PREFETCH(UU) do { const size_t rb_ = ((UU).nl > 0) ? (UU).latbase + (size_t)(UU).jlo * 64 : (UU).ctxbase; \
        kreg = *(const v4u*)(K + (rb_ + kr) * 256 + (UU).kvh * 64 + kc * 8); vreg = *(const v4u*)(VT + (size_t)((UU).kvh * 64 + kr) * MTOT + rb_ + kc * 8); \
        _Pragma("unroll") for (int ks_ = 0; ks_ < 4; ++ks_) qfn[ks_] = *(const bf16x8*)(Q + (UU).mrow * 1024 + (UU).hq * 64 + 16 * ks_ + 8 * hh); } while (0)
    if (have) { att_decode(U, u, g, half, r); ATT_PREFETCH(U); }
    while (have) {
        const int b = U.b, kvh = U.kvh, qb = U.qb, hq = U.hq, n = U.n, jlo = U.jlo, nl = U.nl, T = U.T; const size_t mrow = U.mrow, ctxbase = U.ctxbase, latbase = U.latbase; (void)b;
        bf16x8 qf[4];
#pragma unroll
        for (int ks = 0; ks < 4; ++ks) qf[ks] = qfn[ks];
        const float sink2 = A.in[8][hq] * LOG2E;
        float mrun = sink2, lsum = 0.f;
        f32x16 oacc[2];
#pragma unroll
        for (int i = 0; i < 16; ++i) { oacc[0][i] = 0.f; oacc[1][i] = 0.f; }
        *(LAS v4u*)(Kb + kr * ATT_KROW + kc * 16) = kreg;
        *(LAS v2u*)(Vb + kr * ATT_VROW + kc * 16) = (v2u){vreg.x, vreg.y}; *(LAS v2u*)(Vb + kr * ATT_VROW + kc * 16 + 8) = (v2u){vreg.z, vreg.w};
        __syncthreads();
        const int un = u + F.G; const bool hn = un < NU;
        if (hn) att_decode(Un, un, g, half, r);
        for (int t = 0; t < T; ++t) {
            if (t + 1 < T) { const int t1 = t + 1; const size_t rb = (t1 < nl) ? latbase + (size_t)(jlo + t1) * 64 : ctxbase + (size_t)(t1 - nl) * 64;
                kreg = *(const v4u*)(K + (rb + kr) * 256 + kvh * 64 + kc * 8); vreg = *(const v4u*)(VT + (size_t)(kvh * 64 + kr) * MTOT + rb + kc * 8); }
            else if (hn) ATT_PREFETCH(Un);
            const LAS unsigned char* kb = Kb + (t & 1) * ATT_KB; const LAS unsigned char* vb = Vb + (t & 1) * ATT_VB;
            f32x16 st[2];
#pragma unroll
            for (int sub = 0; sub < 2; ++sub) {
#pragma unroll
                for (int i = 0; i < 16; ++i) st[sub][i] = 0.f;
#pragma unroll
                for (int ks = 0; ks < 4; ++ks) { const bf16x8 kf = *(const LAS bf16x8*)(kb + (32 * sub + r) * ATT_KROW + (16 * ks + 8 * hh) * 2); st[sub] = MFMA32(kf, qf[ks], st[sub]); }
            }
            if (t < nl) { const int jt = jlo + t;
                if (jt == qb - 2 || jt == qb + 2) {
#pragma unroll
                    for (int sub = 0; sub < 2; ++sub)
#pragma unroll
                        for (int i = 0; i < 16; ++i) { const int key = jt * 64 + 32 * sub + (i & 3) + 8 * (i >> 2) + 4 * hh; const int d = key - n; if (d > 128 || d < -128) st[sub][i] = -INFINITY; }
                } }
            float mx = st[0][0];
#pragma unroll
            for (int i = 1; i < 16; ++i) mx = fmaxf(mx, st[0][i]);
#pragma unroll
            for (int i = 0; i < 16; ++i) mx = fmaxf(mx, st[1][i]);
            mx = fmaxf(mx, __shfl_xor(mx, 32));
            const float mnew = fmaxf(mrun, mx);
            if (__builtin_amdgcn_ballot_w64(mnew != mrun) != 0ull) {
                const float alpha = __builtin_amdgcn_exp2f(mrun - mnew); mrun = mnew; lsum *= alpha;
#pragma unroll
                for (int i = 0; i < 16; ++i) { oacc[0][i] *= alpha; oacc[1][i] *= alpha; } }
            float ps = 0.f;
#pragma unroll
            for (int sub = 0; sub < 2; ++sub)
#pragma unroll
                for (int i = 0; i < 16; ++i) { const float p = __builtin_amdgcn_exp2f(st[sub][i] - mnew); st[sub][i] = p; ps += p; }
            lsum += ps;
#pragma unroll
            for (int sub = 0; sub < 2; ++sub)
#pragma unroll
                for (int s = 0; s < 2; ++s) {
                    v4u pw; pw.x = cvtpk(st[sub][8 * s], st[sub][8 * s + 1]); pw.y = cvtpk(st[sub][8 * s + 2], st[sub][8 * s + 3]); pw.z = cvtpk(st[sub][8 * s + 4], st[sub][8 * s + 5]); pw.w = cvtpk(st[sub][8 * s + 6], st[sub][8 * s + 7]);
                    const bf16x8 pf = __builtin_bit_cast(bf16x8, pw);
#pragma unroll
                    for (int dt = 0; dt < 2; ++dt) { const LAS unsigned char* vp = vb + (32 * dt + r) * ATT_VROW + (32 * sub + 16 * s + 4 * hh) * 2;
                        const v2u lo = *(const LAS v2u*)vp, hi = *(const LAS v2u*)(vp + 16);
                        const bf16x8 vf = __builtin_bit_cast(bf16x8, (v4u){lo.x, lo.y, hi.x, hi.y});
                        oacc[dt] = MFMA32(vf, pf, oacc[dt]); }
                }
            if (t + 1 < T) { LAS unsigned char* kw = Kb + ((t + 1) & 1) * ATT_KB; LAS unsigned char* vw = Vb + ((t + 1) & 1) * ATT_VB;
                *(LAS v4u*)(kw + kr * ATT_KROW + kc * 16) = kreg;
                *(LAS v2u*)(vw + kr * ATT_VROW + kc * 16) = (v2u){vreg.x, vreg.y}; *(LAS v2u*)(vw + kr * ATT_VROW + kc * 16 + 8) = (v2u){vreg.z, vreg.w}; }
            __syncthreads();
        }
        lsum += __shfl_xor(lsum, 32);
        const float inv = 1.0f / (lsum + __builtin_amdgcn_exp2f(sink2 - mrun));
        bf16* orow = O + mrow * 1024 + hq * 64;
#pragma unroll
        for (int dt = 0; dt < 2; ++dt)
#pragma unroll
            for (int rq = 0; rq < 4; ++rq) { v2u w; w.x = cvtpk(oacc[dt][4 * rq] * inv, oacc[dt][4 * rq + 1] * inv); w.y = cvtpk(oacc[dt][4 * rq + 2] * inv, oacc[dt][4 * rq + 3] * inv);
                *(v2u*)(orow + 32 * dt + 8 * rq + 4 * hh) = w; }
        U = Un; u = un; have = hn;
    }
#undef ATT_PREFETCH
    if (F.G == 256 && F.vcu >= 128) tr_moe_items(F, A.in[26], A.in[27], A.in[28], A.ws + WS_WGU1, A.ws + WS_WD1, 0, L1_ATT, (F.vcu - 128) * NWAVES + F.wave, 128 * NWAVES);
    else if (F.G != 256) tr_moe_items(F, A.in[26], A.in[27], A.in[28], A.ws + WS_WGU1, A.ws + WS_WD1, 0, L1_ATT, F.vcu * NWAVES + F.wave, F.G * NWAVES);
}

template <int R> __device__ __forceinline__ void nr_rows(const Frame& F, const bf16* xres, int m0, const float* g, const float* mod, const LAS float* WrT, unsigned char* H8, float* AFF, float* AFFC, RowCoef& C, int& curb) {
    f32x4 vv[R][4];
#pragma unroll
    for (int t = 0; t < R; ++t) load_row_bf16(vv[t], xres + (size_t)(m0 + t) * D, F.lane);
#pragma unroll
    for (int t = 0; t < R; ++t) { const int m = m0 + t; const int mb = modrow(m);
        if (mb != curb) { load_coef(C, g, mod + (size_t)mb * 6144 + 3 * 1024, mod + (size_t)mb * 6144 + 4 * 1024, F.lane); curb = mb; }
        const float rstd = row_rstd(vv[t]);
#pragma unroll
        for (int j = 0; j < 4; ++j) vv[t][j] = vv[t][j] * rstd * C.a[j] + C.b[j];
#pragma unroll
        for (int j = 0; j < 4; ++j) ((unsigned*)(H8 + (size_t)m * D))[F.lane + 64 * j] = pk4f8(vv[t][j].x, vv[t][j].y, vv[t][j].z, vv[t][j].w); }
    const LAS float* wrt = WrT; asm volatile("" : "+v"(wrt));
    float lgt[R];
    proj16xR<R>(vv, wrt, F.lane, lgt);
#pragma unroll
    for (int t = 0; t < R; ++t) { const float logit = lgt[t];
        float mx = logit;
#pragma unroll
        for (int o = 4; o < 64; o <<= 1) mx = fmaxf(mx, __shfl_xor(mx, o));
        const float ex = expf(logit - mx); float den = ex;
#pragma unroll
        for (int o = 4; o < 64; o <<= 1) den += __shfl_xor(den, o);
        const float mine = ex / den; const int ee = F.lane >> 2; const int m = m0 + t;
        if ((F.lane & 3) == 0) { if (m < MLAT) AFF[((size_t)(m >> 12) * NE + ee) * SEQ + (m & 4095)] = mine; else { const int mm = m - MLAT; AFFC[((size_t)(mm >> 8) * NE + ee) * CTXL + (mm & 255)] = mine; } } }
}
__device__ __forceinline__ void phase_norm_router(const Frame& F, const Args& A, const bf16* xres, int nrows, const float* g, const float* mod, const float* router) {
    LAS float* WrT = (LAS float*)F.lds;
    for (int idx = F.tid; idx < 16384; idx += NTHR) WrT[(idx & 15) * 1024 + (idx >> 4)] = router[idx];
    __syncthreads();
    const int gw = F.vcu * NWAVES + F.wave, NGW = F.G * NWAVES;
    unsigned char* H8 = A.ws + WS_H8; float* AFF = (float*)(A.ws + WS_AFF); float* AFFC = AFF + (size_t)NB * NE * SEQ;
    const int rpw = (nrows + NGW - 1) / NGW;
    int curb = -1; RowCoef C;
    const int mbeg = gw * rpw, cnt = (nrows - mbeg) < rpw ? (nrows - mbeg) : rpw;
    int r = 0;
    for (; r + 4 <= cnt; r += 4) nr_rows<4>(F, xres, mbeg + r, g, mod, WrT, H8, AFF, AFFC, C, curb);
    for (; r < cnt; ++r) nr_rows<1>(F, xres, mbeg + r, g, mod, WrT, H8, AFF, AFFC, C, curb);
    __syncthreads();
}

__device__ __forceinline__ void phase_topk(const Frame& F, const Args& A, bool with_ctx, int erows, const float* cwg, const float* cwu, const float* cwd, unsigned char* cwgu, unsigned char* cwdn, int clo, int chi) {
    LAS unsigned* hist = (LAS unsigned*)F.lds;
    LAS unsigned* ctl = hist + 256;
    LAS unsigned* wsum = hist + 272;
    LAS int* sel = (LAS int*)(hist + 512);
    const float* AFF = (const float*)(A.ws + WS_AFF); const float* AFFC = AFF + (size_t)NB * NE * SEQ;
    float* GW = (float*)(A.ws + WS_GW); int* SLOT = (int*)(A.ws + WS_SLOT);
    const unsigned char* H8 = A.ws + WS_H8; unsigned char* XG = A.ws + WS_XG;
    const int nprob = with_ctx ? 256 : 128;
    for (int p = F.vcu; p < nprob; p += F.G) {
        int b, e, N, cap, rowbase, tokbase; const float* src;
        if (p < 128) { b = p >> 4; e = p & 15; N = SEQ; cap = CAPL; src = AFF + (size_t)(b * NE + e) * SEQ; rowbase = e * erows + b * CAPL; tokbase = b * SEQ; }
        else { const int pp = p - 128; b = pp >> 4; e = pp & 15; N = CTXL; cap = CAPC; src = AFFC + (size_t)(b * NE + e) * CTXL; rowbase = e * erows + NB * CAPL + b * CAPC; tokbase = MLAT + b * CTXL; }
        const bool own = 8 * F.tid < N;
        unsigned v[8];
        { f32x4 x0 = (f32x4){0.f, 0.f, 0.f, 0.f}, x1 = x0; if (own) { x0 = ((const f32x4*)src)[2 * F.tid]; x1 = ((const f32x4*)src)[2 * F.tid + 1]; }
          v[0] = __float_as_uint(x0.x); v[1] = __float_as_uint(x0.y); v[2] = __float_as_uint(x0.z); v[3] = __float_as_uint(x0.w); v[4] = __float_as_uint(x1.x); v[5] = __float_as_uint(x1.y); v[6] = __float_as_uint(x1.z); v[7] = __float_as_uint(x1.w); }
        unsigned prefix = 0u, need = (unsigned)cap;
#pragma unroll
        for (int pass = 0; pass < 4; ++pass) { const int shift = 24 - 8 * pass;
            if (F.tid < 256) hist[F.tid] = 0u;
            __syncthreads();
            if (own) {
#pragma unroll
                for (int k = 0; k < 8; ++k) { const bool match = (pass == 0) ? true : ((v[k] >> ((shift + 8) & 31)) == (prefix >> ((shift + 8) & 31))); if (match) atomicAdd((unsigned*)&hist[(v[k] >> shift) & 255u], 1u); } }
            __syncthreads();
            if (F.wave == 0) { const unsigned c0 = hist[4 * F.lane], c1 = hist[4 * F.lane + 1], c2 = hist[4 * F.lane + 2], c3 = hist[4 * F.lane + 3]; const unsigned tot = (c0 + c1) + (c2 + c3);
                unsigned sv = tot;
#pragma unroll
                for (int o = 1; o < 64; o <<= 1) { const unsigned t = __shfl_down(sv, o); if (F.lane + o < 64) sv += t; }
                const unsigned g3 = sv - tot, g2 = g3 + c3, g1 = g2 + c2, g0 = g1 + c1;
                if (g3 < need && need <= g3 + c3) { ctl[0] = 4 * F.lane + 3; ctl[1] = need - g3; }
                else if (g2 < need && need <= g2 + c2) { ctl[0] = 4 * F.lane + 2; ctl[1] = need - g2; }
                else if (g1 < need && need <= g1 + c1) { ctl[0] = 4 * F.lane + 1; ctl[1] = need - g1; }
                else if (g0 < need && need <= g0 + c0) { ctl[0] = 4 * F.lane; ctl[1] = need - g0; } }
            __syncthreads();
            prefix |= ctl[0] << shift; need = ctl[1]; }
        const unsigned T = prefix;
        unsigned packed = 0u;
        if (own) {
#pragma unroll
            for (int k = 0; k < 8; ++k) packed += (v[k] > T ? 1u : 0u) + (v[k] == T ? 0x10000u : 0u); }
        unsigned incl = packed;
#pragma unroll
        for (int o = 1; o < 64; o <<= 1) { const unsigned t = __shfl_up(incl, o); if (F.lane >= o) incl += t; }
        if (F.lane == 63) wsum[F.wave] = incl;
        __syncthreads();
        unsigned base = 0u;
#pragma unroll
        for (int w = 0; w < 8; ++w) if (w < F.wave) base += wsum[w];
        unsigned rg = ((incl - packed) + base) & 0xffffu, re = ((incl - packed) + base) >> 16; const unsigned totalgt = (unsigned)cap - need;
        if (own) {
#pragma unroll
            for (int k = 0; k < 8; ++k) { const int tok = tokbase + 8 * F.tid + k; int slot = -1;
                if (v[k] > T) { slot = (int)rg; ++rg; } else if (v[k] == T) { if (re < need) slot = (int)(totalgt + re); ++re; }
                if (slot >= 0) { GW[rowbase + slot] = __uint_as_float(v[k]); SLOT[(size_t)tok * 16 + e] = rowbase + slot; sel[slot] = tok; } else SLOT[(size_t)tok * 16 + e] = -1; } }
        __syncthreads();
        for (int i0 = F.wave; i0 < cap; i0 += 8 * NWAVES) {
            v4u x[8];
#pragma unroll
            for (int q = 0; q < 8; ++q) { const int i = i0 + q * NWAVES; const int tok = sel[i < cap ? i : i0]; x[q] = ((const v4u*)(H8 + (size_t)tok * D))[F.lane]; }
#pragma unroll
            for (int q = 0; q < 8; ++q) { const int i = i0 + q * NWAVES; if (i < cap) ((v4u*)(XG + (size_t)(rowbase + i) * D))[F.lane] = x[q]; } }
        __syncthreads();
    }
    if (F.G == 256) { if (F.vcu >= 128) tr_moe_items(F, cwg, cwu, cwd, cwgu, cwdn, clo, chi, (F.vcu - 128) * NWAVES + F.wave, 128 * NWAVES); }
    else tr_moe_items(F, cwg, cwu, cwd, cwgu, cwdn, clo, chi, F.vcu * NWAVES + F.wave, F.G * NWAVES);
}

struct CombineIn { int sv; v2u xr[4]; };
__device__ __forceinline__ void combine_issue(CombineIn& ci, const bf16* xres_row, const int* slot_row, int lane) {
    ci.sv = slot_row[lane & 15];
#pragma unroll
    for (int j = 0; j < 4; ++j) ci.xr[j] = ((const v2u*)xres_row)[lane + 64 * j];
}
__device__ __forceinline__ void combine_finish(f32x4 (&v)[4], const CombineIn& ci, const bf16* Y, const float* GW, const float* gt2, int lane) {
    f32x4 acc[4];
#pragma unroll
    for (int j = 0; j < 4; ++j) acc[j] = (f32x4){0.f, 0.f, 0.f, 0.f};
    const int sv = ci.sv;
    unsigned mask = (unsigned)(__builtin_amdgcn_ballot_w64(sv >= 0) & 0xffffull);
    while (mask) {
        v2u w[4][4]; float gte[4];
#pragma unroll
        for (int q = 0; q < 4; ++q) {
            gte[q] = 0.f;
#pragma unroll
            for (int j = 0; j < 4; ++j) w[q][j] = (v2u){0u, 0u};
            if (mask) { const int e = __builtin_ctz(mask); mask &= mask - 1u; const int s = __builtin_amdgcn_readlane(sv, e);
                gte[q] = GW[s]; const v2u* yr = (const v2u*)(Y + (size_t)s * D);
#pragma unroll
                for (int j = 0; j < 4; ++j) w[q][j] = yr[lane + 64 * j]; } }
#pragma unroll
        for (int q = 0; q < 4; ++q)
#pragma unroll
            for (int j = 0; j < 4; ++j) acc[j] += (f32x4){bflo(w[q][j].x), bfhi(w[q][j].x), bflo(w[q][j].y), bfhi(w[q][j].y)} * gte[q];
    }
#pragma unroll
    for (int j = 0; j < 4; ++j) v[j] = (f32x4){bflo(ci.xr[j].x), bfhi(ci.xr[j].x), bflo(ci.xr[j].y), bfhi(ci.xr[j].y)} + ((const f32x4*)gt2)[lane + 64 * j] * acc[j];
}

template <int R> __device__ __forceinline__ void cmb_rows(const Frame& F, const Args& A, int m0, const LAS float* WabT, RowCoef& C, int& curb, float alog, float dtb) {
    const float* MOD0 = (const float*)(A.ws + WS_MOD); const float* MOD1 = MOD0 + 9 * 6144;
    bf16* XRES = (bf16*)(A.ws + WS_XRES); bf16* H = (bf16*)(A.ws + WS_H); const bf16* Y = (const bf16*)(A.ws + WS_XG); const int* SLOT = (const int*)(A.ws + WS_SLOT);
    float* Gb = (float*)(A.ws + WS_G); float* Bb = (float*)(A.ws + WS_BETA);
    f32x4 vv[R][4]; CombineIn ci[R];
#pragma unroll
    for (int t = 0; t < R; ++t) combine_issue(ci[t], XRES + (size_t)(m0 + t) * D, SLOT + (size_t)(m0 + t) * 16, F.lane);
#pragma unroll
    for (int t = 0; t < R; ++t) { const int m = m0 + t; const int mb = modrow(m);
        if (mb != curb) { load_coef(C, A.in[17], MOD1 + (size_t)mb * 6144, MOD1 + (size_t)mb * 6144 + 1024, F.lane); curb = mb; }
        combine_finish(vv[t], ci[t], Y, (const float*)(A.ws + WS_GW), MOD0 + (size_t)mb * 6144 + 5 * 1024, F.lane);
        store_row_bf16(XRES + (size_t)m * D, vv[t], F.lane);
        const float rstd = row_rstd(vv[t]);
#pragma unroll
        for (int j = 0; j < 4; ++j) vv[t][j] = vv[t][j] * rstd * C.a[j] + C.b[j];
        store_row_bf16(H + (size_t)m * D, vv[t], F.lane); }
    const LAS float* wab = WabT; asm volatile("" : "+v"(wab));
    float av[R], bv[R];
    proj16xR<R>(vv, wab, F.lane, av); proj16xR<R>(vv, wab + 16 * 1024, F.lane, bv);
    if ((F.lane & 3) == 0) { const int jj = F.lane >> 2;
#pragma unroll
        for (int t = 0; t < R; ++t) { const int m = m0 + t; const float xx = av[t] + dtb; const float sp = fmaxf(xx, 0.f) + log1pf(expf(-fabsf(xx))); Gb[(size_t)m * 16 + jj] = -expf(alog) * sp; Bb[(size_t)m * 16 + jj] = 1.0f / (1.0f + expf(-bv[t])); } }
}
__device__ __forceinline__ void phase_combine0(const Frame& F, const Args& A) {
    const int gw = F.vcu * NWAVES + F.wave, NGW = F.G * NWAVES;
    tr_moe_items(F, A.in[26], A.in[27], A.in[28], A.ws + WS_WGU1, A.ws + WS_WD1, L1_ATT + L1_G2 + L1_WIN, L1_ATT + L1_G2 + L1_WIN + L1_CMB, gw, NGW);
    __syncthreads();
    LAS float* WabT = (LAS float*)F.lds;
    for (int idx = F.tid; idx < 32768; idx += NTHR) { const int k = idx >> 5, j = idx & 31; WabT[j * 1024 + k] = A.in[18][(size_t)k * LDWIN + 4096 + j]; }
    __syncthreads();
    const int rpw = (MTOT + NGW - 1) / NGW;
    int curb = -1; RowCoef C;
    const float alog = A.in[20][(F.lane >> 2) & 15], dtb = A.in[21][(F.lane >> 2) & 15];
    const int mbeg = gw * rpw, cnt = (MTOT - mbeg) < rpw ? (MTOT - mbeg) : rpw;
    int r = 0;
    for (; r + 4 <= cnt; r += 4) cmb_rows<4>(F, A, mbeg + r, WabT, C, curb, alog, dtb);
    for (; r < cnt; ++r) cmb_rows<1>(F, A, mbeg + r, WabT, C, curb, alog, dtb);
    __syncthreads();
}

__device__ __forceinline__ void phase_conv(const Frame& F, const Args& A) {
    const int gw = F.vcu * NWAVES + F.wave, NGW = F.G * NWAVES;
    const bf16* P = (const bf16*)(A.ws + WS_PQKV); const float* cw = A.in[19];
    bf16* out0 = (bf16*)(A.ws + WS_QN);
    const int nchunk = NGW / 2, rpc = (MTOT + nchunk - 1) / nchunk;
    const int half = gw & 1, chunk = gw >> 1;
    const int mbeg = chunk * rpc, cnt = (MTOT - mbeg) < rpc ? (MTOT - mbeg) : rpc;
    if (cnt <= 0) return;
    float w[3][3][8];
#pragma unroll
    for (int ii = 0; ii < 3; ++ii) { const int c = 512 * (3 * half + ii) + 8 * F.lane;
#pragma unroll
        for (int j = 0; j < 3; ++j) { const f32x4 a = *(const f32x4*)(cw + j * 3072 + c), bq = *(const f32x4*)(cw + j * 3072 + c + 4);
            w[ii][j][0] = a.x; w[ii][j][1] = a.y; w[ii][j][2] = a.z; w[ii][j][3] = a.w; w[ii][j][4] = bq.x; w[ii][j][5] = bq.y; w[ii][j][6] = bq.z; w[ii][j][7] = bq.w; } }
    v4u xp[3], xc[3], xn[3], xnn[3];
    const int cbase = 512 * 3 * half + 8 * F.lane;
#pragma unroll
    for (int ii = 0; ii < 3; ++ii) { xp[ii] = (v4u){0u, 0u, 0u, 0u}; xc[ii] = *(const v4u*)(P + (size_t)mbeg * 3072 + cbase + 512 * ii); xn[ii] = (v4u){0u, 0u, 0u, 0u}; xnn[ii] = (v4u){0u, 0u, 0u, 0u}; }
    if (mbeg > 0) {
#pragma unroll
        for (int ii = 0; ii < 3; ++ii) xp[ii] = *(const v4u*)(P + (size_t)(mbeg - 1) * 3072 + cbase + 512 * ii); }
    if (mbeg + 1 < MTOT) {
#pragma unroll
        for (int ii = 0; ii < 3; ++ii) xn[ii] = *(const v4u*)(P + (size_t)(mbeg + 1) * 3072 + cbase + 512 * ii); }
    for (int r = 0; r < cnt; ++r) { const int m = mbeg + r;
        bool hp, hn; if (m < MLAT) { const int n = m & 4095; hp = n > 0; hn = n < SEQ - 1; } else { const int l = (m - MLAT) & 255; hp = l > 0; hn = l < CTXL - 1; }
        if (m + 2 < MTOT) {
#pragma unroll
            for (int ii = 0; ii < 3; ++ii) xnn[ii] = *(const v4u*)(P + (size_t)(m + 2) * 3072 + cbase + 512 * ii); }
#pragma unroll
        for (int ii = 0; ii < 3; ++ii) { const int i = 3 * half + ii;
            const v4u a = hp ? xp[ii] : (v4u){0u, 0u, 0u, 0u}, c = xc[ii], e = hn ? xn[ii] : (v4u){0u, 0u, 0u, 0u};
            float y[8];
            y[0] = bflo(a.x) * w[ii][0][0] + bflo(c.x) * w[ii][1][0] + bflo(e.x) * w[ii][2][0]; y[1] = bfhi(a.x) * w[ii][0][1] + bfhi(c.x) * w[ii][1][1] + bfhi(e.x) * w[ii][2][1];
            y[2] = bflo(a.y) * w[ii][0][2] + bflo(c.y) * w[ii][1][2] + bflo(e.y) * w[ii][2][2]; y[3] = bfhi(a.y) * w[ii][0][3] + bfhi(c.y) * w[ii][1][3] + bfhi(e.y) * w[ii][2][3];
            y[4] = bflo(a.z) * w[ii][0][4] + bflo(c.z) * w[ii][1][4] + bflo(e.z) * w[ii][2][4]; y[5] = bfhi(a.z) * w[ii][0][5] + bfhi(c.z) * w[ii][1][5] + bfhi(e.z) * w[ii][2][5];
            y[6] = bflo(a.w) * w[ii][0][6] + bflo(c.w) * w[ii][1][6] + bflo(e.w) * w[ii][2][6]; y[7] = bfhi(a.w) * w[ii][0][7] + bfhi(c.w) * w[ii][1][7] + bfhi(e.w) * w[ii][2][7];
            float ss = 0.f;
#pragma unroll
            for (int t = 0; t < 8; ++t) { y[t] = silu_f(y[t]); ss += y[t] * y[t]; }
            if (i < 4) { ss += __shfl_xor(ss, 1); ss += __shfl_xor(ss, 2); ss += __shfl_xor(ss, 4); ss += __shfl_xor(ss, 8);
                const float sc = (1.0f / sqrtf(ss + EPS)) * (i < 2 ? 0.08838834764831845f : 1.0f);
#pragma unroll
                for (int t = 0; t < 8; ++t) y[t] *= sc; }
            v4u o; o.x = pkbf(y[0], y[1]); o.y = pkbf(y[2], y[3]); o.z = pkbf(y[4], y[5]); o.w = pkbf(y[6], y[7]);
            *(v4u*)(out0 + (size_t)(i >> 1) * (68 * MiB / 2) + (size_t)m * D + ((512 * i + 8 * F.lane) & 1023)) = o;
            xp[ii] = xc[ii]; xc[ii] = xn[ii]; xn[ii] = xnn[ii];
        }
    }
}

constexpr int NCHK = 68, NTASK = NB * 8 * NCHK * 2;
constexpr int TAB_OFF = RING_BYTES + 1024;
typedef short s16x4 __attribute__((ext_vector_type(4)));
typedef short v4i16_t __attribute__((ext_vector_type(4)));
__device__ __forceinline__ size_t gdn_tok0(int b, int cidx) { return cidx < 4 ? (size_t)MLAT + b * CTXL + cidx * 64 : (size_t)b * SEQ + (size_t)(cidx - 4) * 64; }
__device__ __forceinline__ bf16x8 tr_pair(const LAS unsigned char* p, int rowstride4) {
    const s16x4 lo = __builtin_bit_cast(s16x4, __builtin_amdgcn_ds_read_tr16_b64_v4i16((LAS v4i16_t*)p));
    const s16x4 hi = __builtin_bit_cast(s16x4, __builtin_amdgcn_ds_read_tr16_b64_v4i16((LAS v4i16_t*)(p + rowstride4)));
    return (bf16x8){lo[0], lo[1], lo[2], lo[3], hi[0], hi[1], hi[2], hi[3]};
}
__device__ __forceinline__ void st_acc_T(LAS unsigned char* base, int stride, int col, int row0, const f32x16& a, int hh) {
#pragma unroll
    for (int rq = 0; rq < 4; ++rq) { v2u w; w.x = cvtpk(a[4 * rq], a[4 * rq + 1]); w.y = cvtpk(a[4 * rq + 2], a[4 * rq + 3]); *(LAS v2u*)(base + col * stride + (row0 + 8 * rq + 4 * hh) * 2) = w; }
}

__device__ __forceinline__ void phase_gdn_prep(const Frame& F, const Args& A) {
    const bf16* QN = (const bf16*)(A.ws + WS_QN); const bf16* KN = (const bf16*)(A.ws + WS_KN);
    const float* Gb = (const float*)(A.ws + WS_G); const float* Bb = (const float*)(A.ws + WS_BETA);
    bf16* TB = (bf16*)(A.ws + WS_TB); bf16* TG = (bf16*)(A.ws + WS_TG); bf16* QKD = (bf16*)(A.ws + WS_QKD); float* GC = (float*)(A.ws + WS_GC);
    LAS float* As = (LAS float*)(F.lds + F.wave * 16384);
    LAS float* tab = (LAS float*)(F.lds + TAB_OFF + F.wave * 512);
    const int gw = F.vcu * NWAVES + F.wave, NGW = F.G * NWAVES;
    for (int task = gw; task < NTASK; task += NGW) {
        int ln = F.lane; asm volatile("" : "+v"(ln));
        const int r = ln & 31, hh = ln >> 5;
        const int dir = task & 1, t2 = task >> 1, cidx = t2 % NCHK, bh = t2 / NCHK, h = bh & 7, b = bh >> 3;
        const size_t m0 = gdn_tok0(b, cidx);
        { const size_t mi = m0 + (dir ? 63 - ln : ln);
          float gc = Gb[mi * 16 + dir * 8 + h]; const float bt = Bb[mi * 16 + dir * 8 + h];
#pragma unroll
          for (int o = 1; o < 64; o <<= 1) { const float t = __shfl_up(gc, o); if (ln >= o) gc += t; }
          tab[ln] = gc; tab[64 + ln] = bt; GC[(size_t)task * 64 + ln] = gc; }
        bf16x8 kf[2][8], qf[2][8];
        LAS unsigned char* tl8 = (LAS unsigned char*)As;
        const int l4 = ln >> 4, l15 = ln & 15, rr = ln & 31, h2 = ln >> 5;
#pragma unroll
        for (int which = 0; which < 2; ++which) { const bf16* src = which ? KN : QN;
#pragma unroll
            for (int hb = 0; hb < 2; ++hb) { v4u st[8];
#pragma unroll
                for (int i = 0; i < 8; ++i) { const int row = 32 * hb + 4 * i + l4; const size_t m = m0 + (dir ? 63 - row : row); st[i] = *(const v4u*)(src + m * D + h * 128 + l15 * 8); }
#pragma unroll
                for (int i = 0; i < 8; ++i) { const int row = 32 * hb + 4 * i + l4; *(LAS v4u*)(tl8 + (row * 16 + (l15 ^ (row & 15))) * 16) = st[i]; }
                asm volatile("" ::: "memory"); }
            LDS_WAIT();
#pragma unroll
            for (int ti = 0; ti < 2; ++ti) { const int row = 32 * ti + rr;
#pragma unroll
                for (int s = 0; s < 8; ++s) { const bf16x8 f = *(const LAS bf16x8*)(tl8 + (row * 16 + ((2 * s + h2) ^ (row & 15))) * 16); if (which) kf[ti][s] = f; else qf[ti][s] = f; } }
            LDS_WAIT();
        }
#pragma unroll
        for (int tile = 0; tile < 3; ++tile) { const int ti = tile == 0 ? 0 : 1, tj = tile == 2 ? 1 : 0;
            f32x16 acc;
#pragma unroll
            for (int i = 0; i < 16; ++i) acc[i] = 0.f;
#pragma unroll
            for (int s = 0; s < 8; ++s) acc = MFMA32(kf[ti][s], kf[tj][s], acc);
            const int j = 32 * tj + r; const float gcj = tab[j];
#pragma unroll
            for (int i16 = 0; i16 < 16; ++i16) { const int i = 32 * ti + (i16 & 3) + 8 * (i16 >> 2) + 4 * hh;
                As[i * 64 + ((((j >> 2) ^ (i & 15)) << 2) | (j & 3))] = (i > j) ? tab[64 + i] * acc[i16] * __expf(tab[i] - gcj) : 0.f; } }
        bf16* qkd = QKD + (size_t)task * 4096;
#pragma unroll
        for (int ti = 0; ti < 2; ++ti) { const int row = 32 * ti + r;
            const float gci = tab[row];
#pragma unroll
            for (int tj = 0; tj < 2; ++tj) {
                if (tj > ti) { *(v4u*)(qkd + row * 64 + 32 + 16 * hh) = (v4u){0u, 0u, 0u, 0u}; *(v4u*)(qkd + row * 64 + 32 + 16 * hh + 8) = (v4u){0u, 0u, 0u, 0u}; continue; }
                f32x16 acc;
#pragma unroll
                for (int i = 0; i < 16; ++i) acc[i] = 0.f;
#pragma unroll
                for (int s = 0; s < 8; ++s) acc = MFMA32(kf[tj][s], qf[ti][s], acc);
#pragma unroll
                for (int rq = 0; rq < 4; ++rq) { const int j0 = 32 * tj + 8 * rq + 4 * hh; float v[4];
#pragma unroll
                    for (int e = 0; e < 4; ++e) { const int j = j0 + e; v[e] = (row >= j) ? acc[4 * rq + e] * __expf(gci - tab[j]) : 0.f; }
                    v2u w; w.x = cvtpk(v[0], v[1]); w.y = cvtpk(v[2], v[3]); *(v2u*)(qkd + row * 64 + j0) = w; }
            } }
        LDS_WAIT();
        LAS unsigned char* Tr = tl8;
        LAS unsigned char* Tcb = tl8 + 8192;
#define PREP_LDA8(DST, ROW, G0) do { const int row_ = (ROW); const f32x4 a_ = *(const LAS f32x4*)(As + row_ * 64 + ((((G0)) ^ (row_ & 15)) << 2)); const f32x4 b_ = *(const LAS f32x4*)(As + row_ * 64 + ((((G0) + 1) ^ (row_ & 15)) << 2)); \
            v4u w_; w_.x = cvtpk(a_.x, a_.y); w_.y = cvtpk(a_.z, a_.w); w_.z = cvtpk(b_.x, b_.y); w_.w = cvtpk(b_.z, b_.w); DST = __builtin_bit_cast(bf16x8, w_); } while (0)
        bf16x8 L64[2], L32[2];
#pragma unroll
        for (int ks = 0; ks < 2; ++ks) PREP_LDA8(L64[ks], 32 + r, 4 * ks + 2 * hh);
#pragma unroll
        for (int q = 0; q < 2; ++q) { PREP_LDA8(L32[q], 32 * q + r, 8 * q + 2 * hh); if (r < 16) L32[q] = (bf16x8){0, 0, 0, 0, 0, 0, 0, 0}; }
#undef PREP_LDA8
        const int dblk = ln >> 4, cl = ln & 15;
        float x[16];
#pragma unroll
        for (int i = 0; i < 16; ++i) { float acc = (cl == i) ? 1.f : 0.f;
#pragma unroll
            for (int jq = 0; jq < (i + 3) / 4; ++jq) { const f32x4 a4 = *(const LAS f32x4*)(As + (16 * dblk + i) * 64 + (((4 * dblk + jq) ^ i) << 2));
                if (4 * jq + 0 < i) acc -= a4.x * x[4 * jq + 0];
                if (4 * jq + 1 < i) acc -= a4.y * x[4 * jq + 1];
                if (4 * jq + 2 < i) acc -= a4.z * x[4 * jq + 2];
                if (4 * jq + 3 < i) acc -= a4.w * x[4 * jq + 3]; }
            x[i] = acc; }
        LDS_WAIT();
        { v4u w0, w1; w0.x = cvtpk(x[0], x[1]); w0.y = cvtpk(x[2], x[3]); w0.z = cvtpk(x[4], x[5]); w0.w = cvtpk(x[6], x[7]); w1.x = cvtpk(x[8], x[9]); w1.y = cvtpk(x[10], x[11]); w1.z = cvtpk(x[12], x[13]); w1.w = cvtpk(x[14], x[15]);
          *(LAS v4u*)(Tcb + ln * 128 + (((2 * dblk) ^ (ln & 7)) << 4)) = w0; *(LAS v4u*)(Tcb + ln * 128 + (((2 * dblk + 1) ^ (ln & 7)) << 4)) = w1;
#pragma unroll
          for (int i = 0; i < 16; ++i) { const int row = 16 * dblk + i; *(LAS unsigned short*)(Tr + row * 128 + (((ln >> 3) ^ (i & 7)) << 4) + (ln & 7) * 2) = (unsigned short)(cvtpk(x[i], 0.f) & 0xffffu); } }
        LDS_WAIT();
#pragma unroll
        for (int q = 0; q < 2; ++q) {
            v4u bz = (v4u){0u, 0u, 0u, 0u};
            if (r < 16) bz = *(const LAS v4u*)(Tcb + (32 * q + r) * 128 + (((4 * q + hh) ^ (r & 7)) << 4));
            f32x16 W;
#pragma unroll
            for (int i = 0; i < 16; ++i) W[i] = 0.f;
            W = MFMA32(L32[q], __builtin_bit_cast(bf16x8, bz), W);
            v4u pw; pw.x = cvtpk(W[8], W[9]); pw.y = cvtpk(W[10], W[11]); pw.z = cvtpk(W[12], W[13]); pw.w = cvtpk(W[14], W[15]);
            v2u lo = (v2u){0u, 0u}, hi = lo;
            if (r >= 16) { const LAS unsigned char* rowp = Tr + (32 * q + r) * 128; lo = *(const LAS v2u*)(rowp + (((4 * q + 2) ^ (r & 7)) << 4) + 8 * hh); hi = *(const LAS v2u*)(rowp + (((4 * q + 3) ^ (r & 7)) << 4) + 8 * hh); }
            f32x16 Y;
#pragma unroll
            for (int i = 0; i < 16; ++i) Y[i] = 0.f;
            Y = MFMA32(__builtin_bit_cast(bf16x8, ((v4u){lo.x, lo.y, hi.x, hi.y})), __builtin_bit_cast(bf16x8, pw), Y);
            if (r < 16) {
#pragma unroll
                for (int rq = 2; rq < 4; ++rq) { v2u w; w.x = cvtpk(-Y[4 * rq], -Y[4 * rq + 1]); w.y = cvtpk(-Y[4 * rq + 2], -Y[4 * rq + 3]); *(LAS v2u*)(Tcb + (32 * q + r) * 128 + (((4 * q + rq) ^ (r & 7)) << 4) + 8 * hh) = w; }
#pragma unroll
                for (int i = 8; i < 16; ++i) { const int row = 32 * q + (i & 3) + 8 * (i >> 2) + 4 * hh; *(LAS unsigned short*)(Tr + row * 128 + (((4 * q + (r >> 3)) ^ (row & 7)) << 4) + (r & 7) * 2) = (unsigned short)(cvtpk(-Y[i], 0.f) & 0xffffu); }
            }
        }
        LDS_WAIT();
        { f32x16 W;
#pragma unroll
          for (int i = 0; i < 16; ++i) W[i] = 0.f;
#pragma unroll
          for (int ks = 0; ks < 2; ++ks) { v4u bz = (v4u){0u, 0u, 0u, 0u}; if (ks >= (r >> 4)) bz = *(const LAS v4u*)(Tcb + r * 128 + (((2 * ks + hh) ^ (r & 7)) << 4)); W = MFMA32(L64[ks], __builtin_bit_cast(bf16x8, bz), W); }
          f32x16 Y;
#pragma unroll
          for (int i = 0; i < 16; ++i) Y[i] = 0.f;
#pragma unroll
          for (int sq = 0; sq < 2; ++sq) { v4u pw; pw.x = cvtpk(W[8 * sq], W[8 * sq + 1]); pw.y = cvtpk(W[8 * sq + 2], W[8 * sq + 3]); pw.z = cvtpk(W[8 * sq + 4], W[8 * sq + 5]); pw.w = cvtpk(W[8 * sq + 6], W[8 * sq + 7]);
              v2u lo = (v2u){0u, 0u}, hi = lo;
              if (sq <= (r >> 4)) { const LAS unsigned char* rowp = Tr + (32 + r) * 128; lo = *(const LAS v2u*)(rowp + (((4 + 2 * sq) ^ (r & 7)) << 4) + 8 * hh); hi = *(const LAS v2u*)(rowp + (((5 + 2 * sq) ^ (r & 7)) << 4) + 8 * hh); }
              Y = MFMA32(__builtin_bit_cast(bf16x8, ((v4u){lo.x, lo.y, hi.x, hi.y})), __builtin_bit_cast(bf16x8, pw), Y); }
#pragma unroll
          for (int i = 0; i < 16; ++i) { const int row = 32 + (i & 3) + 8 * (i >> 2) + 4 * hh; *(LAS unsigned short*)(Tr + row * 128 + (((r >> 3) ^ (row & 7)) << 4) + (r & 7) * 2) = (unsigned short)(cvtpk(-Y[i], 0.f) & 0xffffu); } }
        LDS_WAIT();
        { const int cch = ln & 7, rb = ln >> 3;
          float sbv[8], sgv[8];
#pragma unroll
          for (int e = 0; e < 8; ++e) { const float bt = tab[64 + 8 * cch + e]; sbv[e] = bt; sgv[e] = -bt * __expf(tab[8 * cch + e]); }
          bf16* tb = TB + (size_t)task * 4096 + 8 * cch; bf16* tg = TG + (size_t)task * 4096 + 8 * cch;
#pragma unroll
          for (int it = 0; it < 8; ++it) { const int row = rb + 8 * it;
              v4u t = (v4u){0u, 0u, 0u, 0u};
              if ((cch >> 1) <= (it >> 1)) t = *(const LAS v4u*)(Tr + row * 128 + ((cch ^ rb) << 4));
              const float f0 = bflo(t.x), f1 = bfhi(t.x), f2 = bflo(t.y), f3 = bfhi(t.y), f4 = bflo(t.z), f5 = bfhi(t.z), f6 = bflo(t.w), f7 = bfhi(t.w);
              v4u o; o.x = cvtpk(f0 * sbv[0], f1 * sbv[1]); o.y = cvtpk(f2 * sbv[2], f3 * sbv[3]); o.z = cvtpk(f4 * sbv[4], f5 * sbv[5]); o.w = cvtpk(f6 * sbv[6], f7 * sbv[7]);
              *(v4u*)(tb + row * 64) = o;
              o.x = cvtpk(f0 * sgv[0], f1 * sgv[1]); o.y = cvtpk(f2 * sgv[2], f3 * sgv[3]); o.z = cvtpk(f4 * sgv[4], f5 * sgv[5]); o.w = cvtpk(f6 * sgv[6], f7 * sgv[7]);
              *(v4u*)(tg + row * 64) = o; } }
        LDS_WAIT();
    }
    if (F.G == 256 && F.vcu >= 64) tr_moe_items(F, A.in[26], A.in[27], A.in[28], A.ws + WS_WGU1, A.ws + WS_WD1, L1_ATT + L1_G2 + L1_WIN + L1_CMB, L1_ATT + L1_G2 + L1_WIN + L1_CMB + L1_PREP, (F.vcu - 64) * NWAVES + F.wave, 192 * NWAVES);
    else if (F.G != 256) tr_moe_items(F, A.in[26], A.in[27], A.in[28], A.ws + WS_WGU1, A.ws + WS_WD1, L1_ATT + L1_G2 + L1_WIN + L1_CMB, L1_ATT + L1_G2 + L1_WIN + L1_CMB + L1_PREP, F.vcu * NWAVES + F.wave, F.G * NWAVES);
}

constexpr int G_QS = 0, G_KS = 17408, G_VS = 37888, G_TBS = 50176, G_TGS = 59392, G_QKS = 68608, G_WS = 77824, G_SS = 95232, G_VNS = 112640, G_VSS = 121856;
constexpr int G_SQ = 272, G_SK = 320, G_SV = 192, G_ST = 144;
__device__ __forceinline__ void phase_gdn_scan(const Frame& F, const Args& A) {
    const bf16* QN = (const bf16*)(A.ws + WS_QN); const bf16* KN = (const bf16*)(A.ws + WS_KN); const bf16* VV = (const bf16*)(A.ws + WS_VV);
    const bf16* TB = (const bf16*)(A.ws + WS_TB); const bf16* TG = (const bf16*)(A.ws + WS_TG); const bf16* QKD = (const bf16*)(A.ws + WS_QKD); const float* GC = (const float*)(A.ws + WS_GC);
    bf16* OF = (bf16*)A.out; bf16* OB = OF + (size_t)MLAT * D;
    LAS unsigned char* L = F.lds; LAS float* tab = (LAS float*)(F.lds + TAB_OFF);
    const int w = F.wave, r = F.lane & 31, hh = F.lane >> 5, g16 = F.lane >> 4, q4 = (F.lane & 15) >> 2, p4 = F.lane & 3;
    const int dkt = w >> 1, tt1 = w & 1, dvtS = w & 1;
    const int ttv = (w & 3) >> 1, dvtv = w & 1;
    const int dvto = (w & 3) >> 1, tto = w & 1;
    const int trrow = 8 * (g16 >> 1) + q4, trcol = 16 * (g16 & 1) + 4 * p4;
    for (int unit = F.vcu; unit < 256; unit += F.G) {
        const int half = unit & 1, dir = (unit >> 1) & 1, h = (unit >> 2) & 7, b = unit >> 5;
        bf16* O = dir ? OB : OF;
        f32x16 accS;
#pragma unroll
        for (int i = 0; i < 16; ++i) accS[i] = 0.f;
        v4u pre[8]; float gcv = 0.f, gcl = 0.f;
#define GDN_LOAD_A(S_) do { const int cidx_ = dir ? ((S_) < 4 ? 3 - (S_) : 71 - (S_)) : (S_); const size_t m0_ = gdn_tok0(b, cidx_); const size_t task_ = ((size_t)((b * 8 + h) * NCHK + cidx_)) * 2 + dir; \
        _Pragma("unroll") for (int e_ = 0; e_ < 2; ++e_) { const int ci_ = F.tid + 512 * e_, row_ = ci_ >> 4, c16_ = ci_ & 15; const size_t m_ = m0_ + (dir ? 63 - row_ : row_); \
            pre[2 + e_] = *(const v4u*)(KN + m_ * D + h * 128 + c16_ * 8); } \
        { const int row_ = F.tid >> 3, c16_ = F.tid & 7; const size_t m_ = m0_ + (dir ? 63 - row_ : row_); pre[4] = *(const v4u*)(VV + m_ * D + h * 128 + half * 64 + c16_ * 8); \
          pre[5] = *(const v4u*)(TB + task_ * 4096 + F.tid * 8); pre[6] = *(const v4u*)(TG + task_ * 4096 + F.tid * 8); } } while (0)
#define GDN_LOAD_B(S_) do { const int cidx_ = dir ? ((S_) < 4 ? 3 - (S_) : 71 - (S_)) : (S_); const size_t m0_ = gdn_tok0(b, cidx_); const size_t task_ = ((size_t)((b * 8 + h) * NCHK + cidx_)) * 2 + dir; \
        _Pragma("unroll") for (int e_ = 0; e_ < 2; ++e_) { const int ci_ = F.tid + 512 * e_, row_ = ci_ >> 4, c16_ = ci_ & 15; const size_t m_ = m0_ + (dir ? 63 - row_ : row_); \
            pre[e_] = *(const v4u*)(QN + m_ * D + h * 128 + c16_ * 8); } \
        pre[7] = *(const v4u*)(QKD + task_ * 4096 + F.tid * 8); \
        gcv = GC[task_ * 64 + (F.tid & 63)]; gcl = GC[task_ * 64 + 63]; } while (0)
#define GDN_LOAD(S_) do { GDN_LOAD_A(S_); GDN_LOAD_B(S_); } while (0)
#define GDN_STAGE() do { \
        _Pragma("unroll") for (int e_ = 0; e_ < 2; ++e_) { const int ci_ = F.tid + 512 * e_, row_ = ci_ >> 4, c16_ = ci_ & 15; \
            *(LAS v4u*)(L + G_QS + row_ * G_SQ + c16_ * 16) = pre[e_]; *(LAS v4u*)(L + G_KS + row_ * G_SK + c16_ * 16) = pre[2 + e_]; } \
        { const int row_ = F.tid >> 3, c16_ = F.tid & 7; *(LAS v4u*)(L + G_VS + row_ * G_SV + c16_ * 16) = pre[4]; \
          *(LAS v4u*)(L + G_TBS + row_ * G_ST + c16_ * 16) = pre[5]; *(LAS v4u*)(L + G_TGS + row_ * G_ST + c16_ * 16) = pre[6]; *(LAS v4u*)(L + G_QKS + row_ * G_ST + c16_ * 16) = pre[7]; } \
        if (F.tid < 64) { tab[F.tid] = __expf(gcv); tab[64 + F.tid] = __expf(gcl - gcv); if (F.tid == 0) tab[128] = __expf(gcl); } } while (0)
#define GDN_STAGE_A() do { \
        _Pragma("unroll") for (int e_ = 0; e_ < 2; ++e_) { const int ci_ = F.tid + 512 * e_, row_ = ci_ >> 4, c16_ = ci_ & 15; *(LAS v4u*)(L + G_KS + row_ * G_SK + c16_ * 16) = pre[2 + e_]; } \
        { const int row_ = F.tid >> 3, c16_ = F.tid & 7; *(LAS v4u*)(L + G_VS + row_ * G_SV + c16_ * 16) = pre[4]; \
          *(LAS v4u*)(L + G_TBS + row_ * G_ST + c16_ * 16) = pre[5]; *(LAS v4u*)(L + G_TGS + row_ * G_ST + c16_ * 16) = pre[6]; } } while (0)
#define GDN_STAGE_B() do { \
        _Pragma("unroll") for (int e_ = 0; e_ < 2; ++e_) { const int ci_ = F.tid + 512 * e_, row_ = ci_ >> 4, c16_ = ci_ & 15; *(LAS v4u*)(L + G_QS + row_ * G_SQ + c16_ * 16) = pre[e_]; } \
        { const int row_ = F.tid >> 3, c16_ = F.tid & 7; *(LAS v4u*)(L + G_QKS + row_ * G_ST + c16_ * 16) = pre[7]; } \
        if (F.tid < 64) { tab[F.tid] = __expf(gcv); tab[64 + F.tid] = __expf(gcl - gcv); if (F.tid == 0) tab[128] = __expf(gcl); } } while (0)
        GDN_LOAD(0); GDN_STAGE();
        GDN_LOAD(1);
        __syncthreads();
        for (int s = 0; s < NCHK; ++s) {
            const int cidx = dir ? (s < 4 ? 3 - s : 71 - s) : s; const size_t m0 = gdn_tok0(b, cidx);
            bf16x8 kT[4];
#pragma unroll
            for (int ks = 0; ks < 4; ++ks) kT[ks] = tr_pair(L + G_KS + (16 * ks + trrow) * G_SK + (32 * dkt + trcol) * 2, 4 * G_SK);
            { f32x16 accw;
#pragma unroll
              for (int i = 0; i < 16; ++i) accw[i] = 0.f;
#pragma unroll
              for (int ks = 0; ks < 4; ++ks) { const bf16x8 bq = *(const LAS bf16x8*)(L + G_TGS + (32 * tt1 + r) * G_ST + (16 * ks + 8 * hh) * 2); accw = MFMA32(kT[ks], bq, accw); }
              st_acc_T(L + G_WS, G_SQ, 32 * tt1 + r, 32 * dkt, accw, hh); }
            f32x16 accv;
#pragma unroll
            for (int i = 0; i < 16; ++i) accv[i] = 0.f;
            if (w < 4) {
#pragma unroll
                for (int ks = 0; ks < 4; ++ks) { const bf16x8 a = *(const LAS bf16x8*)(L + G_TBS + (32 * ttv + r) * G_ST + (16 * ks + 8 * hh) * 2);
                    const bf16x8 bv = tr_pair(L + G_VS + (16 * ks + trrow) * G_SV + (32 * dvtv + trcol) * 2, 4 * G_SV); accv = MFMA32(a, bv, accv); }
            }
            st_acc_T(L + G_SS, G_SQ, 32 * dvtS + r, 32 * dkt, accS, hh);
            __syncthreads();
            if (s + 1 < NCHK) GDN_STAGE_A();
            if (s + 2 < NCHK) GDN_LOAD_A(s + 2);
            f32x16 acco;
#pragma unroll
            for (int i = 0; i < 16; ++i) acco[i] = 0.f;
            if (w < 4) {
#pragma unroll
                for (int ks = 0; ks < 8; ++ks) { const bf16x8 a = *(const LAS bf16x8*)(L + G_WS + (32 * ttv + r) * G_SQ + (16 * ks + 8 * hh) * 2);
                    const bf16x8 bs = *(const LAS bf16x8*)(L + G_SS + (32 * dvtv + r) * G_SQ + (16 * ks + 8 * hh) * 2); accv = MFMA32(a, bs, accv); }
                st_acc_T(L + G_VNS, G_ST, 32 * dvtv + r, 32 * ttv, accv, hh);
                f32x16 sc;
#pragma unroll
                for (int rq = 0; rq < 4; ++rq) { const f32x4 e4 = *(const LAS f32x4*)(tab + 64 + 32 * ttv + 8 * rq + 4 * hh);
                    sc[4 * rq] = accv[4 * rq] * e4.x; sc[4 * rq + 1] = accv[4 * rq + 1] * e4.y; sc[4 * rq + 2] = accv[4 * rq + 2] * e4.z; sc[4 * rq + 3] = accv[4 * rq + 3] * e4.w; }
                st_acc_T(L + G_VSS, G_ST, 32 * dvtv + r, 32 * ttv, sc, hh);
            } else {
#pragma unroll
                for (int ks = 0; ks < 8; ++ks) { const bf16x8 a = *(const LAS bf16x8*)(L + G_SS + (32 * dvto + r) * G_SQ + (16 * ks + 8 * hh) * 2);
                    const bf16x8 bq = *(const LAS bf16x8*)(L + G_QS + (32 * tto + r) * G_SQ + (16 * ks + 8 * hh) * 2); acco = MFMA32(a, bq, acco); }
                const float egi = tab[32 * tto + r];
#pragma unroll
                for (int i = 0; i < 16; ++i) acco[i] *= egi;
            }
            __syncthreads();
            if (w >= 4) {
#pragma unroll
                for (int ks = 0; ks < 4; ++ks) { const bf16x8 a = *(const LAS bf16x8*)(L + G_VNS + (32 * dvto + r) * G_ST + (16 * ks + 8 * hh) * 2);
                    const bf16x8 bq = *(const LAS bf16x8*)(L + G_QKS + (32 * tto + r) * G_ST + (16 * ks + 8 * hh) * 2); acco = MFMA32(a, bq, acco); }
                if (cidx >= 4) { const int i = 32 * tto + r; const size_t m = m0 + (dir ? 63 - i : i);
                    bf16* op = O + m * D + h * 128 + half * 64 + 32 * dvto + 4 * hh;
#pragma unroll
                    for (int rq = 0; rq < 4; ++rq) { v2u ww; ww.x = cvtpk(acco[4 * rq], acco[4 * rq + 1]); ww.y = cvtpk(acco[4 * rq + 2], acco[4 * rq + 3]); *(v2u*)(op + 8 * rq) = ww; } }
            }
            { const float egl = tab[128];
#pragma unroll
              for (int i = 0; i < 16; ++i) accS[i] *= egl;
#pragma unroll
              for (int ks = 0; ks < 4; ++ks) { const bf16x8 bv = *(const LAS bf16x8*)(L + G_VSS + (32 * dvtS + r) * G_ST + (16 * ks + 8 * hh) * 2); accS = MFMA32(kT[ks], bv, accS); } }
            __syncthreads();
            if (s + 1 < NCHK) GDN_STAGE_B();
            if (s + 2 < NCHK) GDN_LOAD_B(s + 2);
        }
        __syncthreads();
#undef GDN_LOAD
#undef GDN_LOAD_A
#undef GDN_LOAD_B
#undef GDN_STAGE
#undef GDN_STAGE_A
#undef GDN_STAGE_B
    }
}

__device__ __forceinline__ void phase_readout(const Frame& F, const Args& A) {
    const int gw = F.vcu * NWAVES + F.wave, NGW = F.G * NWAVES;
    const bf16* OF = (const bf16*)A.out; const bf16* OB = OF + (size_t)MLAT * D; const bf16* Z = (const bf16*)(A.ws + WS_Z); bf16* RO = (bf16*)(A.ws + WS_RO);
    const f32x4 on = ((const f32x4*)A.in[22])[F.lane & 31];
    const int rpw = (MLAT + NGW - 1) / NGW;
    const int mbeg = gw * rpw, cnt = (MLAT - mbeg) < rpw ? (MLAT - mbeg) : rpw;
    for (int r = 0; r < cnt; r += 2) {
        v2u wf[2][4], wb[2][4], zw[2][4];
#pragma unroll
        for (int t = 0; t < 2; ++t) { const int m = mbeg + ((r + t < cnt) ? r + t : r);
#pragma unroll
            for (int j = 0; j < 4; ++j) { wf[t][j] = ((const v2u*)(OF + (size_t)m * D))[F.lane + 64 * j]; wb[t][j] = ((const v2u*)(OB + (size_t)m * D))[F.lane + 64 * j]; zw[t][j] = ((const v2u*)(Z + (size_t)m * D))[F.lane + 64 * j]; } }
#pragma unroll
        for (int t = 0; t < 2; ++t) { const int m = mbeg + r + t;
            f32x4 v[4];
#pragma unroll
            for (int j = 0; j < 4; ++j) {
                v[j] = (f32x4){bflo(wf[t][j].x) + bflo(wb[t][j].x), bfhi(wf[t][j].x) + bfhi(wb[t][j].x), bflo(wf[t][j].y) + bflo(wb[t][j].y), bfhi(wf[t][j].y) + bfhi(wb[t][j].y)};
                float ss = (v[j].x * v[j].x + v[j].y * v[j].y) + (v[j].z * v[j].z + v[j].w * v[j].w);
                ss += __shfl_xor(ss, 1); ss += __shfl_xor(ss, 2); ss += __shfl_xor(ss, 4); ss += __shfl_xor(ss, 8); ss += __shfl_xor(ss, 16);
                const float rs = 1.0f / sqrtf(ss * (1.0f / 128.0f) + EPS);
                v[j].x = v[j].x * rs * on.x * silu_f(bflo(zw[t][j].x)); v[j].y = v[j].y * rs * on.y * silu_f(bfhi(zw[t][j].x)); v[j].z = v[j].z * rs * on.z * silu_f(bflo(zw[t][j].y)); v[j].w = v[j].w * rs * on.w * silu_f(bfhi(zw[t][j].y)); }
            if (r + t < cnt) store_row_bf16(RO + (size_t)m * D, v, F.lane); }
    }
}


struct EpiNull { static constexpr bool PERM = false, AFTER_DRAIN = false; float* sink;
    __device__ __forceinline__ void operator()(const f32x4 (&acc)[2][2][4][2], const pg8::Unit&, int, int, int, int) const { float s = 0.f;
#pragma unroll
        for (int a = 0; a < 2; ++a)
#pragma unroll
            for (int b = 0; b < 2; ++b)
#pragma unroll
                for (int mm = 0; mm < 4; ++mm)
#pragma unroll
                    for (int n = 0; n < 2; ++n) s += acc[a][b][mm][n][0] + acc[a][b][mm][n][3];
        if (s == 12345.678f) sink[threadIdx.x] = s; }
};
struct ProbeOrder { int nunits, nM, G, c, mode;
    __device__ void init(int nunits_, int nM_, int G_, int c_, int mode_) { nunits = nunits_; nM = nM_; G = G_; c = c_; mode = mode_; }
    __device__ bool next(int i, pg8::Unit& u) const { const int L = i * G + c; if (L >= nunits) return false; if (mode == 0) { u.pm = L % nM; u.pn = L / nM; } else if (mode == 1) { u.pm = 0; u.pn = 0; } else { u.pm = L % nM; u.pn = 0; } return true; }
    __device__ __forceinline__ void a_ready(const pg8::Unit&) const {}
    __device__ __forceinline__ void done(const pg8::Unit&) const {}
    __device__ __forceinline__ const char* aptr(const pg8::Gemm& g, const pg8::Unit& u, size_t tstep) const { return (const char*)g.A + (size_t)u.pm * tstep; }
    __device__ __forceinline__ const char* bptr(const pg8::Gemm& g, const pg8::Unit& u, size_t tstep) const { return (const char*)g.Bt + (size_t)u.pn * tstep; }
};
__device__ __forceinline__ void phase_final(const Frame& F, const Args& A) {
    const int gw = F.vcu * NWAVES + F.wave, NGW = F.G * NWAVES;
    const float* MOD1 = (const float*)(A.ws + WS_MOD) + 9 * 6144;
    const bf16* XRES = (const bf16*)(A.ws + WS_XRES); const bf16* Y = (const bf16*)(A.ws + WS_XG); const int* SLOT = (const int*)(A.ws + WS_SLOT);
    f32x4 fg[4];
#pragma unroll
    for (int j = 0; j < 4; ++j) fg[j] = ((const f32x4*)A.in[29])[F.lane + 64 * j];
    const int rpw = (MLAT + NGW - 1) / NGW;
    const int mbeg = gw * rpw, cnt = (MLAT - mbeg) < rpw ? (MLAT - mbeg) : rpw;
    for (int r = 0; r < cnt; r += 2) {
        f32x4 vv[2][4]; CombineIn ci[2];
#pragma unroll
        for (int t = 0; t < 2; ++t) { const int m = mbeg + ((r + t < cnt) ? r + t : r); combine_issue(ci[t], XRES + (size_t)m * D, SLOT + (size_t)m * 16, F.lane); }
#pragma unroll
        for (int t = 0; t < 2; ++t) { const int m = mbeg + ((r + t < cnt) ? r + t : r);
            combine_finish(vv[t], ci[t], Y, (const float*)(A.ws + WS_GW), MOD1 + (size_t)(m >> 12) * 6144 + 5 * 1024, F.lane); }
#pragma unroll
        for (int t = 0; t < 2; ++t) { const int m = mbeg + r + t; const float rstd = row_rstd(vv[t]);
            if (r + t < cnt) {
#pragma unroll
                for (int j = 0; j < 4; ++j) ((f32x4*)(A.out + (size_t)m * D))[F.lane + 64 * j] = vv[t][j] * rstd * fg[j]; } }
    }
}

#ifndef MK_ONE_LAUNCH
#define MK_ONE_LAUNCH 1
#endif
__global__ void __launch_bounds__(NWAVES * 64, 2) fwd_kernel(Args args) {
    extern __shared__ __attribute__((aligned(16))) unsigned char lds[];
    Frame F;
    F.lds = (LAS unsigned char*)lds;
    F.MISC = (volatile LAS unsigned*)(F.lds + MISC_OFF);
    F.tid = threadIdx.x; F.lane = F.tid & 63; F.wave = __builtin_amdgcn_readfirstlane(F.tid >> 6);
    F.G = gridDim.x; { const int bx = blockIdx.x; F.vcu = (F.G % 8 == 0) ? (bx % 8) * (F.G / 8) + bx / 8 : bx; }
    unsigned char* ws = args.ws;
    gu32* ctl = (gu32*)(ws + WS_CTL);
    for (int u = F.tid; u < (LDS_BYTES - LDSCTL_OFF) / 4; u += NWAVES * 64) ((LAS unsigned*)(F.lds + LDSCTL_OFF))[u] = 0u;
    __syncthreads();
    XcdBarrier bar; bar.bar = (unsigned*)(ctl + CW_BAR); bar.x = 0; bar.st = nullptr;
    const int lo = args.ph_lo, hi = args.ph_hi;
    if (hi - lo > 1) bar = xcd_barrier_post((unsigned*)(ctl + CW_BAR), F.MISC + 8);
#ifndef PROBE_REP
#define PROBE_REP 0u
#endif
#define IN(k) (lo <= (k) && (k) < hi)
#define SEAM(k) do { if (IN(k) && IN((k) + 1)) xcd_barrier(bar); } while (0)

    const float* MOD0 = (const float*)(ws + WS_MOD); const float* MOD1 = MOD0 + 9 * 6144;
    bf16* XRES = (bf16*)(ws + WS_XRES);

    if (IN(0)) { phase_prologue(F, args); } SEAM(0);
    if (IN(1)) { phase_modnorm0(F, args); } SEAM(1);
    if (IN(2)) {
        pg8::Gemm g{(const pg8::bf16_t*)(ws + WS_H), (const pg8::bf16_t*)(ws + WS_WQKV), MTOT, NQKV, D}; QKVOrder S; S.init(F.G, (int)blockIdx.x);
        EpiQKV E{(bf16*)(ws + WS_Q), (bf16*)(ws + WS_K), (bf16*)(ws + WS_V), (const float*)(ws + WS_ROPE), (const float*)(ws + WS_ROPE) + 1024, QSCALE};
        pg8::gemm_phase<EpiQKV, QKVOrder, true, true>(F.lds, g, S, E);
        if (F.G == 256) { const int lid = (int)blockIdx.x / 8, x = (int)blockIdx.x % 8;
            if (lid >= 6) tr_moe_items(F, args.in[12], args.in[13], args.in[14], ws + WS_WGU, ws + WS_WD, L0_PRO, L0_PRO + L0_QKV, (x * 26 + lid - 6) * NWAVES + F.wave, 208 * NWAVES); }
        else tr_moe_items(F, args.in[12], args.in[13], args.in[14], ws + WS_WGU, ws + WS_WD, L0_PRO, L0_PRO + L0_QKV, F.vcu * NWAVES + F.wave, F.G * NWAVES);
    } SEAM(2);
    if (IN(3)) { phase_attn_v2(F, args); } SEAM(3);
    if (IN(4)) {
        pg8::Gemm g{(const pg8::bf16_t*)(ws + WS_ATT), (const pg8::bf16_t*)(ws + WS_WO0), MTOT, D, D}; pg8::StaticOrder S; S.init(MTOT, D, F.G, (int)blockIdx.x);
        EpiResid<false> E{args.in[0], args.in[2], XRES, MOD0 + 2 * 1024};
        pg8::gemm_phase<EpiResid<false>, pg8::StaticOrder, true, true>(F.lds, g, S, E);
        if (F.G == 256) { if (blockIdx.x >= 32) tr_moe_items(F, args.in[12], args.in[13], args.in[14], ws + WS_WGU, ws + WS_WD, L0_PRO + L0_QKV, L0_PRO + L0_QKV + L0_WO, ((int)blockIdx.x - 32) * NWAVES + F.wave, 224 * NWAVES); }
        else tr_moe_items(F, args.in[12], args.in[13], args.in[14], ws + WS_WGU, ws + WS_WD, L0_PRO + L0_QKV, L0_PRO + L0_QKV + L0_WO, F.vcu * NWAVES + F.wave, F.G * NWAVES);
    } SEAM(4);
    if (IN(5)) { phase_norm_router(F, args, XRES, MTOT, args.in[10], MOD0, args.in[11]); } SEAM(5);
    if (IN(6)) { phase_topk(F, args, true, EROWS0, args.in[12], args.in[13], args.in[14], ws + WS_WGU, ws + WS_WD, IT_MOE - L0_TOPK, IT_MOE); } SEAM(6);
    if (IN(7)) {
        pg8::Gemm g{(const pg8::bf16_t*)(ws + WS_XG), (const pg8::bf16_t*)(ws + WS_WGU), NE * EROWS0, NE * 4096, D / 2}; GroupOrder<EROWS0 / 256, 16> S; S.init(F.G, (int)blockIdx.x);
        EpiSwiGLU E{ws + WS_HID};
        pg8::gemm_phase<EpiSwiGLU, decltype(S), true, true, true>(F.lds, g, S, E);
    } SEAM(7);
    if (IN(8)) {
        pg8::Gemm g{(const pg8::bf16_t*)(ws + WS_HID), (const pg8::bf16_t*)(ws + WS_WD), NE * EROWS0, NE * 1024, FF / 2}; GroupOrder<EROWS0 / 256, 4> S; S.init(F.G, (int)blockIdx.x);
        EpiY E{(bf16*)(ws + WS_XG)};
        pg8::gemm_phase<EpiY, decltype(S), true, true, true>(F.lds, g, S, E);
        if (F.G == 256) { const int lid = (int)blockIdx.x / 8, x = (int)blockIdx.x % 8;
            if (lid >= 8) tr_moe_items(F, args.in[26], args.in[27], args.in[28], ws + WS_WGU1, ws + WS_WD1, L1_ATT, L1_ATT + L1_G2, (x * 24 + lid - 8) * NWAVES + F.wave, 192 * NWAVES); }
        else tr_moe_items(F, args.in[26], args.in[27], args.in[28], ws + WS_WGU1, ws + WS_WD1, L1_ATT, L1_ATT + L1_G2, F.vcu * NWAVES + F.wave, F.G * NWAVES);
    } SEAM(8);
    if (IN(9)) { phase_combine0(F, args); } SEAM(9);
    if (IN(10)) {
        pg8::Gemm g{(const pg8::bf16_t*)(ws + WS_H), (const pg8::bf16_t*)(ws + WS_WIN), MTOT, NWIN, D}; pg8::StaticOrder S; S.init(MTOT, NWIN, F.G, (int)blockIdx.x);
        EpiP E{(bf16*)(ws + WS_PQKV), (bf16*)(ws + WS_Z)};
        pg8::gemm_phase<EpiP, pg8::StaticOrder, true, true>(F.lds, g, S, E);
        if (F.G == 256) { if (blockIdx.x >= 128) tr_moe_items(F, args.in[26], args.in[27], args.in[28], ws + WS_WGU1, ws + WS_WD1, L1_ATT + L1_G2, L1_ATT + L1_G2 + L1_WIN, ((int)blockIdx.x - 128) * NWAVES + F.wave, 128 * NWAVES); }
        else tr_moe_items(F, args.in[26], args.in[27], args.in[28], ws + WS_WGU1, ws + WS_WD1, L1_ATT + L1_G2, L1_ATT + L1_G2 + L1_WIN, F.vcu * NWAVES + F.wave, F.G * NWAVES);
    } SEAM(10);
    if (IN(11)) { phase_conv(F, args); } SEAM(11);
    if (IN(12)) { phase_gdn_prep(F, args); } SEAM(12);
    if (IN(13)) { phase_gdn_scan(F, args); } SEAM(13);
    if (IN(14)) { phase_readout(F, args); } SEAM(14);
    if (IN(15)) {
        pg8::Gemm g{(const pg8::bf16_t*)(ws + WS_RO), (const pg8::bf16_t*)(ws + WS_WO1), MLAT, D, D}; pg8::StaticOrder S; S.init(MLAT, D, F.G, (int)blockIdx.x);
        EpiResid<true> E{XRES, XRES + (size_t)MLAT * D, XRES, MOD1 + 2 * 1024};
        pg8::gemm_phase<EpiResid<true>, pg8::StaticOrder, true, true>(F.lds, g, S, E);
    } SEAM(15);
    if (IN(16)) { phase_norm_router(F, args, XRES, MLAT, args.in[24], MOD1, args.in[25]); } SEAM(16);
    if (IN(17)) { phase_topk(F, args, false, EROWS1, args.in[26], args.in[27], args.in[28], ws + WS_WGU1, ws + WS_WD1, IT_MOE - L1_TOPK, IT_MOE); } SEAM(17);
    if (IN(18)) {
        pg8::Gemm g{(const pg8::bf16_t*)(ws + WS_XG), (const pg8::bf16_t*)(ws + WS_WGU1), NE * EROWS1, NE * 4096, D / 2}; GroupOrder<EROWS1 / 256, 16> S; S.init(F.G, (int)blockIdx.x);
        EpiSwiGLU E{ws + WS_HID};
        pg8::gemm_phase<EpiSwiGLU, decltype(S), true, true, true>(F.lds, g, S, E);
    } SEAM(18);
    if (IN(19)) {
        pg8::Gemm g{(const pg8::bf16_t*)(ws + WS_HID), (const pg8::bf16_t*)(ws + WS_WD1), NE * EROWS1, NE * 1024, FF / 2}; GroupOrder<EROWS1 / 256, 4> S; S.init(F.G, (int)blockIdx.x);
        EpiY E{(bf16*)(ws + WS_XG)};
        pg8::gemm_phase<EpiY, decltype(S), true, true, true>(F.lds, g, S, E);
    } SEAM(19);
    if (IN(20)) { phase_final(F, args); }
#ifdef PROBE_GEMM
    if (IN(21)) {
        EpiNull E{(float*)(ws + 960 * MiB)};
#if PROBE_GEMM == 1 || PROBE_GEMM == 2 || PROBE_GEMM == 7
        { pg8::Gemm g{(const pg8::bf16_t*)(ws + WS_H), (const pg8::bf16_t*)(ws + WS_WIN), MTOT, NWIN, D}; ProbeOrder S; S.init(2176, 136, F.G, (int)blockIdx.x, PROBE_GEMM == 1 ? 0 : (PROBE_GEMM == 2 ? 1 : 2));
          pg8::gemm_phase<EpiNull, ProbeOrder, true, true>(F.lds, g, S, E); }
#elif PROBE_GEMM == 8 || PROBE_GEMM == 9
        { pg8::Gemm g{(const pg8::bf16_t*)(ws + WS_H), (const pg8::bf16_t*)(ws + WS_WIN), MTOT, NWIN, PROBE_GEMM == 8 ? 512 : 256}; ProbeOrder S; S.init(2176, 136, F.G, (int)blockIdx.x, 1);
          pg8::gemm_phase<EpiNull, ProbeOrder, true, true>(F.lds, g, S, E); }
#elif PROBE_GEMM == 10 || PROBE_GEMM == 11
        { pg8::Gemm g{(const pg8::bf16_t*)(ws + WS_XG), (const pg8::bf16_t*)(ws + WS_WGU), NE * EROWS0, NE * 4096, PROBE_GEMM == 10 ? 256 : 1024}; ProbeOrder S; S.init(4352, 272, F.G, (int)blockIdx.x, 1);
          pg8::gemm_phase<EpiNull, ProbeOrder, true, true, true>(F.lds, g, S, E); }
#elif PROBE_GEMM == 3 || PROBE_GEMM == 4
        { pg8::Gemm g{(const pg8::bf16_t*)(ws + WS_HID), (const pg8::bf16_t*)(ws + WS_WD), NE * EROWS0, NE * 1024, FF / 2}; ProbeOrder S; S.init(1088, 272, F.G, (int)blockIdx.x, PROBE_GEMM == 3 ? 0 : 1);
          pg8::gemm_phase<EpiNull, ProbeOrder, true, true, true>(F.lds, g, S, E); }
#elif PROBE_GEMM == 5 || PROBE_GEMM == 6
        { pg8::Gemm g{(const pg8::bf16_t*)(ws + WS_XG), (const pg8::bf16_t*)(ws + WS_WGU), NE * EROWS0, NE * 4096, D / 2}; ProbeOrder S; S.init(4352, 272, F.G, (int)blockIdx.x, PROBE_GEMM == 5 ? 0 : 1);
          pg8::gemm_phase<EpiNull, ProbeOrder, true, true, true>(F.lds, g, S, E); }
#endif
    }
#endif
#undef IN
#undef SEAM
}

extern "C" void kernel_launch(void* const* d_in, const int* in_sizes, int n_in, void* d_out, int out_size, void* d_ws, size_t ws_size, hipStream_t stream) {
    static int grid = 0;
    if (grid == 0) {
        if (n_in != 30 || in_sizes[0] != MLAT * D || out_size != MLAT * D || ws_size < WS_END) { fprintf(stderr, "kernel_launch: unexpected shapes (n_in %d, in0 %d, out %d, ws %zu); nothing launched\n", n_in, n_in > 0 ? in_sizes[0] : -1, out_size, ws_size); grid = -1; return; }
        int dev = 0, cus = 0, per_cu = 0;
        if (hipGetDevice(&dev) != hipSuccess || hipDeviceGetAttribute(&cus, hipDeviceAttributeMultiprocessorCount, dev) != hipSuccess) { grid = -1; return; }
        if (hipFuncSetAttribute((const void*)fwd_kernel, hipFuncAttributeMaxDynamicSharedMemorySize, LDS_BYTES) != hipSuccess) { fprintf(stderr, "kernel_launch: hipFuncSetAttribute failed\n"); grid = -1; return; }
        if (hipOccupancyMaxActiveBlocksPerMultiprocessor(&per_cu, (const void*)fwd_kernel, NWAVES * 64, LDS_BYTES) != hipSuccess || per_cu < 1) { fprintf(stderr, "kernel_launch: occupancy query says %d blocks per CU\n", per_cu); }
        (void)hipGetLastError();
        grid = cus;
        if (grid % 8 != 0) { fprintf(stderr, "kernel_launch: CU count %d is not a multiple of 8\n", grid); grid = -1; return; }
    }
    if (grid < 0) return;
    if (hipMemsetAsync((char*)d_ws + WS_CTL, 0, CTL_ZERO_BYTES, stream) != hipSuccess) return;
    Args a{};
    for (int i = 0; i < 30; ++i) a.in[i] = (const float*)d_in[i];
    a.out = (float*)d_out; a.ws = (unsigned char*)d_ws;
#if MK_ONE_LAUNCH
    a.ph_lo = 0; a.ph_hi = NPH;
    hipLaunchKernelGGL(fwd_kernel, dim3(grid), dim3(NWAVES * 64), LDS_BYTES, stream, a);
#else
#ifdef PROBE_GEMM
    const int nph_launch = NPH + 1;
#else
    const int nph_launch = NPH;
#endif
    for (int p = 0; p < nph_launch; ++p) for (int rep = 0; rep < (((PROBE_REP >> p) & 1u) ? 2 : 1); ++rep) { a.ph_lo = p; a.ph_hi = p + 1; hipLaunchKernelGGL(fwd_kernel, dim3(grid), dim3(NWAVES * 64), LDS_BYTES, stream, a); }
#endif
}
```
